# Optimizing an MI355X kernel written in HIP

```python
import jax, jax.numpy as jnp
from jax import lax
import numpy as np

D_MODEL = 1024
BATCH = 2
SEQ = 8192
DEPTH = 2
DEC_BATCH = 32
DEC_SEQ = 16
PAST_LEN = 4096

CHUNK = 64
EXPAND = 2
D_INNER = EXPAND * D_MODEL
SGU_CHUNK = 128
SGU_GROUPS = 8
SGU_GROUP_DIM = D_INNER // SGU_GROUPS
MLSTM_HEADS = 4
MLSTM_HEAD_DIM = D_INNER // MLSTM_HEADS
QKV_BLOCK = 4
QKV_NBLK = D_INNER // QKV_BLOCK
CONV_W = 4
N_MIXERS = 2
N_A = (DEPTH + 1) // 2
N_B = DEPTH // 2
RMS_EPS = 1e-6
LN_EPS = 1e-5

kernel_name = "chunk_sgu_mlstm_hybrid_step"


def _rmsnorm(x, g):
    xf = x.astype(jnp.float32)
    y = xf * lax.rsqrt(jnp.mean(xf * xf, axis=-1, keepdims=True) + RMS_EPS)
    return (y * g.astype(jnp.float32)).astype(x.dtype)


def _layernorm(x, g, b=None):
    xf = x.astype(jnp.float32)
    mu = jnp.mean(xf, axis=-1, keepdims=True)
    var = jnp.mean(jnp.square(xf - mu), axis=-1, keepdims=True)
    y = (xf - mu) * lax.rsqrt(var + LN_EPS) * g.astype(jnp.float32)
    if b is not None:
        y = y + b.astype(jnp.float32)
    return y.astype(x.dtype)


def _sgu_branch(xn, w_in, ln_g, ln_b, w_s, b_s, w_out, prompt):
    E = D_INNER
    proj = xn @ w_in
    uv = jax.nn.gelu(proj[..., :2 * E])
    u, v = uv[..., :E], uv[..., E:]
    z = proj[..., 2 * E:]
    v = _layernorm(v, ln_g, ln_b)
    bsz, t_len, _ = v.shape
    causal = jnp.tril(jnp.ones((SGU_CHUNK, SGU_CHUNK), dtype=bool))
    w_m = jnp.where(causal, w_s, jnp.zeros_like(w_s))
    if prompt:
        vc = v.reshape(bsz, t_len // SGU_CHUNK, SGU_CHUNK, SGU_GROUPS, SGU_GROUP_DIM)
        s = jnp.einsum('gts,bnsgc->bntgc', w_m, vc) + b_s.T[:, :, None]
    else:
        vc = v.reshape(bsz, t_len, SGU_GROUPS, SGU_GROUP_DIM)
        s = jnp.einsum('gts,bsgc->btgc', w_m[:, :t_len, :t_len], vc) + b_s[:, :t_len].T[:, :, None]
    s = s.reshape(bsz, t_len, E)
    out = u * s * jax.nn.silu(z)
    return out @ w_out, v


def _mlstm_chunk(carry, inp):
    C, n, m = carry
    q, k, v, ig, lf = inp
    L = q.shape[-2]
    b = jnp.cumsum(lf, axis=-1)
    causal = jnp.tril(jnp.ones((L, L), dtype=bool))
    log_d = jnp.where(causal, b[..., :, None] - b[..., None, :] + ig[..., None, :], -jnp.inf)
    m_inter = b + m[..., None]
    m_t = jnp.maximum(m_inter, jnp.max(log_d, axis=-1))
    w_intra = jnp.exp(log_d - m_t[..., None])
    w_inter = jnp.exp(m_inter - m_t)
    s = jnp.einsum('bhtd,bhsd->bhts', q, k) * w_intra
    num = jnp.einsum('bhts,bhse->bhte', s, v) + w_inter[..., None] * jnp.einsum('bhtd,bhde->bhte', q, C)
    den = jnp.sum(s, axis=-1) + w_inter * jnp.einsum('bhtd,bhd->bht', q, n)
    h = num / jnp.maximum(jnp.abs(den), jnp.exp(-m_t))[..., None]
    b_last = b[..., -1]
    log_w = b_last[..., None] - b + ig
    m_new = jnp.maximum(b_last + m, jnp.max(log_w, axis=-1))
    w = jnp.exp(log_w - m_new[..., None])
    decay = jnp.exp(b_last + m - m_new)
    C_new = decay[..., None, None] * C + jnp.einsum('bhs,bhsd,bhse->bhde', w, k, v)
    n_new = decay[..., None] * n + jnp.einsum('bhs,bhsd->bhd', w, k)
    return (C_new, n_new, m_new), h


def _mlstm_branch(xn, w_in, conv_w, conv_b, wq, wk, wv, w_gates, b_gates, hn_g, skip, w_out,
                  C0, n0, m0, conv0):
    E, H, DH = D_INNER, MLSTM_HEADS, MLSTM_HEAD_DIM
    f32 = jnp.float32
    proj = xn @ w_in
    xm, z = proj[..., :E], proj[..., E:]
    bsz, t_len, _ = xm.shape
    xpad = jnp.concatenate([conv0.astype(xm.dtype), xm], axis=1)
    xc = conv_b + sum(xpad[:, j:j + t_len] * conv_w[j] for j in range(CONV_W))
    xc = jax.nn.silu(xc)
    new_conv = xpad[:, -(CONV_W - 1):]

    def blockdiag(a, w):
        a = a.reshape(bsz, t_len, QKV_NBLK, QKV_BLOCK)
        return jnp.einsum('btni,nio->btno', a, w).reshape(bsz, t_len, E)

    q, k, v = blockdiag(xc, wq), blockdiag(xc, wk), blockdiag(xm, wv)
    gates = (jnp.concatenate([q, k, v], axis=-1) @ w_gates + b_gates).astype(f32)
    ig = gates[..., :H]
    lf = jax.nn.log_sigmoid(gates[..., H:])

    def heads(a):
        return a.reshape(bsz, t_len, H, DH).transpose(0, 2, 1, 3).astype(f32)

    qh, kh, vh = heads(q), heads(k) * (DH ** -0.5), heads(v)
    igh, lfh = ig.transpose(0, 2, 1), lf.transpose(0, 2, 1)
    L = min(t_len, CHUNK)
    nc = t_len // L

    def chunks(a):
        return jnp.moveaxis(a.reshape(a.shape[:2] + (nc, L) + a.shape[3:]), 2, 0)

    (C, n, m), h = lax.scan(_mlstm_chunk, (C0.astype(f32), n0.astype(f32), m0.astype(f32)),
                            (chunks(qh), chunks(kh), chunks(vh), chunks(igh), chunks(lfh)))
    h = jnp.moveaxis(h, 0, 2).reshape(bsz, H, t_len, DH).transpose(0, 2, 1, 3)
    h = _layernorm(h, hn_g.reshape(H, DH)).reshape(bsz, t_len, E).astype(xm.dtype)
    out = (h + skip * xc) * jax.nn.silu(z)
    return out @ w_out, (C, n, m, new_conv)


def setup_inputs(seed: int = 0) -> dict:
    key = jax.random.key(seed)
    ks = jax.random.split(key, 32)
    E, H, DH, D = D_INNER, MLSTM_HEADS, MLSTM_HEAD_DIM, D_MODEL

    def nrm(k, shape, scale):
        return scale * jax.random.normal(k, shape, jnp.float32)

    f_bias = jnp.broadcast_to(jnp.linspace(3.0, 6.0, H, dtype=jnp.float32), (N_B, H))
    b_gates = jnp.concatenate([nrm(ks[20], (N_B, H), 0.1), f_bias + nrm(ks[21], (N_B, H), 0.1)], axis=-1)
    return {
        'x_prompt': nrm(ks[0], (BATCH, SEQ, D), 1.0),
        'x_sample': nrm(ks[1], (DEC_BATCH, DEC_SEQ, D), 1.0),
        'state_mlstm_C': nrm(ks[2], (N_B, DEC_BATCH, H, DH, DH), 0.05),
        'state_mlstm_n': nrm(ks[3], (N_B, DEC_BATCH, H, DH), 0.1),
        'state_mlstm_m': nrm(ks[4], (N_B, DEC_BATCH, H), 1.0),
        'state_mlstm_conv': nrm(ks[5], (N_B, DEC_BATCH, CONV_W - 1, E), 1.0),
        'norm_g': 1.0 + nrm(ks[6], (DEPTH, D), 0.05),
        'final_norm_g': 1.0 + nrm(ks[7], (D,), 0.05),
        'a_w_in': nrm(ks[8], (N_A, D, 3 * E), D ** -0.5),
        'a_ln_g': 1.0 + nrm(ks[9], (N_A, E), 0.05),
        'a_ln_b': nrm(ks[10], (N_A, E), 0.02),
        'a_w_s': nrm(ks[11], (N_A, SGU_GROUPS, SGU_CHUNK, SGU_CHUNK), 0.5 * SGU_CHUNK ** -0.5),
        'a_b_s': 1.0 + nrm(ks[12], (N_A, SGU_GROUPS, SGU_CHUNK), 0.1),
        'a_w_out': nrm(ks[13], (N_A, E, D), E ** -0.5),
        'b_w_in': nrm(ks[14], (N_B, D, 2 * E), D ** -0.5),
        'b_conv_w': nrm(ks[15], (N_B, CONV_W, E), CONV_W ** -0.5),
        'b_conv_b': nrm(ks[16], (N_B, E), 0.02),
        'b_wq': nrm(ks[17], (N_B, QKV_NBLK, QKV_BLOCK, QKV_BLOCK), QKV_BLOCK ** -0.5),
        'b_wk': nrm(ks[18], (N_B, QKV_NBLK, QKV_BLOCK, QKV_BLOCK), QKV_BLOCK ** -0.5),
        'b_wv': nrm(ks[19], (N_B, QKV_NBLK, QKV_BLOCK, QKV_BLOCK), QKV_BLOCK ** -0.5),
        'b_w_gates': nrm(ks[22], (N_B, 3 * E, 2 * H), (3 * E) ** -0.5),
        'b_b_gates': b_gates,
        'b_hnorm_g': 1.0 + nrm(ks[23], (N_B, E), 0.05),
        'b_skip': 1.0 + nrm(ks[24], (N_B, E), 0.05),
        'b_w_out': nrm(ks[25], (N_B, E, D), E ** -0.5),
    }


def reference(x_prompt, x_sample, state_mlstm_C, state_mlstm_n, state_mlstm_m, state_mlstm_conv,
              norm_g, final_norm_g, a_w_in, a_ln_g, a_ln_b, a_w_s, a_b_s, a_w_out,
              b_w_in, b_conv_w, b_conv_b, b_wq, b_wk, b_wv, b_w_gates, b_b_gates,
              b_hnorm_g, b_skip, b_w_out):
    E, H, DH = D_INNER, MLSTM_HEADS, MLSTM_HEAD_DIM
    xp, xs = x_prompt, x_sample
    sgu_v = []
    p_C, p_n, p_m, p_conv = [], [], [], []
    s_C, s_n, s_m, s_conv = [], [], [], []
    for i in range(DEPTH):
        j = i // N_MIXERS
        if i % N_MIXERS == 0:
            wa = (a_w_in[j], a_ln_g[j], a_ln_b[j], a_w_s[j], a_b_s[j], a_w_out[j])
            yp, _ = _sgu_branch(_rmsnorm(xp, norm_g[i]), *wa, prompt=True)
            ys, vs = _sgu_branch(_rmsnorm(xs, norm_g[i]), *wa, prompt=False)
            xp = xp + yp
            xs = xs + ys
            sgu_v.append(vs)
        else:
            wb = (b_w_in[j], b_conv_w[j], b_conv_b[j], b_wq[j], b_wk[j], b_wv[j],
                  b_w_gates[j], b_b_gates[j], b_hnorm_g[j], b_skip[j], b_w_out[j])
            zC = jnp.zeros((BATCH, H, DH, DH), jnp.float32)
            zn = jnp.zeros((BATCH, H, DH), jnp.float32)
            zm = jnp.zeros((BATCH, H), jnp.float32)
            zconv = jnp.zeros((BATCH, CONV_W - 1, E), xp.dtype)
            yp, (c1, n1, m1, cv1) = _mlstm_branch(_rmsnorm(xp, norm_g[i]), *wb, zC, zn, zm, zconv)
            ys, (c2, n2, m2, cv2) = _mlstm_branch(_rmsnorm(xs, norm_g[i]), *wb, state_mlstm_C[j],
                                                  state_mlstm_n[j], state_mlstm_m[j], state_mlstm_conv[j])
            xp = xp + yp
            xs = xs + ys
            p_C.append(c1); p_n.append(n1); p_m.append(m1); p_conv.append(cv1)
            s_C.append(c2); s_n.append(n2); s_m.append(m2); s_conv.append(cv2)
    y_prompt = _rmsnorm(xp, final_norm_g)
    y_sample = _rmsnorm(xs, final_norm_g)
    sdt = state_mlstm_C.dtype
    sgu_v_sample = jnp.stack(sgu_v).astype(x_sample.dtype)
    C_prompt = jnp.stack(p_C).astype(sdt)
    n_prompt = jnp.stack(p_n).astype(state_mlstm_n.dtype)
    m_prompt = jnp.stack(p_m).astype(state_mlstm_m.dtype)
    conv_prompt = jnp.stack(p_conv).astype(state_mlstm_conv.dtype)
    C_sample = jnp.stack(s_C).astype(sdt)
    n_sample = jnp.stack(s_n).astype(state_mlstm_n.dtype)
    m_sample = jnp.stack(s_m).astype(state_mlstm_m.dtype)
    conv_sample = jnp.stack(s_conv).astype(state_mlstm_conv.dtype)
    return (y_prompt, y_sample, sgu_v_sample, C_prompt, n_prompt, m_prompt, conv_prompt,
            C_sample, n_sample, m_sample, conv_sample)
```

```cpp
#include <hip/hip_runtime.h>
#include <hip/hip_cooperative_groups.h>
#include <cstdio>
#include <cstdint>
namespace cg = cooperative_groups;

#ifndef MULTI_LAUNCH
#define MULTI_LAUNCH 0
#endif

typedef unsigned short bf16_t;
typedef short bf16x8 __attribute__((ext_vector_type(8)));
typedef float f32x16 __attribute__((ext_vector_type(16)));
typedef float f32x4 __attribute__((ext_vector_type(4)));
typedef float f32x2 __attribute__((ext_vector_type(2)));
typedef unsigned u32x4 __attribute__((ext_vector_type(4)));
typedef unsigned u32x2 __attribute__((ext_vector_type(2)));
#define DEV __device__ __forceinline__
#define MFMA32(a, b, c) __builtin_amdgcn_mfma_f32_32x32x16_bf16((a), (b), (c), 0, 0, 0)

constexpr int T = 16896, NP = 16384, DM = 1024, E = 2048, NBLK = 256;
constexpr int NPHASE = 11;
constexpr size_t SLOT = 69206016;
constexpr size_t OFF_A = 0;
constexpr size_t OFF_B = SLOT;
constexpr size_t OFF_C = 2 * SLOT;
constexpr size_t OFF_D = 3 * SLOT;
constexpr size_t OFF_E = 4 * SLOT;
constexpr size_t OFF_F = 5 * SLOT;
constexpr size_t OFF_W1 = 6 * SLOT;
constexpr size_t OFF_W2 = OFF_W1 + 12582912;
constexpr size_t OFF_W3 = OFF_W2 + 4194304;
constexpr size_t OFF_W4 = OFF_W3 + 8388608;
constexpr size_t OFF_WM = OFF_W4 + 4194304;
constexpr size_t OFF_WMS = OFF_WM + 262144;
constexpr size_t OFF_SW = OFF_WMS + 262144;
constexpr size_t OFF_VST = OFF_SW + 69206016;
constexpr size_t OFF_RS0 = OFF_VST + 4325376;
constexpr size_t OFF_SS1 = OFF_RS0 + 67584;
constexpr size_t OFF_SS2 = OFF_SS1 + 1081344;
constexpr size_t OFF_GB = OFF_SS2 + 1081344;
constexpr size_t OFF_GU = OFF_GB + 270336;
constexpr size_t OFF_GA = OFF_GU + 270336;
constexpr size_t OFF_WINTER = OFF_GA + 270336;
constexpr size_t OFF_WUPD = OFF_WINTER + 270336;
constexpr size_t OFF_DENI = OFF_WUPD + 270336;
constexpr size_t OFF_ENEGM = OFF_DENI + 270336;
constexpr size_t OFF_DINV = OFF_ENEGM + 270336;
constexpr size_t OFF_CHS = OFF_DINV + 270336;
constexpr size_t OFF_DECAY = OFF_CHS + 8192;
constexpr size_t OFF_GP = OFF_DECAY + 8192;
constexpr size_t OFF_BAR = OFF_GP + 1081344;
constexpr size_t OFF_GT = OFF_BAR + 16384;
constexpr size_t WS_END = OFF_GT + 524288;
constexpr size_t O_Y = 0;
constexpr size_t O_SGUV = 17301504;
constexpr size_t O_CP = 18350080;
constexpr size_t O_NP = 20447232;
constexpr size_t O_MP = 20451328;
constexpr size_t O_CONVP = 20451336;
constexpr size_t O_CS = 20463624;
constexpr size_t O_NS = 54018056;
constexpr size_t O_MS = 54083592;
constexpr size_t O_CONVS = 54083720;

struct Params {
  const float* in[25];
  float* out;
  char* ws;
  int ph_lo, ph_hi;
};

typedef __bf16 bf16v2 __attribute__((ext_vector_type(2)));
DEV unsigned cvt_pk_bf16(float lo, float hi) { f32x2 v = {lo, hi}; bf16v2 b = __builtin_convertvector(v, bf16v2); return __builtin_bit_cast(unsigned, b); }
DEV float bf_lo(unsigned u) { return __uint_as_float(u << 16); }
DEV float bf_hi(unsigned u) { return __uint_as_float(u & 0xffff0000u); }
DEV float bf1(bf16_t b) { return __uint_as_float(((unsigned)b) << 16); }
DEV bf16_t f2bf(float x) { return (bf16_t)(cvt_pk_bf16(x, 0.f) & 0xffffu); }
DEV float sigmoidf_(float x) { return __builtin_amdgcn_rcpf(1.f + __builtin_amdgcn_exp2f(-1.4426950408889634f * x)); }
DEV float siluf_(float x) { return x * __builtin_amdgcn_rcpf(1.f + __builtin_amdgcn_exp2f(-1.4426950408889634f * x)); }
DEV float geluf_(float x) { const float x2 = x * x; const float t = x * (-2.302208198092545f - 0.10294324517f * x2); return x * __builtin_amdgcn_rcpf(1.f + __builtin_amdgcn_exp2f(t)); }
DEV int crow(int reg, int h) { return (reg & 3) + 8 * (reg >> 2) + 4 * h; }
DEV float wave_sum(float v) {
#pragma unroll
  for (int o = 1; o < 64; o <<= 1) v += __shfl_xor(v, o);
  return v;
}
DEV bf16x8 as_bf16x8(u32x4 v) { return __builtin_bit_cast(bf16x8, v); }

DEV void transpose_tile(const float* __restrict__ W, int K, int N, const float* __restrict__ gain, bf16_t* __restrict__ WT, int tile, float* scr) {
  const int tid = threadIdx.x;
  const int ntn = N / 64, kb = tile / ntn, nb = tile % ntn, k0 = kb * 64, n0 = nb * 64;
#pragma unroll
  for (int j = 0; j < 4; ++j) {
    const int c = tid + 256 * j, r = c >> 4, c4 = (c & 15) * 4;
    f32x4 v = *(const f32x4*)(W + (size_t)(k0 + r) * N + n0 + c4);
    const float g = gain ? gain[k0 + r] : 1.f;
    scr[r * 65 + c4 + 0] = v.x * g; scr[r * 65 + c4 + 1] = v.y * g; scr[r * 65 + c4 + 2] = v.z * g; scr[r * 65 + c4 + 3] = v.w * g;
  }
  __syncthreads();
  {
    const int n = tid >> 2, ks = (tid & 3) * 16;
    u32x4 o0, o1;
    const float* s = scr + ks * 65 + n;
    o0.x = cvt_pk_bf16(s[0 * 65], s[1 * 65]); o0.y = cvt_pk_bf16(s[2 * 65], s[3 * 65]); o0.z = cvt_pk_bf16(s[4 * 65], s[5 * 65]); o0.w = cvt_pk_bf16(s[6 * 65], s[7 * 65]);
    o1.x = cvt_pk_bf16(s[8 * 65], s[9 * 65]); o1.y = cvt_pk_bf16(s[10 * 65], s[11 * 65]); o1.z = cvt_pk_bf16(s[12 * 65], s[13 * 65]); o1.w = cvt_pk_bf16(s[14 * 65], s[15 * 65]);
    bf16_t* dst = WT + (size_t)(n0 + n) * K + k0 + ks;
    *(u32x4*)dst = o0; *(u32x4*)(dst + 8) = o1;
  }
  __syncthreads();
}

DEV void phase0(const Params& p, char* smem) {
  float* scr = (float*)smem;
  const int nb = gridDim.x, bid = blockIdx.x, tid = threadIdx.x;
  bf16_t* W1 = (bf16_t*)(p.ws + OFF_W1); bf16_t* W2 = (bf16_t*)(p.ws + OFF_W2); bf16_t* W3 = (bf16_t*)(p.ws + OFF_W3); bf16_t* W4 = (bf16_t*)(p.ws + OFF_W4);
  constexpr int T1 = 16 * 96, T2 = 32 * 16, T3 = 16 * 64, T4 = 32 * 16;
  for (int it = bid; it < T1 + T2 + T3 + T4; it += nb) {
    int r = it;
    if (r < T1) { transpose_tile(p.in[8], 1024, 6144, p.in[6], W1, r, scr); continue; } r -= T1;
    if (r < T2) { transpose_tile(p.in[13], 2048, 1024, nullptr, W2, r, scr); continue; } r -= T2;
    if (r < T3) { transpose_tile(p.in[14], 1024, 4096, p.in[6] + 1024, W3, r, scr); continue; } r -= T3;
    transpose_tile(p.in[24], 2048, 1024, nullptr, W4, r, scr);
  }
  {
    bf16_t* XB = (bf16_t*)(p.ws + OFF_E); float* RS0 = (float*)(p.ws + OFF_RS0);
    const int lane = tid & 63, wid = tid >> 6;
    for (int row = bid * 4 + wid; row < T; row += nb * 4) {
      const float* xr = row < NP ? p.in[0] + (size_t)row * DM : p.in[1] + (size_t)(row - NP) * DM;
      f32x4 v[4]; float ss = 0.f;
#pragma unroll
      for (int j = 0; j < 4; ++j) { v[j] = *(const f32x4*)(xr + j * 256 + lane * 4); ss += v[j].x * v[j].x + v[j].y * v[j].y + v[j].z * v[j].z + v[j].w * v[j].w; }
      ss = wave_sum(ss);
#pragma unroll
      for (int j = 0; j < 4; ++j) { u32x2 o; o.x = cvt_pk_bf16(v[j].x, v[j].y); o.y = cvt_pk_bf16(v[j].z, v[j].w); *(u32x2*)(XB + (size_t)row * DM + j * 256 + lane * 4) = o; }
      if (lane == 0) RS0[row] = rsqrtf(ss * (1.f / DM) + 1e-6f);
    }
  }
  {
    bf16_t* GT = (bf16_t*)(p.ws + OFF_GT);
    const float* wq = p.in[17]; const float* wk = p.in[18]; const float* wv = p.in[19]; const float* wgt = p.in[20];
    for (int idx = bid * 256 + tid; idx < 32 * 4096; idx += nb * 256) {
      const int j = idx >> 12, k = idx & 4095;
      bf16_t hi = 0, lo = 0;
      if (j < 8) {
        const int part = k >> 11, ch = k & 2047, nbk = ch >> 2, i = ch & 3, cb4 = ch & ~3;
        float g = 0.f;
#pragma unroll
        for (int o = 0; o < 4; ++o) {
          if (part == 0) g += wq[nbk * 16 + i * 4 + o] * wgt[(size_t)(cb4 + o) * 8 + j] + wk[nbk * 16 + i * 4 + o] * wgt[(size_t)(E + cb4 + o) * 8 + j];
          else g += wv[nbk * 16 + i * 4 + o] * wgt[(size_t)(2 * E + cb4 + o) * 8 + j];
        }
        hi = f2bf(g); lo = f2bf(g - bf1(hi));
      }
      GT[(size_t)j * 4096 + k] = hi; GT[(size_t)(32 + j) * 4096 + k] = lo;
    }
  }
  {
    bf16_t* WM = (bf16_t*)(p.ws + OFF_WM); bf16_t* WMS = (bf16_t*)(p.ws + OFF_WMS);
    const float* ws_ = p.in[11];
    for (int i = bid * 256 + tid; i < 8 * 128 * 128; i += nb * 256) {
      const int g = i >> 14, t = (i >> 7) & 127, s = i & 127;
      WM[i] = f2bf(s <= t ? ws_[i] : 0.f);
      const int tl = t & 15, sl = s & 15;
      WMS[i] = f2bf(((t >> 4) == (s >> 4) && sl <= tl) ? ws_[(g << 14) + tl * 128 + sl] : 0.f);
    }
  }
}

constexpr int LDS_ST = 72;
constexpr int TILE_E = 128 * LDS_ST;

constexpr int TILE_G = 128 * 64;

template <int MI, class Epi>
DEV void gemm_tile(const bf16_t* __restrict__ X, const bf16_t* __restrict__ W, const int K, const int row0, const int col0, const Epi& epi, bf16_t* sm) {
  int tid_ = threadIdx.x; asm volatile("" : "+v"(tid_));
  const int tid = tid_, lane = tid & 63, wid = tid >> 6, wr = wid >> 1, wc = wid & 1;
  const int l31 = lane & 31, hh = lane >> 5;
  bf16_t* sa = sm; bf16_t* sb = sm + 2 * TILE_G;
  f32x16 acc[MI][2];
#pragma unroll
  for (int a = 0; a < MI; ++a)
#pragma unroll
    for (int b = 0; b < 2; ++b)
#pragma unroll
      for (int i = 0; i < 16; ++i) acc[a][b][i] = 0.f;
  const int srow = wid * 8 + (lane >> 3);
  const int sc8 = ((lane & 7) ^ (((wid & 1) << 2) | (lane >> 4))) * 8;
  const bf16_t* xp = X + (size_t)(row0 + srow) * K + sc8;
  const bf16_t* wp = W + (size_t)(col0 + srow) * K + sc8;
  const int sdst = wid * 8 * 64 + lane * 8;
#define GEMM_STAGE(bufi, k0) do { _Pragma("unroll") for (int j = 0; j < 4; ++j) { \
      if (j < 2 * MI) __builtin_amdgcn_global_load_lds((const unsigned*)(xp + (size_t)(32 * j) * K + (k0)), (unsigned*)(sa + (bufi) * TILE_G + sdst + j * 2048), 16, 0, 0); \
      __builtin_amdgcn_global_load_lds((const unsigned*)(wp + (size_t)(32 * j) * K + (k0)), (unsigned*)(sb + (bufi) * TILE_G + sdst + j * 2048), 16, 0, 0); } } while (0)
  GEMM_STAGE(0, 0); GEMM_STAGE(1, 64);
  const int swz = (l31 >> 1) & 7;
  int koff[4];
#pragma unroll
  for (int kk = 0; kk < 4; ++kk) koff[kk] = ((2 * kk + hh) ^ swz) * 8;
  const int nk = K >> 6;
  for (int kt = 0; kt < nk; ++kt) {
    const int buf = kt & 1;
    if (kt + 1 < nk) { if (MI == 2) asm volatile("s_waitcnt vmcnt(8)" ::: "memory"); else asm volatile("s_waitcnt vmcnt(6)" ::: "memory"); }
    else asm volatile("s_waitcnt vmcnt(0)" ::: "memory");
    __builtin_amdgcn_s_barrier();
    const bf16_t* ca = sa + buf * TILE_G + (wr * 32 * MI + l31) * 64;
    const bf16_t* cb = sb + buf * TILE_G + (wc * 64 + l31) * 64;
    bf16x8 fa[4][MI], fb[4][2];
#pragma unroll
    for (int kk = 0; kk < 4; ++kk) {
#pragma unroll
      for (int mi = 0; mi < MI; ++mi) fa[kk][mi] = *(const bf16x8*)(ca + mi * 32 * 64 + koff[kk]);
      fb[kk][0] = *(const bf16x8*)(cb + koff[kk]); fb[kk][1] = *(const bf16x8*)(cb + 32 * 64 + koff[kk]);
    }
    asm volatile("s_waitcnt lgkmcnt(0)" ::: "memory");
    __builtin_amdgcn_s_barrier();
    if (kt + 2 < nk) GEMM_STAGE(buf, (kt + 2) * 64);
    __builtin_amdgcn_sched_barrier(0);
#pragma unroll
    for (int kk = 0; kk < 4; ++kk)
#pragma unroll
      for (int mi = 0; mi < MI; ++mi) {
        acc[mi][0] = MFMA32(fb[kk][0], fa[kk][mi], acc[mi][0]); acc[mi][1] = MFMA32(fb[kk][1], fa[kk][mi], acc[mi][1]);
      }
  }
#undef GEMM_STAGE
  epi.template run<MI>(acc, row0 + wr * 32 * MI, col0 + wc * 64, l31, hh);
}

template <class Epi>
DEV void gemm_phase(const bf16_t* X, const bf16_t* W, int N, int K, const Epi& epi, bf16_t* sm, bool half_tail = false) {
  const int ntn = N / 128, ntm = T / 128, nt = ntn * ntm;
  const int rem = nt % (int)gridDim.x;
  const int full_rows = (half_tail && rem > 0 && rem % ntn == 0) ? ntm - rem / ntn : ntm;
  for (int t = blockIdx.x; t < full_rows * ntn; t += gridDim.x) {
    const int tm = t / ntn, tn = t % ntn;
    gemm_tile<2>(X, W, K, tm * 128, tn * 128, epi, sm);
  }
  if (full_rows < ntm) {
    for (int t = blockIdx.x; t < (ntm - full_rows) * 2 * ntn; t += gridDim.x) {
      const int tmh = t / ntn, tn = t % ntn;
      gemm_tile<1>(X, W, K, full_rows * 128 + tmh * 64, tn * 128, epi, sm);
    }
  }
}

struct Epi1 {
  const float* rs0; bf16_t* U; bf16_t* VT; bf16_t* Z; float* VST;
  template <int MI> DEV void run(const f32x16 (&acc)[MI][2], int rbase, int cbase, int l31, int hh) const {
    const float rr[2] = {rs0[rbase + l31], rs0[rbase + 32 + l31]};
#pragma unroll
    for (int mi = 0; mi < MI; ++mi) {
      const int tok = rbase + mi * 32 + l31;
      const float r = rr[mi];
      if (cbase < 2048) {
#pragma unroll
        for (int ni = 0; ni < 2; ++ni)
#pragma unroll
          for (int g = 0; g < 4; ++g) {
            const int ch = cbase + ni * 32 + 8 * g + 4 * hh;
            u32x2 o; o.x = cvt_pk_bf16(geluf_(acc[mi][ni][4 * g] * r), geluf_(acc[mi][ni][4 * g + 1] * r));
            o.y = cvt_pk_bf16(geluf_(acc[mi][ni][4 * g + 2] * r), geluf_(acc[mi][ni][4 * g + 3] * r));
            *(u32x2*)(U + (size_t)tok * E + ch) = o;
          }
      } else if (cbase < 4096) {
        float s = 0.f, ss = 0.f;
#pragma unroll
        for (int ni = 0; ni < 2; ++ni)
#pragma unroll
          for (int i = 0; i < 16; ++i) {
            const int ch = cbase - 2048 + ni * 32 + crow(i, hh);
            const float v = geluf_(acc[mi][ni][i] * r);
            s += v; ss += v * v;
            VT[(size_t)ch * T + tok] = f2bf(v);
          }
        s += __shfl_xor(s, 32); ss += __shfl_xor(ss, 32);
        if (hh == 0) { f32x2 o; o.x = s; o.y = ss; *(f32x2*)(VST + ((size_t)tok * 32 + ((cbase - 2048) >> 6)) * 2) = o; }
      } else {
#pragma unroll
        for (int ni = 0; ni < 2; ++ni)
#pragma unroll
          for (int g = 0; g < 4; ++g) {
            const int ch = cbase - 4096 + ni * 32 + 8 * g + 4 * hh;
            u32x2 o; o.x = cvt_pk_bf16(acc[mi][ni][4 * g] * r, acc[mi][ni][4 * g + 1] * r);
            o.y = cvt_pk_bf16(acc[mi][ni][4 * g + 2] * r, acc[mi][ni][4 * g + 3] * r);
            *(u32x2*)(Z + (size_t)tok * E + ch) = o;
          }
      }
    }
  }
};

struct EpiRes {
  const float* res_p; const float* res_s;
  float* OUT; bf16_t* OUTB; float* SS;
  template <int MI> DEV void run(const f32x16 (&acc)[MI][2], int rbase, int cbase, int l31, int hh) const {
#pragma unroll
    for (int mi = 0; mi < MI; ++mi) {
      const int tok = rbase + mi * 32 + l31;
      const float* rp = tok < NP ? res_p + (size_t)tok * DM : res_s + (size_t)(tok - NP) * DM;
      f32x4 rva[2][4];
#pragma unroll
      for (int ni = 0; ni < 2; ++ni)
#pragma unroll
        for (int g = 0; g < 4; ++g) rva[ni][g] = *(const f32x4*)(rp + cbase + ni * 32 + 8 * g + 4 * hh);
      float ss = 0.f;
#pragma unroll
      for (int ni = 0; ni < 2; ++ni)
#pragma unroll
        for (int g = 0; g < 4; ++g) {
          const int ch = cbase + ni * 32 + 8 * g + 4 * hh;
          const f32x4 rv = rva[ni][g];
          f32x4 o; o.x = acc[mi][ni][4 * g] + rv.x; o.y = acc[mi][ni][4 * g + 1] + rv.y; o.z = acc[mi][ni][4 * g + 2] + rv.z; o.w = acc[mi][ni][4 * g + 3] + rv.w;
          ss += o.x * o.x + o.y * o.y + o.z * o.z + o.w * o.w;
          *(f32x4*)(OUT + (size_t)tok * DM + ch) = o;
          if (OUTB) { u32x2 b; b.x = cvt_pk_bf16(o.x, o.y); b.y = cvt_pk_bf16(o.z, o.w); *(u32x2*)(OUTB + (size_t)tok * DM + ch) = b; }
        }
      ss += __shfl_xor(ss, 32);
      if (hh == 0) SS[(size_t)tok * 16 + (cbase >> 6)] = ss;
    }
  }
};

struct Epi3 {
  const float* SS1; bf16_t* XM; bf16_t* Z2;
  template <int MI> DEV void run(const f32x16 (&acc)[MI][2], int rbase, int cbase, int l31, int hh) const {
    float sums[2];
#pragma unroll
    for (int mi = 0; mi < MI; ++mi) {
      float s = 0.f;
#pragma unroll
      for (int j = 0; j < 4; ++j) { const f32x4 v = *(const f32x4*)(SS1 + (size_t)(rbase + mi * 32 + l31) * 16 + 4 * j); s += v.x + v.y + v.z + v.w; }
      sums[mi] = s;
    }
#pragma unroll
    for (int mi = 0; mi < MI; ++mi) {
      const int tok = rbase + mi * 32 + l31;
      const float r = rsqrtf(sums[mi] * (1.f / DM) + 1e-6f);
      bf16_t* dst = cbase < 2048 ? XM + (size_t)tok * E + cbase : Z2 + (size_t)tok * E + cbase - 2048;
#pragma unroll
      for (int ni = 0; ni < 2; ++ni)
#pragma unroll
        for (int g = 0; g < 4; ++g) {
          u32x2 o; o.x = cvt_pk_bf16(acc[mi][ni][4 * g] * r, acc[mi][ni][4 * g + 1] * r);
          o.y = cvt_pk_bf16(acc[mi][ni][4 * g + 2] * r, acc[mi][ni][4 * g + 3] * r);
          *(u32x2*)(dst + ni * 32 + 8 * g + 4 * hh) = o;
        }
    }
  }
};

DEV void sgu_phase(const Params& p, char* smem) {
  const int tid = threadIdx.x, lane = tid & 63, wid = tid >> 6, l31 = lane & 31, hh = lane >> 5;
  float* smu = (float*)smem; float* srs = smu + 128;
  const bf16_t* U = (const bf16_t*)(p.ws + OFF_A); const bf16_t* VT = (const bf16_t*)(p.ws + OFF_B); const bf16_t* Z = (const bf16_t*)(p.ws + OFF_C);
  bf16_t* G = (bf16_t*)(p.ws + OFF_D);
  const float* VST = (const float*)(p.ws + OFF_VST);
  const float* lng = p.in[9]; const float* lnb = p.in[10]; const float* bs = p.in[12];
  for (int unit = blockIdx.x; unit < 132 * 8; unit += gridDim.x) {
    const int ci = unit >> 3, g = unit & 7, tok0 = ci * 128;
    const bool samp = ci >= 128;
    const bf16_t* WMg = (const bf16_t*)(p.ws + (samp ? OFF_WMS : OFF_WM)) + g * 16384;
    __syncthreads();
    if (tid < 128) {
      float s = 0.f, ss = 0.f;
      const f32x4* q = (const f32x4*)(VST + (size_t)(tok0 + tid) * 64);
#pragma unroll
      for (int j = 0; j < 16; ++j) { const f32x4 v = q[j]; s += v.x + v.z; ss += v.y + v.w; }
      const float mean = s * (1.f / E); const float var = ss * (1.f / E) - mean * mean;
      smu[tid] = mean; srs[tid] = rsqrtf(var + 1e-5f);
    }
    __syncthreads();
    const int cbase = g * 256 + wid * 64;
    bf16x8 af[2][8];
#pragma unroll
    for (int mi = 0; mi < 2; ++mi) {
      const int c = cbase + mi * 32 + l31;
      const float gg = lng[c], bb = lnb[c];
      u32x4 raws[8];
#pragma unroll
      for (int kk = 0; kk < 8; ++kk) raws[kk] = *(const u32x4*)(VT + (size_t)c * T + tok0 + kk * 16 + 8 * hh);
      __builtin_amdgcn_sched_barrier(0);
#pragma unroll
      for (int kk = 0; kk < 8; ++kk) {
        const int s0 = kk * 16 + 8 * hh;
        const u32x4 raw = raws[kk];
        const f32x4 m0 = *(const f32x4*)(smu + s0), m1 = *(const f32x4*)(smu + s0 + 4);
        const f32x4 r0 = *(const f32x4*)(srs + s0), r1 = *(const f32x4*)(srs + s0 + 4);
        float v[8];
        v[0] = (bf_lo(raw.x) - m0.x) * r0.x * gg + bb; v[1] = (bf_hi(raw.x) - m0.y) * r0.y * gg + bb;
        v[2] = (bf_lo(raw.y) - m0.z) * r0.z * gg + bb; v[3] = (bf_hi(raw.y) - m0.w) * r0.w * gg + bb;
        v[4] = (bf_lo(raw.z) - m1.x) * r1.x * gg + bb; v[5] = (bf_hi(raw.z) - m1.y) * r1.y * gg + bb;
        v[6] = (bf_lo(raw.w) - m1.z) * r1.z * gg + bb; v[7] = (bf_hi(raw.w) - m1.w) * r1.w * gg + bb;
        u32x4 pk; pk.x = cvt_pk_bf16(v[0], v[1]); pk.y = cvt_pk_bf16(v[2], v[3]); pk.z = cvt_pk_bf16(v[4], v[5]); pk.w = cvt_pk_bf16(v[6], v[7]);
        af[mi][kk] = as_bf16x8(pk);
        if (samp) {
          float* sv = p.out + O_SGUV + (size_t)(tok0 - NP + s0) * E + c;
#pragma unroll
          for (int j = 0; j < 8; ++j) sv[(size_t)j * E] = v[j];
        }
      }
    }
#pragma unroll
    for (int nt = 0; nt < 4; ++nt) {
      f32x16 acc[2];
#pragma unroll
      for (int i = 0; i < 16; ++i) { acc[0][i] = 0.f; acc[1][i] = 0.f; }
      const int tl = nt * 32 + l31;
      u32x4 bfrs[8];
#pragma unroll
      for (int kk = 0; kk < 8; ++kk) if (kk <= 2 * nt + 1) bfrs[kk] = *(const u32x4*)(WMg + tl * 128 + kk * 16 + 8 * hh);
      __builtin_amdgcn_sched_barrier(0);
#pragma unroll
      for (int kk = 0; kk < 8; ++kk) {
        if (kk <= 2 * nt + 1) {
          acc[0] = MFMA32(af[0][kk], as_bf16x8(bfrs[kk]), acc[0]);
          acc[1] = MFMA32(af[1][kk], as_bf16x8(bfrs[kk]), acc[1]);
        }
      }
      const int tok = tok0 + tl;
      const float bias = bs[g * 128 + (samp ? (tl & 15) : tl)];
      u32x2 uus[2][4], zzs[2][4];
#pragma unroll
      for (int mi = 0; mi < 2; ++mi)
#pragma unroll
        for (int q = 0; q < 4; ++q) {
          const int c = cbase + mi * 32 + 8 * q + 4 * hh;
          uus[mi][q] = *(const u32x2*)(U + (size_t)tok * E + c);
          zzs[mi][q] = *(const u32x2*)(Z + (size_t)tok * E + c);
        }
#pragma unroll
      for (int mi = 0; mi < 2; ++mi)
#pragma unroll
        for (int q = 0; q < 4; ++q) {
          const int c = cbase + mi * 32 + 8 * q + 4 * hh;
          const u32x2 uu = uus[mi][q];
          const u32x2 zz = zzs[mi][q];
          const float o0 = bf_lo(uu.x) * (acc[mi][4 * q] + bias) * siluf_(bf_lo(zz.x));
          const float o1 = bf_hi(uu.x) * (acc[mi][4 * q + 1] + bias) * siluf_(bf_hi(zz.x));
          const float o2 = bf_lo(uu.y) * (acc[mi][4 * q + 2] + bias) * siluf_(bf_lo(zz.y));
          const float o3 = bf_hi(uu.y) * (acc[mi][4 * q + 3] + bias) * siluf_(bf_hi(zz.y));
          u32x2 o; o.x = cvt_pk_bf16(o0, o1); o.y = cvt_pk_bf16(o2, o3);
          *(u32x2*)(G + (size_t)tok * E + c) = o;
        }
    }
  }
}

DEV int perm4(int g) { return ((g & 1) << 1) | (g >> 1); }

struct ConvHist { float x1[4], x2[4], x3[4]; };
DEV void conv_hist_init(ConvHist& H, const bf16_t* XM, const float* conv0, int t, int tt, int pos, bool samp, int ch) {
  if (pos == 0) {
    if (samp) {
      const float* c0 = conv0 + (size_t)((t - NP) >> 4) * 3 * E + ch;
      const f32x4 a = *(const f32x4*)(c0), b = *(const f32x4*)(c0 + E), c = *(const f32x4*)(c0 + 2 * E);
      H.x3[0] = a.x; H.x3[1] = a.y; H.x3[2] = a.z; H.x3[3] = a.w; H.x2[0] = b.x; H.x2[1] = b.y; H.x2[2] = b.z; H.x2[3] = b.w; H.x1[0] = c.x; H.x1[1] = c.y; H.x1[2] = c.z; H.x1[3] = c.w;
    } else {
#pragma unroll
      for (int i = 0; i < 4; ++i) { H.x1[i] = 0.f; H.x2[i] = 0.f; H.x3[i] = 0.f; }
    }
  } else if (tt == 0) {
    const u32x2 a = *(const u32x2*)(XM + (size_t)(t - 1) * E + ch), b = *(const u32x2*)(XM + (size_t)(t - 2) * E + ch), c = *(const u32x2*)(XM + (size_t)(t - 3) * E + ch);
    H.x1[0] = bf_lo(a.x); H.x1[1] = bf_hi(a.x); H.x1[2] = bf_lo(a.y); H.x1[3] = bf_hi(a.y);
    H.x2[0] = bf_lo(b.x); H.x2[1] = bf_hi(b.x); H.x2[2] = bf_lo(b.y); H.x2[3] = bf_hi(b.y);
    H.x3[0] = bf_lo(c.x); H.x3[1] = bf_hi(c.x); H.x3[2] = bf_lo(c.y); H.x3[3] = bf_hi(c.y);
  }
}

DEV float reduce16(float (&r16)[16], int lane) {
#pragma unroll
  for (int i = 0; i < 8; ++i) { const bool up = lane & 8; const float send = up ? r16[i] : r16[i + 8]; const float keep = up ? r16[i + 8] : r16[i]; r16[i] = keep + __shfl_xor(send, 8); }
#pragma unroll
  for (int i = 0; i < 4; ++i) { const bool up = lane & 4; const float send = up ? r16[i] : r16[i + 4]; const float keep = up ? r16[i + 4] : r16[i]; r16[i] = keep + __shfl_xor(send, 4); }
#pragma unroll
  for (int i = 0; i < 2; ++i) { const bool up = lane & 2; const float send = up ? r16[i] : r16[i + 2]; const float keep = up ? r16[i + 2] : r16[i]; r16[i] = keep + __shfl_xor(send, 2); }
  { const bool up = lane & 1; const float send = up ? r16[0] : r16[1]; const float keep = up ? r16[1] : r16[0]; r16[0] = keep + __shfl_xor(send, 1); }
  float tot = r16[0];
  tot += __shfl_xor(tot, 16); tot += __shfl_xor(tot, 32);
  return tot;
}

DEV void conv_phase(const Params& p, char* smem) {
  const int tid = threadIdx.x;
  const bf16_t* XM = (const bf16_t*)(p.ws + OFF_B);
  bf16_t* XC = (bf16_t*)(p.ws + OFF_D); bf16_t* QF = (bf16_t*)(p.ws + OFF_E); bf16_t* VF = (bf16_t*)(p.ws + OFF_F);
  bf16_t* KF = (bf16_t*)(p.out + O_CS); bf16_t* KTF = (bf16_t*)(p.out + O_Y);
  const float* conv0 = p.in[5]; const float* convw = p.in[15]; const float* convb = p.in[16];
  const float* wq = p.in[17]; const float* wk = p.in[18]; const float* wv = p.in[19];
  const float kscale = 0.04419417382415922f;
  bf16_t* QS = (bf16_t*)(smem + 4096); bf16_t* KS = QS + 128 * 136;
  for (int unit = blockIdx.x; unit < (T / 16) * 2; unit += gridDim.x) {
    const int hf = unit & 1, tok0 = (unit >> 1) * 16, cg = tok0 >> 6, tt0 = tok0 & 63;
    const bool samp = tok0 >= NP;
    const int nb = hf * 256 + tid, ch = nb * 4, h = nb >> 7, nl = nb & 127;
    const int pd = (nl & ~3) * 4 + perm4(nl & 3) * 4, kstep = pd >> 4, hhq = (pd >> 3) & 1, j0 = pd & 7;
    float cw[4][4], cb[4], q_w[4][4], k_w[4][4], v_w[4][4];
#pragma unroll
    for (int j = 0; j < 4; ++j) { const f32x4 v = *(const f32x4*)(convw + j * E + ch); cw[j][0] = v.x; cw[j][1] = v.y; cw[j][2] = v.z; cw[j][3] = v.w; }
    { const f32x4 v = *(const f32x4*)(convb + ch); cb[0] = v.x; cb[1] = v.y; cb[2] = v.z; cb[3] = v.w; }
#pragma unroll
    for (int i = 0; i < 4; ++i) {
      const f32x4 a = *(const f32x4*)(wq + nb * 16 + i * 4), b = *(const f32x4*)(wk + nb * 16 + i * 4), c = *(const f32x4*)(wv + nb * 16 + i * 4);
      q_w[i][0] = a.x; q_w[i][1] = a.y; q_w[i][2] = a.z; q_w[i][3] = a.w;
      k_w[i][0] = b.x * kscale; k_w[i][1] = b.y * kscale; k_w[i][2] = b.z * kscale; k_w[i][3] = b.w * kscale;
      v_w[i][0] = c.x; v_w[i][1] = c.y; v_w[i][2] = c.z; v_w[i][3] = c.w;
    }
    u32x2 xrow[16];
#pragma unroll
    for (int i = 0; i < 16; ++i) xrow[i] = *(const u32x2*)(XM + (size_t)(tok0 + i) * E + ch);
    __syncthreads();
    ConvHist H;
    const int srun = (((tid >> 7) * 32 + kstep) * 2 + hhq) * 136 + j0;
#pragma unroll
    for (int tb8 = 0; tb8 < 2; ++tb8) {
      unsigned kacc[4][4], vacc[4][4];
#pragma unroll
      for (int pr = 0; pr < 4; ++pr) {
        float kq[2][4], vq[2][4];
#pragma unroll
        for (int u = 0; u < 2; ++u) {
          const int ttl = tb8 * 8 + pr * 2 + u, t = tok0 + ttl;
          const int pos = samp ? ttl : (t & 8191);
          conv_hist_init(H, XM, conv0, t, ttl, pos, samp, ch);
          const u32x2 xr = xrow[ttl];
          float x0[4] = {bf_lo(xr.x), bf_hi(xr.x), bf_lo(xr.y), bf_hi(xr.y)};
          float xc[4];
#pragma unroll
          for (int i = 0; i < 4; ++i) xc[i] = siluf_(cb[i] + cw[0][i] * H.x3[i] + cw[1][i] * H.x2[i] + cw[2][i] * H.x1[i] + cw[3][i] * x0[i]);
          float qv[4];
#pragma unroll
          for (int o = 0; o < 4; ++o) {
            qv[o] = xc[0] * q_w[0][o] + xc[1] * q_w[1][o] + xc[2] * q_w[2][o] + xc[3] * q_w[3][o];
            kq[u][o] = xc[0] * k_w[0][o] + xc[1] * k_w[1][o] + xc[2] * k_w[2][o] + xc[3] * k_w[3][o];
            vq[u][o] = x0[0] * v_w[0][o] + x0[1] * v_w[1][o] + x0[2] * v_w[2][o] + x0[3] * v_w[3][o];
          }
          { u32x2 o; o.x = cvt_pk_bf16(xc[0], xc[1]); o.y = cvt_pk_bf16(xc[2], xc[3]); *(u32x2*)(XC + (size_t)t * E + ch) = o; }
          { u32x2 o; o.x = cvt_pk_bf16(qv[0], qv[1]); o.y = cvt_pk_bf16(qv[2], qv[3]); *(u32x2*)(QS + srun + ttl * 8) = o; }
          { u32x2 o; o.x = cvt_pk_bf16(kq[u][0], kq[u][1]); o.y = cvt_pk_bf16(kq[u][2], kq[u][3]); *(u32x2*)(KS + srun + ttl * 8) = o; }
          if (samp) { if (pos >= 13) { f32x4 o; o.x = x0[0]; o.y = x0[1]; o.z = x0[2]; o.w = x0[3]; *(f32x4*)(p.out + O_CONVS + ((size_t)((t - NP) >> 4) * 3 + (pos - 13)) * E + ch) = o; } }
          else if (pos >= 8189) { f32x4 o; o.x = x0[0]; o.y = x0[1]; o.z = x0[2]; o.w = x0[3]; *(f32x4*)(p.out + O_CONVP + ((size_t)(t >> 13) * 3 + (pos - 8189)) * E + ch) = o; }
#pragma unroll
          for (int i = 0; i < 4; ++i) { H.x3[i] = H.x2[i]; H.x2[i] = H.x1[i]; H.x1[i] = x0[i]; }
        }
#pragma unroll
        for (int o = 0; o < 4; ++o) { kacc[o][pr] = cvt_pk_bf16(kq[0][o], kq[1][o]); vacc[o][pr] = cvt_pk_bf16(vq[0][o], vq[1][o]); }
      }
      const int tg = tt0 + tb8 * 8, ks = tg >> 4, hht = (tg >> 3) & 1;
#pragma unroll
      for (int o = 0; o < 4; ++o) {
        const int d = nl * 4 + o;
        const size_t fo = ((((size_t)(cg * 4 + h) * 16 + (d >> 5)) * 4 + ks) * 64 + (d & 31) + 32 * hht) * 8;
        u32x4 kk_; kk_.x = kacc[o][0]; kk_.y = kacc[o][1]; kk_.z = kacc[o][2]; kk_.w = kacc[o][3];
        u32x4 vv_; vv_.x = vacc[o][0]; vv_.y = vacc[o][1]; vv_.z = vacc[o][2]; vv_.w = vacc[o][3];
        *(u32x4*)(KTF + fo) = kk_;
        *(u32x4*)(VF + fo) = vv_;
      }
    }
    __syncthreads();
#pragma unroll 2
    for (int i = 0; i < 8; ++i) {
      const int pc = i * 256 + tid, run = pc >> 4, l16 = pc & 15;
      const int hl = run >> 6, ks_ = (run >> 1) & 31, hq_ = run & 1;
      const size_t dst = ((size_t)((cg * 4 + 2 * hf + hl) * 64 + (tt0 >> 5) * 32 + ks_)) * 512 + ((tt0 & 31) + l16 + 32 * hq_) * 8;
      *(u32x4*)(QF + dst) = *(const u32x4*)(QS + run * 136 + l16 * 8);
      *(u32x4*)(KF + dst) = *(const u32x4*)(KS + run * 136 + l16 * 8);
    }
  }
}

DEV void gate_phase(const Params& p, char* smem) {
  const int tid = threadIdx.x, lane = tid & 63, wid = tid >> 6, l31 = lane & 31, hh = lane >> 5;
  float* sig = (float*)smem; float* slf = sig + 256;
  float* red = (float*)(smem + 2048);
  const bf16_t* XMb = (const bf16_t*)(p.ws + OFF_B); const bf16_t* XCb = (const bf16_t*)(p.ws + OFF_D);
  const bf16_t* GT = (const bf16_t*)(p.ws + OFF_GT);
  const float* bgt = p.in[21];
  float* GB = (float*)(p.ws + OFF_GB); float* GU = (float*)(p.ws + OFF_GU); float* GA = (float*)(p.ws + OFF_GA); float* CHS = (float*)(p.ws + OFF_CHS);
  for (int unit = blockIdx.x; unit < T / 64; unit += gridDim.x) {
    const int tok0 = unit * 64;
    const bool samp = tok0 >= NP;
    __syncthreads();
    {
      bf16_t* slab = (bf16_t*)smem;
      f32x16 a0, a1;
#pragma unroll
      for (int i = 0; i < 16; ++i) { a0[i] = 0.f; a1[i] = 0.f; }
      const int lrow = tid >> 5, lc8 = (tid & 31) * 8;
      const bf16_t* gxc = XCb + (size_t)(tok0 + lrow) * E + lc8;
      const bf16_t* gxm = XMb + (size_t)(tok0 + lrow) * E + lc8;
      const bf16_t* gtp = GT + (size_t)(l31 < 8 ? l31 : 8) * 4096 + wid * 64 + 8 * hh;
      u32x4 ar[8], bcur[8], bnxt[8];
#pragma unroll
      for (int i = 0; i < 8; ++i) ar[i] = *(const u32x4*)(gxc + (size_t)(8 * i) * E);
#pragma unroll
      for (int i = 0; i < 4; ++i) { bcur[i] = *(const u32x4*)(gtp + i * 16); bcur[4 + i] = *(const u32x4*)(gtp + (size_t)32 * 4096 + i * 16); }
#pragma unroll
      for (int i = 0; i < 8; ++i) *(u32x4*)(slab + (lrow + 8 * i) * 264 + lc8) = ar[i];
      __syncthreads();
#pragma unroll 1
      for (int s = 0; s < 16; ++s) {
        const int buf = s & 1;
        if (s + 1 < 16) {
          const bf16_t* g = ((s + 1) < 8 ? gxc : gxm) + ((s + 1) & 7) * 256;
#pragma unroll
          for (int i = 0; i < 8; ++i) ar[i] = *(const u32x4*)(g + (size_t)(8 * i) * E);
#pragma unroll
          for (int i = 0; i < 4; ++i) { bnxt[i] = *(const u32x4*)(gtp + (s + 1) * 256 + i * 16); bnxt[4 + i] = *(const u32x4*)(gtp + (size_t)32 * 4096 + (s + 1) * 256 + i * 16); }
        }
        const bf16_t* sb0 = slab + buf * (64 * 264) + l31 * 264 + wid * 64 + 8 * hh;
#pragma unroll
        for (int i = 0; i < 4; ++i) {
          const bf16x8 x0 = *(const bf16x8*)(sb0 + i * 16), x1 = *(const bf16x8*)(sb0 + 32 * 264 + i * 16);
          a0 = MFMA32(x0, as_bf16x8(bcur[i]), a0); a1 = MFMA32(x1, as_bf16x8(bcur[i]), a1);
          a0 = MFMA32(x0, as_bf16x8(bcur[4 + i]), a0); a1 = MFMA32(x1, as_bf16x8(bcur[4 + i]), a1);
        }
        if (s + 1 < 16) {
#pragma unroll
          for (int i = 0; i < 8; ++i) *(u32x4*)(slab + (buf ^ 1) * (64 * 264) + (lrow + 8 * i) * 264 + lc8) = ar[i];
#pragma unroll
          for (int i = 0; i < 8; ++i) bcur[i] = bnxt[i];
        }
        __syncthreads();
      }
      if (l31 < 8) {
        float* rb = red + (wid * 64 + 4 * hh) * 8 + l31;
#pragma unroll
        for (int i = 0; i < 16; ++i) {
          const int t0 = (i & 3) + 8 * (i >> 2);
          rb[t0 * 8] = a0[i]; rb[(32 + t0) * 8] = a1[i];
        }
      }
    }
    __syncthreads();
    {
      const int tt = tid >> 2, h = tid & 3;
      float gi = bgt[h], gf = bgt[4 + h];
#pragma unroll
      for (int w = 0; w < 4; ++w) { gi += red[(w * 64 + tt) * 8 + h]; gf += red[(w * 64 + tt) * 8 + 4 + h]; }
      sig[h * 64 + tt] = gi;
      slf[h * 64 + tt] = fminf(gf, 0.f) - log1pf(__expf(-fabsf(gf)));
    }
    __syncthreads();
    {
      const int seglen = samp ? 16 : 64, nseg = 64 / seglen;
      if (tid < 4 * nseg) {
        const int h = tid & 3, sg = tid >> 2;
        float b = 0.f, a = -INFINITY;
        for (int j = 0; j < seglen; ++j) {
          const int tt = sg * seglen + j;
          b += slf[h * 64 + tt];
          const float u = sig[h * 64 + tt] - b;
          a = fmaxf(a, u);
          const size_t o = (size_t)(tok0 + tt) * 4 + h;
          GB[o] = b; GU[o] = u; GA[o] = a;
        }
        if (!samp) { CHS[(unit * 4 + h) * 2] = b; CHS[(unit * 4 + h) * 2 + 1] = a; }
      }
    }
  }
}

DEV size_t numidx(int row, int h, int e) { return ((((size_t)(row >> 1) * 4 + h) * 16 + (e >> 5)) * 2 + (row & 1)) * 32 + (e & 31); }

DEV u32x4 coherent_load16(const bf16_t* ptr) {
  unsigned* q = (unsigned*)ptr; u32x4 r;
  r.x = __hip_atomic_load(q, __ATOMIC_RELAXED, __HIP_MEMORY_SCOPE_AGENT); r.y = __hip_atomic_load(q + 1, __ATOMIC_RELAXED, __HIP_MEMORY_SCOPE_AGENT);
  r.z = __hip_atomic_load(q + 2, __ATOMIC_RELAXED, __HIP_MEMORY_SCOPE_AGENT); r.w = __hip_atomic_load(q + 3, __ATOMIC_RELAXED, __HIP_MEMORY_SCOPE_AGENT);
  return r;
}

constexpr int NSUB = 4;

DEV float mscan_prefix(const float* CHS, int pb, int h, int c, int lane) {
  float P[2], Q[2];
#pragma unroll
  for (int j = 0; j < 2; ++j) {
    const int i = 2 * lane + j;
    if (i < c) { const float bl = CHS[((pb * 128 + i) * 4 + h) * 2], al = CHS[((pb * 128 + i) * 4 + h) * 2 + 1]; P[j] = bl; Q[j] = al + bl; }
    else { P[j] = 0.f; Q[j] = -INFINITY; }
  }
  float Pc = P[0] + P[1], Qc = fmaxf(Q[0] + P[1], Q[1]);
#pragma unroll
  for (int off = 1; off < 64; off <<= 1) {
    const float Po = __shfl_xor(Pc, off), Qo = __shfl_xor(Qc, off);
    if (lane & off) { Qc = fmaxf(Qo + Pc, Qc); Pc = Po + Pc; }
    else { Qc = fmaxf(Qc + Po, Qo); Pc = Pc + Po; }
  }
  return fmaxf(Pc, Qc);
}

DEV void intra_phase(const Params& p, char* smem) {
  const int tid = threadIdx.x, lane = tid & 63, wid = tid >> 6, l31 = lane & 31, hh = lane >> 5;
  float* su = (float*)smem;
  float* sM = su + NSUB * 64;
  float* sden = sM + 64;
  bf16_t* SWL = (bf16_t*)(smem + 2048);
  const bf16_t* QF = (const bf16_t*)(p.ws + OFF_E); const bf16_t* KF = (const bf16_t*)(p.out + O_CS); const bf16_t* VF = (const bf16_t*)(p.ws + OFF_F);
  bf16_t* NUMI = (bf16_t*)(p.ws + OFF_SW);
  const float* GB = (const float*)(p.ws + OFF_GB); const float* GU = (const float*)(p.ws + OFF_GU); const float* GA = (const float*)(p.ws + OFF_GA);
  const float* CHS = (const float*)(p.ws + OFF_CHS);
  float* WINTER = (float*)(p.ws + OFF_WINTER); float* WUPD = (float*)(p.ws + OFF_WUPD); float* DENI = (float*)(p.ws + OFF_DENI); float* ENEGM = (float*)(p.ws + OFF_ENEGM);
  float* DECAY = (float*)(p.ws + OFF_DECAY);
  const int si = wid >> 1, ti = wid & 1;
  for (int u0 = blockIdx.x; u0 < 1152; u0 += gridDim.x) {
    const int uid = (u0 >= 512 && u0 < 1024) ? (u0 ^ 12) : u0;
    const bool samp = uid >= 1024;
    const int h = uid & 3;
    __syncthreads();
    if (!samp) {
      const int cg = uid >> 2, pb = cg >> 7, cseq = cg & 127, tb = cseq & (NSUB - 1), cg0 = cg - tb, row0 = cg * 64;
      if (wid == 0) {
        const float mprev = mscan_prefix(CHS, pb, h, cseq - tb, lane);
        float B[NSUB + 1]; B[0] = 0.f; float Apre = -INFINITY, Aall = -INFINITY;
#pragma unroll
        for (int i = 0; i < NSUB; ++i) {
          const float bl = CHS[((cg0 + i) * 4 + h) * 2], al = CHS[((cg0 + i) * 4 + h) * 2 + 1];
          if (i < tb) Apre = fmaxf(Apre, al - B[i]);
          Aall = fmaxf(Aall, al - B[i]);
          B[i + 1] = B[i] + bl;
        }
        float Btb = 0.f;
#pragma unroll
        for (int i = 0; i < NSUB; ++i) if (i == tb) Btb = B[i];
        const float Mlast = fmaxf(mprev, Aall);
        const size_t o = (size_t)(row0 + lane) * 4 + h;
        const float bt = GB[o] + Btb, ut = GU[o] - Btb, at = fmaxf(Apre, GA[o] - Btb);
        const float Mt = fmaxf(mprev, at);
        sM[lane] = Mt;
        WINTER[o] = __expf(mprev - Mt);
        ENEGM[o] = __expf(-(bt + Mt));
        WUPD[o] = __expf(ut - Mlast);
#pragma unroll
        for (int i = 0; i < NSUB; ++i) if (i <= tb) su[i * 64 + lane] = GU[(size_t)((cg0 + i) * 64 + lane) * 4 + h] - B[i];
        if (lane == 0) {
          if (tb == 0) DECAY[uid] = __expf(mprev - Mlast);
          if (cseq == 127) p.out[O_MP + pb * 4 + h] = B[NSUB] + Mlast;
        }
      }
      __syncthreads();
      float dpart = 0.f;
      const int t = 32 * ti + l31;
      const float Mt = sM[t];
      for (int jj = 0; jj <= tb; ++jj) {
        bf16_t* swb = SWL + (size_t)((jj * 2 + ti) * 4) * 512;
        if (jj < tb || si <= ti) {
          f32x16 acc;
#pragma unroll
          for (int i = 0; i < 16; ++i) acc[i] = 0.f;
          const bf16_t* ka = KF + ((size_t)((cg0 + jj) * 4 + h) * 2 + si) * 32 * 512 + lane * 8;
          const bf16_t* qb = QF + ((size_t)(cg * 4 + h) * 2 + ti) * 32 * 512 + lane * 8;
#pragma unroll 1
          for (int kb = 0; kb < 2; ++kb) {
            u32x4 fa[16], fb[16];
#pragma unroll
            for (int i = 0; i < 16; ++i) { fa[i] = *(const u32x4*)(ka + (kb * 16 + i) * 512); fb[i] = *(const u32x4*)(qb + (kb * 16 + i) * 512); }
            __builtin_amdgcn_sched_barrier(0);
#pragma unroll
            for (int i = 0; i < 16; ++i) acc = MFMA32(as_bf16x8(fa[i]), as_bf16x8(fb[i]), acc);
            __builtin_amdgcn_sched_barrier(0);
          }
#pragma unroll
          for (int g = 0; g < 4; ++g) {
            float w4[4];
#pragma unroll
            for (int x = 0; x < 4; ++x) {
              const int s = 32 * si + 8 * g + 4 * hh + x;
              const float v = (jj < tb || s <= t) ? acc[4 * g + x] * __expf(su[jj * 64 + s] - Mt) : 0.f;
              w4[x] = v; dpart += v;
            }
            u32x2 o; o.x = cvt_pk_bf16(w4[0], w4[1]); o.y = cvt_pk_bf16(w4[2], w4[3]);
            *(u32x2*)(swb + (2 * si + (g >> 1)) * 512 + (l31 + 32 * (g & 1)) * 8 + 4 * hh) = o;
          }
        } else {
          u32x2 z; z.x = 0u; z.y = 0u;
#pragma unroll
          for (int g = 0; g < 4; ++g) *(u32x2*)(swb + (2 * si + (g >> 1)) * 512 + (l31 + 32 * (g & 1)) * 8 + 4 * hh) = z;
        }
      }
      dpart += __shfl_xor(dpart, 32);
      if (hh == 0) sden[si * 64 + t] = dpart;
      __syncthreads();
      if (tid < 64) DENI[(size_t)(row0 + tid) * 4 + h] = sden[tid] + sden[64 + tid];
#pragma unroll 1
      for (int eti = 0; eti < 4; ++eti) {
        const int et = wid + 4 * eti;
        f32x16 a0, a1;
#pragma unroll
        for (int i = 0; i < 16; ++i) { a0[i] = 0.f; a1[i] = 0.f; }
        u32x4 vfr[NSUB][4];
#pragma unroll
        for (int jj = 0; jj < NSUB; ++jj) {
          if (jj <= tb) {
            const bf16_t* vf = VF + ((((size_t)((cg0 + jj) * 4 + h) * 16 + et) * 4) * 64 + lane) * 8;
#pragma unroll
            for (int ks = 0; ks < 4; ++ks) vfr[jj][ks] = *(const u32x4*)(vf + ks * 512);
          }
        }
        __builtin_amdgcn_sched_barrier(0);
#pragma unroll
        for (int jj = 0; jj < NSUB; ++jj) {
          if (jj <= tb) {
            const bf16_t* sw = SWL + (size_t)(jj * 8) * 512 + lane * 8;
#pragma unroll
            for (int ks = 0; ks < 4; ++ks) {
              const bf16x8 v = as_bf16x8(vfr[jj][ks]);
              a0 = MFMA32(v, *(const bf16x8*)(sw + ks * 512), a0);
              a1 = MFMA32(v, *(const bf16x8*)(sw + (4 + ks) * 512), a1);
            }
          }
        }
        bf16_t* dst0 = NUMI + numidx(row0 + l31, h, et * 32) + 4 * hh;
        bf16_t* dst1 = NUMI + numidx(row0 + 32 + l31, h, et * 32) + 4 * hh;
#pragma unroll
        for (int g = 0; g < 4; ++g) {
          u32x2 o0; o0.x = cvt_pk_bf16(a0[4 * g], a0[4 * g + 1]); o0.y = cvt_pk_bf16(a0[4 * g + 2], a0[4 * g + 3]);
          u32x2 o1; o1.x = cvt_pk_bf16(a1[4 * g], a1[4 * g + 1]); o1.y = cvt_pk_bf16(a1[4 * g + 2], a1[4 * g + 3]);
          *(u32x2*)(dst0 + 8 * g) = o0;
          *(u32x2*)(dst1 + 8 * g) = o1;
        }
      }
    } else {
      const int sb = (uid - 1024) >> 2, row0 = NP + sb * 16, cg = row0 >> 6, r0 = (sb & 3) * 16, mts = r0 >> 5, r0t = r0 & 31, ksq = sb & 3;
      if (wid == 0) {
        const float mprev = p.in[4][uid - 1024];
        const bool valid = lane < 16;
        const size_t o = (size_t)(row0 + (valid ? lane : 0)) * 4 + h;
        const float bt = GB[o], ut = GU[o], at = GA[o];
        const float Mt = fmaxf(mprev, at);
        const float alast = __shfl(at, 15), blast = __shfl(bt, 15);
        const float Mlast = fmaxf(mprev, alast);
        sM[lane] = Mt; su[lane] = ut;
        if (valid) { WINTER[o] = __expf(mprev - Mt); ENEGM[o] = __expf(-(bt + Mt)); WUPD[o] = __expf(ut - Mlast); }
        if (lane == 0) { DECAY[uid] = __expf(mprev - Mlast); p.out[O_MS + (uid - 1024)] = blast + Mlast; }
      }
      __syncthreads();
      if (wid == 0) {
        f32x16 acc;
#pragma unroll
        for (int i = 0; i < 16; ++i) acc[i] = 0.f;
        const bf16_t* ka = KF + ((size_t)(cg * 4 + h) * 2 + mts) * 32 * 512 + lane * 8;
        const bf16_t* qb = QF + ((size_t)(cg * 4 + h) * 2 + mts) * 32 * 512 + lane * 8;
#pragma unroll 1
        for (int kb = 0; kb < 2; ++kb) {
          u32x4 fa[16], fb[16];
#pragma unroll
          for (int i = 0; i < 16; ++i) { fa[i] = *(const u32x4*)(ka + (kb * 16 + i) * 512); fb[i] = *(const u32x4*)(qb + (kb * 16 + i) * 512); }
          __builtin_amdgcn_sched_barrier(0);
#pragma unroll
          for (int i = 0; i < 16; ++i) acc = MFMA32(as_bf16x8(fa[i]), as_bf16x8(fb[i]), acc);
          __builtin_amdgcn_sched_barrier(0);
        }
        const int tl = l31 - r0t;
        const bool tv = tl >= 0 && tl < 16;
        const float Mt = sM[tv ? tl : 0];
        float dpart = 0.f;
#pragma unroll
        for (int g = 0; g < 4; ++g) {
          float w4[4];
#pragma unroll
          for (int x = 0; x < 4; ++x) {
            const int s = 8 * g + 4 * hh + x, sl = s - r0t;
            const bool ok = tv && sl >= 0 && s <= l31;
            const float v = ok ? acc[4 * g + x] * __expf(su[ok ? sl : 0] - Mt) : 0.f;
            w4[x] = v; dpart += v;
          }
          u32x2 o; o.x = cvt_pk_bf16(w4[0], w4[1]); o.y = cvt_pk_bf16(w4[2], w4[3]);
          *(u32x2*)(SWL + (g >> 1) * 512 + (l31 + 32 * (g & 1)) * 8 + 4 * hh) = o;
        }
        dpart += __shfl_xor(dpart, 32);
        if (hh == 0 && tv) DENI[(size_t)(row0 + tl) * 4 + h] = dpart;
      }
      __syncthreads();
      {
        const int tl = l31 - r0t;
        const bool tv = tl >= 0 && tl < 16;
        const bf16x8 swf = *(const bf16x8*)(SWL + (r0t >> 4) * 512 + lane * 8);
#pragma unroll 1
        for (int eti = 0; eti < 4; ++eti) {
          const int et = wid + 4 * eti;
          f32x16 a0;
#pragma unroll
          for (int i = 0; i < 16; ++i) a0[i] = 0.f;
          const bf16x8 v = as_bf16x8(*(const u32x4*)(VF + ((((size_t)(cg * 4 + h) * 16 + et) * 4 + ksq) * 64 + lane) * 8));
          a0 = MFMA32(v, swf, a0);
          if (tv) {
            bf16_t* dst = NUMI + numidx(row0 + tl, h, et * 32) + 4 * hh;
#pragma unroll
            for (int g = 0; g < 4; ++g) { u32x2 o0; o0.x = cvt_pk_bf16(a0[4 * g], a0[4 * g + 1]); o0.y = cvt_pk_bf16(a0[4 * g + 2], a0[4 * g + 3]); *(u32x2*)(dst + 8 * g) = o0; }
          }
        }
      }
    }
  }
}

DEV bf16x8 pack_acc(const f32x16& x, int s) {
  u32x4 pk;
  if (s == 0) { pk.x = cvt_pk_bf16(x[0], x[1]); pk.y = cvt_pk_bf16(x[2], x[3]); pk.z = cvt_pk_bf16(x[4], x[5]); pk.w = cvt_pk_bf16(x[6], x[7]); }
  else { pk.x = cvt_pk_bf16(x[8], x[9]); pk.y = cvt_pk_bf16(x[10], x[11]); pk.z = cvt_pk_bf16(x[12], x[13]); pk.w = cvt_pk_bf16(x[14], x[15]); }
  return as_bf16x8(pk);
}
DEV bf16x8 scale_frag(u32x4 raw, const float* w) {
  const f32x4 w0 = *(const f32x4*)(w), w1 = *(const f32x4*)(w + 4);
  u32x4 pk;
  pk.x = cvt_pk_bf16(bf_lo(raw.x) * w0.x, bf_hi(raw.x) * w0.y); pk.y = cvt_pk_bf16(bf_lo(raw.y) * w0.z, bf_hi(raw.y) * w0.w);
  pk.z = cvt_pk_bf16(bf_lo(raw.z) * w1.x, bf_hi(raw.z) * w1.y); pk.w = cvt_pk_bf16(bf_lo(raw.w) * w1.z, bf_hi(raw.w) * w1.w);
  return as_bf16x8(pk);
}

DEV void store_ctile(float* base, const f32x16 (&C)[4]) {
  float* cptr = base;
#pragma unroll
  for (int dt = 0; dt < 4; ++dt)
#pragma unroll
    for (int q = 0; q < 4; ++q) {
      cptr[0] = C[dt][4 * q]; cptr[512] = C[dt][4 * q + 1]; cptr[1024] = C[dt][4 * q + 2]; cptr[1536] = C[dt][4 * q + 3];
      cptr += 8 * 512; asm volatile("" : "+v"(cptr));
    }
}
DEV void load_ctile(const float* base, f32x16 (&C)[4]) {
  const float* cptr = base;
#pragma unroll
  for (int dt = 0; dt < 4; ++dt)
#pragma unroll
    for (int q = 0; q < 4; ++q) {
      C[dt][4 * q] = cptr[0]; C[dt][4 * q + 1] = cptr[512]; C[dt][4 * q + 2] = cptr[1024]; C[dt][4 * q + 3] = cptr[1536];
      cptr += 8 * 512; asm volatile("" : "+v"(cptr));
    }
}

constexpr unsigned BF_ONES = 0x3F803F80u;

DEV void lds_barrier() { asm volatile("s_waitcnt lgkmcnt(0)\n\ts_barrier" ::: "memory"); }

DEV void scan_prompt(const Params& p, char* smem, int pb, int h, int sl, unsigned* prog) {
  int tid_ = threadIdx.x; asm volatile("" : "+v"(tid_));
  const int tid = tid_, lane = tid & 63, wid = tid >> 6, l31 = lane & 31, hh = lane >> 5;
  float* red = (float*)smem;
  float* swi = red + 2 * 4 * 64 * 32;
  float* swu = swi + 256;
  const bf16_t* QF = (const bf16_t*)(p.ws + OFF_E); const bf16_t* VF = (const bf16_t*)(p.ws + OFF_F); const bf16_t* KTF = (const bf16_t*)(p.out + O_Y);
  bf16_t* NUM = (bf16_t*)(p.ws + OFF_B);
  const float* WINTER = (const float*)(p.ws + OFF_WINTER); const float* WUPD = (const float*)(p.ws + OFF_WUPD); const float* DECAY = (const float*)(p.ws + OFF_DECAY);
  const float* DENI = (const float*)(p.ws + OFF_DENI); const float* ENEGM = (const float*)(p.ws + OFF_ENEGM); float* DINV = (float*)(p.ws + OFF_DINV);
  const bool ns = sl == 16;
  const int slv = ns ? 0 : sl;
  f32x16 C[4];
#pragma unroll
  for (int dt = 0; dt < 4; ++dt)
#pragma unroll
    for (int i = 0; i < 16; ++i) C[dt][i] = 0.f;
  const int e0 = slv * 32;
  const u32x4 ones = {BF_ONES, BF_ONES, BF_ONES, BF_ONES};
  constexpr int RQ = 8;
  const int rt = tid >> 2, re8 = (tid & 3) * 8;
  float nwi, nwu, ndecay;
  { const size_t o = (size_t)(pb * 8192 + tid) * 4 + h; nwi = WINTER[o]; nwu = WUPD[o]; ndecay = DECAY[(pb * 128) * 4 + h]; }
  for (int sc = 0; sc < 128 / NSUB; ++sc) {
    const int cg0 = pb * 128 + sc * NSUB, rows = cg0 * 64;
    if (sl == 0 && tid == 0) __hip_atomic_store(prog + pb * 4 + h, (unsigned)sc, __ATOMIC_RELAXED, __HIP_MEMORY_SCOPE_AGENT);
    const bf16_t* qbase = QF + ((size_t)(cg0 * 4 + h) * 64 + 8 * wid) * 512 + lane * 8;
    u32x4 qf[RQ];
#pragma unroll
    for (int q = 0; q < RQ; ++q) qf[q] = *(const u32x4*)(qbase + (size_t)(q >> 4) * (4 * 64 * 512) + (size_t)(((q >> 3) & 1) * 32 + (q & 7)) * 512);
    lds_barrier();
    swi[tid] = nwi; swu[tid] = nwu;
    const float decay = ndecay;
    if (sc + 1 < 128 / NSUB) {
      const size_t o = (size_t)(rows + NSUB * 64 + tid) * 4 + h;
      nwi = WINTER[o]; nwu = WUPD[o]; ndecay = DECAY[(cg0 + NSUB) * 4 + h];
    }
    lds_barrier();
#pragma unroll
    for (int it = 0; it < 2 * NSUB; ++it) {
      const int j = it >> 1, mt = it & 1;
      const int cgj = cg0 + j;
      bf16_t* nump = NUM + numidx(cgj * 64 + rt, h, e0 + re8);
      f32x16 ai;
#pragma unroll
      for (int i = 0; i < 16; ++i) ai[i] = 0.f;
#pragma unroll
      for (int kk = 0; kk < 8; ++kk) {
        const int q = it * 8 + kk;
        ai = MFMA32(as_bf16x8(qf[q % RQ]), pack_acc(C[kk >> 1], kk & 1), ai);
        if (q + RQ < 16 * NSUB) {
          const int qn = q + RQ;
          qf[q % RQ] = *(const u32x4*)(qbase + (size_t)(qn >> 4) * (4 * 64 * 512) + (size_t)(((qn >> 3) & 1) * 32 + (qn & 7)) * 512);
        }
      }
      float* rb = red + (j & 1) * (4 * 64 * 32);
      {
        float* rbt = rb + (wid * 64 + 4 * hh) * 32 + l31;
        const float* swij = swi + j * 64 + 4 * hh + 32 * mt;
        f32x4 w4[4];
#pragma unroll
        for (int q = 0; q < 4; ++q) w4[q] = *(const f32x4*)(swij + 8 * q);
#pragma unroll
        for (int i = 0; i < 16; ++i) {
          const int t0 = 32 * mt + (i & 3) + 8 * (i >> 2);
          rbt[t0 * 32] = w4[i >> 2][i & 3] * ai[i];
        }
      }
      if (mt == 1) {
        lds_barrier();
        f32x4 s0 = *(const f32x4*)(rb + rt * 32 + re8), s1 = *(const f32x4*)(rb + rt * 32 + re8 + 4);
#pragma unroll
        for (int w = 1; w < 4; ++w) { s0 += *(const f32x4*)(rb + (w * 64 + rt) * 32 + re8); s1 += *(const f32x4*)(rb + (w * 64 + rt) * 32 + re8 + 4); }
        if (!ns) {
          u32x4 o;
          o.x = cvt_pk_bf16(s0.x, s0.y); o.y = cvt_pk_bf16(s0.z, s0.w); o.z = cvt_pk_bf16(s1.x, s1.y); o.w = cvt_pk_bf16(s1.z, s1.w);
          *(u32x4*)nump = o;
        } else if (re8 == 0) {
          const size_t o = (size_t)(cgj * 64 + rt) * 4 + h;
          DINV[o] = s0.x;
        }
      }
    }
#pragma unroll
    for (int dt = 0; dt < 4; ++dt)
#pragma unroll
      for (int i = 0; i < 16; ++i) C[dt][i] *= decay;
    constexpr int PF = 4;
    u32x4 vb[PF], kb[PF][4];
    const bf16_t* vbase = VF + ((((size_t)(cg0 * 4 + h) * 16 + slv) * 4) * 64 + lane) * 8;
    const bf16_t* kbase = KTF + ((((size_t)(cg0 * 4 + h) * 16 + 4 * wid) * 4) * 64 + lane) * 8;
#pragma unroll
    for (int k16 = 0; k16 < PF; ++k16) {
      const size_t off = (size_t)(k16 >> 2) * (4 * 16 * 4 * 512) + (size_t)(k16 & 3) * 512;
      vb[k16] = ns ? ones : *(const u32x4*)(vbase + off);
#pragma unroll
      for (int dt = 0; dt < 4; ++dt) kb[k16][dt] = *(const u32x4*)(kbase + off + (size_t)dt * 4 * 512);
    }
#pragma unroll
    for (int k16 = 0; k16 < NSUB * 4; ++k16) {
      const bf16x8 b = scale_frag(vb[k16 % PF], swu + k16 * 16 + 8 * hh);
#pragma unroll
      for (int dt = 0; dt < 4; ++dt) C[dt] = MFMA32(as_bf16x8(kb[k16 % PF][dt]), b, C[dt]);
      if (k16 + PF < NSUB * 4) {
        const int kn = k16 + PF;
        const size_t off = (size_t)(kn >> 2) * (4 * 16 * 4 * 512) + (size_t)(kn & 3) * 512;
        vb[k16 % PF] = ns ? ones : *(const u32x4*)(vbase + off);
#pragma unroll
        for (int dt = 0; dt < 4; ++dt) kb[k16 % PF][dt] = *(const u32x4*)(kbase + off + (size_t)dt * 4 * 512);
      }
    }
  }
  if (!ns) store_ctile(p.out + O_CP + (size_t)(pb * 4 + h) * 262144 + (size_t)(128 * wid + 4 * hh) * 512 + e0 + l31, C);
  else if (l31 == 0) {
    float* nout = p.out + O_NP + (size_t)(pb * 4 + h) * 512 + 128 * wid + 4 * hh;
#pragma unroll
    for (int dt = 0; dt < 4; ++dt)
#pragma unroll
      for (int i = 0; i < 16; ++i) nout[32 * dt + (i & 3) + 8 * (i >> 2)] = C[dt][i];
  }
}

DEV void scan_sample(const Params& p_, char* smem, int sbh, int sl) {
  Params p = p_;
  asm volatile("" : "+s"(p.ws), "+s"(p.out), "+s"(p.in[2]), "+s"(p.in[3]));
  const int tid = threadIdx.x, lane = tid & 63, wid = tid >> 6, l31 = lane & 31, hh = lane >> 5;
  float* red = (float*)smem;
  float* swi = red + 2 * 4 * 64 * 32;
  float* swu = swi + 256;
  const bf16_t* QF = (const bf16_t*)(p.ws + OFF_E); const bf16_t* VF = (const bf16_t*)(p.ws + OFF_F); const bf16_t* KTF = (const bf16_t*)(p.out + O_Y);
  const bf16_t* SWF = (const bf16_t*)(p.ws + OFF_SW);
  bf16_t* NUM = (bf16_t*)(p.ws + OFF_B);
  const float* WINTER = (const float*)(p.ws + OFF_WINTER); const float* WUPD = (const float*)(p.ws + OFF_WUPD); const float* DECAY = (const float*)(p.ws + OFF_DECAY);
  const float* DENI = (const float*)(p.ws + OFF_DENI); const float* ENEGM = (const float*)(p.ws + OFF_ENEGM); float* DINV = (float*)(p.ws + OFF_DINV);
  const int sb = sbh >> 2, h = sbh & 3, row0 = NP + sb * 16, cg = row0 >> 6, r0 = (sb & 3) * 16, mts = r0 >> 5, r0t = r0 & 31, ksq = sb & 3;
  const bool ns = sl == 16;
  const int slv = ns ? 0 : sl;
  const int uid = 1024 + sbh, e0 = slv * 32;
  f32x16 C[4];
  if (!ns) load_ctile(p.in[2] + (size_t)sbh * 262144 + (size_t)(128 * wid + 4 * hh) * 512 + e0 + l31, C);
  else {
    const float* n0 = p.in[3] + (size_t)sbh * 512 + 128 * wid + 4 * hh;
#pragma unroll
    for (int dt = 0; dt < 4; ++dt)
#pragma unroll
      for (int i = 0; i < 16; ++i) C[dt][i] = n0[32 * dt + (i & 3) + 8 * (i >> 2)];
  }
  __syncthreads();
  if (tid < 32) { const int tl = tid - r0t; swi[tid] = (tl >= 0 && tl < 16) ? WINTER[(size_t)(row0 + tl) * 4 + h] : 0.f; }
  if (tid >= 64 && tid < 80) swu[tid - 64] = WUPD[(size_t)(row0 + tid - 64) * 4 + h];
  const float decay = DECAY[uid];
  f32x16 ai, aa;
#pragma unroll
  for (int i = 0; i < 16; ++i) { ai[i] = 0.f; aa[i] = 0.f; }
  const bf16_t* qa = QF + ((size_t)((cg * 4 + h) * 2 + mts) * 32 + 8 * wid) * 512 + lane * 8;
#pragma unroll
  for (int kk = 0; kk < 8; ++kk) {
    const bf16x8 a = as_bf16x8(*(const u32x4*)(qa + (size_t)kk * 512));
    ai = MFMA32(a, pack_acc(C[kk >> 1], kk & 1), ai);
  }
  u32x4 vraw = {BF_ONES, BF_ONES, BF_ONES, BF_ONES};
  if (!ns) vraw = *(const u32x4*)(VF + ((((size_t)(cg * 4 + h) * 16 + slv) * 4 + ksq) * 64 + lane) * 8);
  __syncthreads();
  {
    float* rbt = red + (wid * 32 + 4 * hh) * 32 + l31;
    const float* swij = swi + 4 * hh;
    f32x4 w4[4];
#pragma unroll
    for (int q = 0; q < 4; ++q) w4[q] = *(const f32x4*)(swij + 8 * q);
#pragma unroll
    for (int i = 0; i < 16; ++i) {
      const int t0 = (i & 3) + 8 * (i >> 2);
      rbt[t0 * 32] = aa[i] + w4[i >> 2][i & 3] * ai[i];
    }
  }
#pragma unroll
  for (int dt = 0; dt < 4; ++dt)
#pragma unroll
    for (int i = 0; i < 16; ++i) C[dt][i] *= decay;
  {
    const bf16x8 b = scale_frag(vraw, swu + 8 * hh);
    const bf16_t* ka = KTF + ((((size_t)(cg * 4 + h) * 16 + 4 * wid) * 4 + ksq) * 64 + lane) * 8;
#pragma unroll
    for (int dt = 0; dt < 4; ++dt) C[dt] = MFMA32(as_bf16x8(*(const u32x4*)(ka + (size_t)dt * 4 * 512)), b, C[dt]);
  }
  __syncthreads();
  if (tid < 64) {
    const int t = tid >> 2, e8 = (tid & 3) * 8, tr = r0t + t;
    f32x4 s0 = *(const f32x4*)(red + tr * 32 + e8), s1 = *(const f32x4*)(red + tr * 32 + e8 + 4);
#pragma unroll
    for (int w = 1; w < 4; ++w) { s0 += *(const f32x4*)(red + (w * 32 + tr) * 32 + e8); s1 += *(const f32x4*)(red + (w * 32 + tr) * 32 + e8 + 4); }
    if (!ns) {
      bf16_t* nump = NUM + numidx(row0 + t, h, e0 + e8);
      u32x4 o;
      o.x = cvt_pk_bf16(s0.x, s0.y); o.y = cvt_pk_bf16(s0.z, s0.w); o.z = cvt_pk_bf16(s1.x, s1.y); o.w = cvt_pk_bf16(s1.z, s1.w);
      *(u32x4*)nump = o;
    } else if (e8 == 0) {
      const size_t o = (size_t)(row0 + t) * 4 + h;
      DINV[o] = s0.x;
    }
  }
  if (!ns) store_ctile(p.out + O_CS + (size_t)sbh * 262144 + (size_t)(128 * wid + 4 * hh) * 512 + e0 + l31, C);
  else if (l31 == 0) {
    float* nout = p.out + O_NS + (size_t)sbh * 512 + 128 * wid + 4 * hh;
#pragma unroll
    for (int dt = 0; dt < 4; ++dt)
#pragma unroll
      for (int i = 0; i < 16; ++i) nout[32 * dt + (i & 3) + 8 * (i >> 2)] = C[dt][i];
  }
}

DEV unsigned hw_xcc_id() { return (unsigned)__builtin_amdgcn_s_getreg((3 << 11) | 20) & 0xFu; }

constexpr int NPF = 6;
constexpr int PF_AHEAD = 2;
DEV void scan_prefetch(const Params& p, int bh, int part, unsigned* prog, volatile int* flag) {
  const int tid = threadIdx.x, pb = bh >> 2, h = bh & 3;
  const bf16_t* QF = (const bf16_t*)(p.ws + OFF_E); const bf16_t* VF = (const bf16_t*)(p.ws + OFF_F); const bf16_t* KTF = (const bf16_t*)(p.out + O_Y);
  unsigned sink = 0u;
  for (int sc = 0; sc < 128 / NSUB; ++sc) {
    if (tid == 0) {
      unsigned spins = 0; int dead = 0;
      while ((int)__hip_atomic_load(prog + bh, __ATOMIC_RELAXED, __HIP_MEMORY_SCOPE_AGENT) + PF_AHEAD < sc) { __builtin_amdgcn_s_sleep(8); if (++spins > (1u << 15)) { dead = 1; break; } }
      flag[0] = dead;
    }
    __syncthreads();
    if (flag[0]) break;
    __syncthreads();
    const int cg0 = pb * 128 + sc * NSUB;
    for (int r = part; r < 3 * NSUB; r += NPF) {
      const int which = r / NSUB, j = r % NSUB;
      const bf16_t* base = (which == 0 ? QF : (which == 1 ? KTF : VF)) + (size_t)((cg0 + j) * 4 + h) * 32768;
      u32x4 v[16];
#pragma unroll
      for (int i = 0; i < 16; ++i) v[i] = *(const u32x4*)(base + (size_t)(i * 256 + tid) * 8);
#pragma unroll
      for (int i = 0; i < 16; ++i) sink ^= v[i].x ^ v[i].w;
    }
  }
  asm volatile("" :: "v"(sink));
}


DEV void scan_phase(const Params& p, char* smem) {
  const int tid = threadIdx.x, bid = blockIdx.x;
  unsigned* cnt = (unsigned*)(p.ws + OFF_BAR + 14336);
  volatile int* sunit = (volatile int*)(smem + 73728 - 16);
  constexpr int NSS = 128 * 17;
  int stage = 0, bh_try = 0;
  for (;;) {
    __syncthreads();
    if (tid == 0) {
      int kind = -1, a = 0, b = 0;
      for (;;) {
        if (stage == 0) {
          stage = 1;
          const unsigned x = hw_xcc_id() & 7u;
          if (bid < 256) { const unsigned t = atomicAdd(&cnt[x], 1u); if (t < 17u) { kind = 0; a = (int)x; b = (int)t; break; } }
          else { const unsigned t = atomicAdd(&cnt[8 + x], 1u); if (t < (unsigned)NPF) { kind = 2; a = (int)x; b = (int)t; break; } }
        } else if (stage == 1) {
          const unsigned u = atomicAdd(&cnt[16], 1u);
          if (u < (unsigned)NSS) { kind = 1; a = (int)u; break; }
          stage = 2;
        } else {
          if (bh_try >= 8) break;
          const unsigned t = atomicAdd(&cnt[bh_try], 1u);
          if (t < 17u) { kind = 0; a = bh_try; b = (int)t; break; }
          ++bh_try;
        }
      }
      sunit[0] = kind; sunit[1] = a; sunit[2] = b;
    }
    __syncthreads();
    const int kind = sunit[0], a = sunit[1], b = sunit[2];
    if (kind < 0) break;
    if (kind == 0) scan_prompt(p, smem, a >> 2, a & 3, b, cnt + 32);
    else if (kind == 1) scan_sample(p, smem, a / 17, a % 17);
    else scan_prefetch(p, a, b, cnt + 32, sunit + 3);
  }
}

DEV void hnorm_phase(const Params& p) {
  const int tid = threadIdx.x, lane = tid & 63, h = tid >> 6;
  const bf16_t* NUM = (const bf16_t*)(p.ws + OFF_B); const bf16_t* XC = (const bf16_t*)(p.ws + OFF_D); const bf16_t* Z2 = (const bf16_t*)(p.ws + OFF_C);
  const float* DINV = (const float*)(p.ws + OFF_DINV); const float* DENI = (const float*)(p.ws + OFF_DENI); const float* ENEGM = (const float*)(p.ws + OFF_ENEGM);
  bf16_t* A4 = (bf16_t*)(p.ws + OFF_F);
  const int ch = h * 512 + lane * 8;
  float hg[8], sk[8];
  { const f32x4 a = *(const f32x4*)(p.in[22] + ch), b = *(const f32x4*)(p.in[22] + ch + 4); hg[0] = a.x; hg[1] = a.y; hg[2] = a.z; hg[3] = a.w; hg[4] = b.x; hg[5] = b.y; hg[6] = b.z; hg[7] = b.w; }
  { const f32x4 a = *(const f32x4*)(p.in[23] + ch), b = *(const f32x4*)(p.in[23] + ch + 4); sk[0] = a.x; sk[1] = a.y; sk[2] = a.z; sk[3] = a.w; sk[4] = b.x; sk[5] = b.y; sk[6] = b.z; sk[7] = b.w; }
  const bf16_t* NUMI = (const bf16_t*)(p.ws + OFF_SW);
  const int G = gridDim.x;
  int tok = blockIdx.x;
  float dv_n[2] = {0.f, 0.f}; u32x4 nr_n[2], ni_n[2], xr_n[2], zr_n[2];
#pragma unroll
  for (int u = 0; u < 2; ++u) {
    const int t = tok + u * G; const int tc = t < T ? t : 0;
    dv_n[u] = 1.f / fmaxf(fabsf(DENI[(size_t)tc * 4 + h] + DINV[(size_t)tc * 4 + h]), ENEGM[(size_t)tc * 4 + h]);
    nr_n[u] = *(const u32x4*)(NUM + numidx(tc, h, lane * 8)); ni_n[u] = *(const u32x4*)(NUMI + numidx(tc, h, lane * 8));
    xr_n[u] = *(const u32x4*)(XC + (size_t)tc * E + ch); zr_n[u] = *(const u32x4*)(Z2 + (size_t)tc * E + ch);
  }
  for (; tok < T; tok += 2 * G) {
    float dv[2]; u32x4 nr[2], ni[2], xr[2], zr[2];
#pragma unroll
    for (int u = 0; u < 2; ++u) { dv[u] = dv_n[u]; nr[u] = nr_n[u]; ni[u] = ni_n[u]; xr[u] = xr_n[u]; zr[u] = zr_n[u]; }
#pragma unroll
    for (int u = 0; u < 2; ++u) {
      const int t = tok + 2 * G + u * G; const int tc = t < T ? t : 0;
      dv_n[u] = 1.f / fmaxf(fabsf(DENI[(size_t)tc * 4 + h] + DINV[(size_t)tc * 4 + h]), ENEGM[(size_t)tc * 4 + h]);
      nr_n[u] = *(const u32x4*)(NUM + numidx(tc, h, lane * 8)); ni_n[u] = *(const u32x4*)(NUMI + numidx(tc, h, lane * 8));
      xr_n[u] = *(const u32x4*)(XC + (size_t)tc * E + ch); zr_n[u] = *(const u32x4*)(Z2 + (size_t)tc * E + ch);
    }
    float v[2][8], s[2];
#pragma unroll
    for (int u = 0; u < 2; ++u) {
      const float d = dv[u];
      v[u][0] = (bf_lo(nr[u].x) + bf_lo(ni[u].x)) * d; v[u][1] = (bf_hi(nr[u].x) + bf_hi(ni[u].x)) * d;
      v[u][2] = (bf_lo(nr[u].y) + bf_lo(ni[u].y)) * d; v[u][3] = (bf_hi(nr[u].y) + bf_hi(ni[u].y)) * d;
      v[u][4] = (bf_lo(nr[u].z) + bf_lo(ni[u].z)) * d; v[u][5] = (bf_hi(nr[u].z) + bf_hi(ni[u].z)) * d;
      v[u][6] = (bf_lo(nr[u].w) + bf_lo(ni[u].w)) * d; v[u][7] = (bf_hi(nr[u].w) + bf_hi(ni[u].w)) * d;
      s[u] = 0.f;
#pragma unroll
      for (int j = 0; j < 8; ++j) s[u] += v[u][j];
    }
#pragma unroll
    for (int o = 1; o < 64; o <<= 1) { s[0] += __shfl_xor(s[0], o); s[1] += __shfl_xor(s[1], o); }
    float s2[2];
#pragma unroll
    for (int u = 0; u < 2; ++u) {
      const float mean = s[u] * (1.f / 512.f);
      s2[u] = 0.f;
#pragma unroll
      for (int j = 0; j < 8; ++j) { v[u][j] -= mean; s2[u] += v[u][j] * v[u][j]; }
    }
#pragma unroll
    for (int o = 1; o < 64; o <<= 1) { s2[0] += __shfl_xor(s2[0], o); s2[1] += __shfl_xor(s2[1], o); }
#pragma unroll
    for (int u = 0; u < 2; ++u) {
      const int t = tok + u * G;
      if (t < T) {
        const float rstd = rsqrtf(s2[u] * (1.f / 512.f) + 1e-5f);
        const float xc[8] = {bf_lo(xr[u].x), bf_hi(xr[u].x), bf_lo(xr[u].y), bf_hi(xr[u].y), bf_lo(xr[u].z), bf_hi(xr[u].z), bf_lo(xr[u].w), bf_hi(xr[u].w)};
        const float z[8] = {bf_lo(zr[u].x), bf_hi(zr[u].x), bf_lo(zr[u].y), bf_hi(zr[u].y), bf_lo(zr[u].z), bf_hi(zr[u].z), bf_lo(zr[u].w), bf_hi(zr[u].w)};
        float o[8];
#pragma unroll
        for (int j = 0; j < 8; ++j) o[j] = (v[u][j] * rstd * hg[j] + sk[j] * xc[j]) * siluf_(z[j]);
        u32x4 ov; ov.x = cvt_pk_bf16(o[0], o[1]); ov.y = cvt_pk_bf16(o[2], o[3]); ov.z = cvt_pk_bf16(o[4], o[5]); ov.w = cvt_pk_bf16(o[6], o[7]);
        *(u32x4*)(A4 + (size_t)t * E + ch) = ov;
      }
    }
  }
}

DEV void final_phase(const Params& p) {
  const int tid = threadIdx.x, lane = tid & 63, wid = tid >> 6;
  const float* SS2 = (const float*)(p.ws + OFF_SS2);
  const float* g = p.in[7];
  f32x4 gv[4];
#pragma unroll
  for (int j = 0; j < 4; ++j) gv[j] = *(const f32x4*)(g + j * 256 + lane * 4);
  for (int row = blockIdx.x * 4 + wid; row < T; row += gridDim.x * 4) {
    float s = 0.f;
#pragma unroll
    for (int j = 0; j < 4; ++j) { const f32x4 v = *(const f32x4*)(SS2 + (size_t)row * 16 + 4 * j); s += v.x + v.y + v.z + v.w; }
    const float r = rsqrtf(s * (1.f / DM) + 1e-6f);
    float* y = p.out + O_Y + (size_t)row * DM;
#pragma unroll
    for (int j = 0; j < 4; ++j) { f32x4 v = *(const f32x4*)(y + j * 256 + lane * 4); v.x *= r * gv[j].x; v.y *= r * gv[j].y; v.z *= r * gv[j].z; v.w *= r * gv[j].w; *(f32x4*)(y + j * 256 + lane * 4) = v; }
  }
}

#define XB_TMO      128
#define XB_XCNT(j)  (256  + 64 * (j))
#define XB_XSUB(j)  (1280 + 64 * (j))
#define XB_XGEN(j)  (2304 + 64 * (j))
#define XB_TOP      3328
#define XB_TOPGEN   3392
#define XCD_BAR_WORDS 3456
#define XB_SPIN_CAP (1u << 18)
#define LAS __attribute__((address_space(3)))
DEV unsigned xb_ld(unsigned* p)              { return __hip_atomic_load(p, __ATOMIC_RELAXED, __HIP_MEMORY_SCOPE_AGENT); }
DEV unsigned xb_add(unsigned* p, unsigned v) { return __hip_atomic_fetch_add(p, v, __ATOMIC_RELAXED, __HIP_MEMORY_SCOPE_AGENT); }
DEV unsigned xb_xcc_id() { return (unsigned)__builtin_amdgcn_s_getreg((3 << 11) | 20) & 0xFu; }
#define XB_SPIN(cond, bar) do { unsigned _sp = 0; while (cond) { __builtin_amdgcn_s_sleep(1); \
    if ((++_sp & 255u) == 0u) { if (xb_ld(&(bar)[XB_TMO])) break; if (_sp > XB_SPIN_CAP) { atomicAdd(&(bar)[XB_TMO], 1u); break; } } } } while (0)
struct XcdBarrier { unsigned* bar; unsigned x; volatile LAS unsigned* st; };
DEV XcdBarrier xcd_barrier_post(unsigned* bar, volatile LAS unsigned* st) {
  XcdBarrier b; b.bar = bar; b.x = xb_xcc_id(); b.st = st;
  if (threadIdx.x == 0) (void)xb_add(&bar[XB_XCNT(b.x)], 1u);
  return b;
}
DEV void xcd_barrier_complete(unsigned* bar, unsigned x, unsigned& nloc, unsigned& nx) {
  const unsigned G = gridDim.x * gridDim.y * gridDim.z;
  unsigned sum, cnt, mine, sp = 0u;
  for (;;) {
    sum = 0u; cnt = 0u; mine = 0u;
#pragma unroll
    for (unsigned j = 0; j < 16; ++j) { const unsigned c = xb_ld(&bar[XB_XCNT(j)]); sum += c; cnt += (c > 0u) ? 1u : 0u; mine = (j == x) ? c : mine; }
    if (sum == G) break;
    __builtin_amdgcn_s_sleep(1);
    if ((++sp & 255u) == 0u) { if (xb_ld(&bar[XB_TMO])) break; if (sp > XB_SPIN_CAP) { atomicAdd(&bar[XB_TMO], 1u); break; } }
  }
  nloc = mine > 0u ? mine : 1u; nx = cnt > 0u ? cnt : 1u;
}
DEV void xcd_barrier(const XcdBarrier& b) {
  asm volatile("s_waitcnt vmcnt(0)" ::: "memory");
  __syncthreads();
  if (threadIdx.x == 0) {
    unsigned* bar = b.bar;
    __builtin_amdgcn_s_waitcnt(0);
    unsigned nloc = b.st[0], nx = b.st[1];
    if (nloc == 0u) { xcd_barrier_complete(bar, b.x, nloc, nx); b.st[0] = nloc; b.st[1] = nx; }
    const unsigned old = xb_add(&bar[XB_XSUB(b.x)], 1u);
    const unsigned gen = old / nloc;
    if (old + 1u == (gen + 1u) * nloc) {
      __builtin_amdgcn_fence(__ATOMIC_RELEASE, "agent");
      asm volatile("s_waitcnt vmcnt(0)" ::: "memory");
      const unsigned og = xb_add(&bar[XB_TOP], 1u);
      const unsigned tg = og / nx;
      if (og + 1u == (tg + 1u) * nx) xb_add(&bar[XB_TOPGEN], 1u);
      else XB_SPIN(xb_ld(&bar[XB_TOPGEN]) == tg, bar);
      __builtin_amdgcn_fence(__ATOMIC_ACQUIRE, "agent");
      xb_add(&bar[XB_XGEN(b.x)], 1u);
      asm volatile("s_waitcnt vmcnt(0)" ::: "memory");
    } else {
      XB_SPIN(xb_ld(&bar[XB_XGEN(b.x)]) == gen, bar);
      __builtin_amdgcn_fence(__ATOMIC_ACQUIRE, "agent");
      asm volatile("s_waitcnt vmcnt(0)" ::: "memory");
    }
  }
  __syncthreads();
}

template <bool COOP>
__global__ void __launch_bounds__(NBLK, 2) fwd_kernel(Params p) {
  __shared__ __attribute__((aligned(16))) char smem[73728 + 16];
  XcdBarrier xb;
  if (COOP) {
    if (threadIdx.x == 0) *(uint4*)(smem + 73728) = make_uint4(0u, 0u, 0u, 0u);
    __syncthreads();
    xb = xcd_barrier_post((unsigned*)(p.ws + OFF_BAR), (volatile LAS unsigned*)(smem + 73728));
    if (p.ph_hi > 1000) cg::this_grid().sync();
  }
#ifndef REPMASK
#define REPMASK 0
#endif
#define PH_BEGIN(k) if (p.ph_lo <= (k) && (k) < p.ph_hi) for (int rep_ = 0; rep_ < (((REPMASK >> (k)) & 1) ? 2 : 1); ++rep_) { if (rep_) __syncthreads();
#define PH_END(k) } if (COOP) { if (p.ph_lo <= (k) && (k) + 1 < p.ph_hi) xcd_barrier(xb); }
  PH_BEGIN(0) phase0(p, smem); PH_END(0)
  PH_BEGIN(1) { Epi1 e{(const float*)(p.ws + OFF_RS0), (bf16_t*)(p.ws + OFF_A), (bf16_t*)(p.ws + OFF_B), (bf16_t*)(p.ws + OFF_C), (float*)(p.ws + OFF_VST)};
                gemm_phase((const bf16_t*)(p.ws + OFF_E), (const bf16_t*)(p.ws + OFF_W1), 6144, 1024, e, (bf16_t*)smem); } PH_END(1)
  PH_BEGIN(2) sgu_phase(p, smem); PH_END(2)
  PH_BEGIN(3) { EpiRes e{p.in[0], p.in[1], (float*)(p.ws + OFF_A), (bf16_t*)(p.ws + OFF_E + 34603008), (float*)(p.ws + OFF_SS1)};
                gemm_phase((const bf16_t*)(p.ws + OFF_D), (const bf16_t*)(p.ws + OFF_W2), 1024, 2048, e, (bf16_t*)smem, true); } PH_END(3)
  PH_BEGIN(4) { Epi3 e{(const float*)(p.ws + OFF_SS1), (bf16_t*)(p.ws + OFF_B), (bf16_t*)(p.ws + OFF_C)};
                gemm_phase((const bf16_t*)(p.ws + OFF_E + 34603008), (const bf16_t*)(p.ws + OFF_W3), 4096, 1024, e, (bf16_t*)smem); } PH_END(4)
  PH_BEGIN(5) conv_phase(p, smem); } if (COOP) xcd_barrier(xb); if (p.ph_lo <= 5 && 5 < p.ph_hi) { gate_phase(p, smem); PH_END(5)
  PH_BEGIN(6) intra_phase(p, smem); PH_END(6)
  PH_BEGIN(7) scan_phase(p, smem); PH_END(7)
  PH_BEGIN(8) hnorm_phase(p); PH_END(8)
  PH_BEGIN(9) { const float* x1 = (const float*)(p.ws + OFF_A);
                EpiRes e{x1, x1 + (size_t)NP * DM, p.out + O_Y, nullptr, (float*)(p.ws + OFF_SS2)};
                gemm_phase((const bf16_t*)(p.ws + OFF_F), (const bf16_t*)(p.ws + OFF_W4), 1024, 2048, e, (bf16_t*)smem, true); } PH_END(9)
  PH_BEGIN(10) final_phase(p); }
}

extern "C" void kernel_launch(void* const* d_in, const int* in_sizes, int n_in, void* d_out, int out_size, void* d_ws, size_t ws_size, hipStream_t stream) {
  static int grid = 0;
  if (grid == 0) {
    int dev = 0, cus = 0, per_cu = 0;
    hipGetDevice(&dev);
    hipDeviceGetAttribute(&cus, hipDeviceAttributeMultiprocessorCount, dev);
    hipOccupancyMaxActiveBlocksPerMultiprocessor(&per_cu, (const void*)fwd_kernel<true>, NBLK, 0);
    if (per_cu < 1) per_cu = 1;
    if (per_cu > 2) per_cu = 2;
    grid = cus * per_cu;
    if (ws_size < WS_END) { fprintf(stderr, "kernel_launch: workspace too small (%zu < %zu)\n", ws_size, (size_t)WS_END); grid = -1; }
  }
  if (grid < 0) return;
  Params p{};
  for (int i = 0; i < 25; ++i) p.in[i] = (const float*)d_in[i];
  p.out = (float*)d_out; p.ws = (char*)d_ws;
#if MULTI_LAUNCH
  for (int ph = 0; ph < NPHASE; ++ph) {
    p.ph_lo = ph; p.ph_hi = ph + 1;
    hipLaunchKernelGGL(fwd_kernel<false>, dim3(grid), dim3(NBLK), 0, stream, p);
  }
#else
  p.ph_lo = 0; p.ph_hi = NPHASE;
  (void)hipMemsetAsync((char*)d_ws + OFF_BAR, 0, 16384, stream);
  void* args[] = {&p};
  hipError_t e = hipLaunchCooperativeKernel((const void*)fwd_kernel<true>, dim3(grid), dim3(NBLK), args, 0, stream);
  if (e != hipSuccess) fprintf(stderr, "cooperative launch failed: %s (grid %d)\n", hipGetErrorString(e), grid);
#endif
}
```

```cpp
#include <hip/hip_runtime.h>
#include <hip/hip_cooperative_groups.h>
#include <cstdio>
#include <cstdint>
namespace cg = cooperative_groups;

#ifndef MULTI_LAUNCH
#define MULTI_LAUNCH 0
#endif

typedef unsigned short bf16_t;
typedef short bf16x8 __attribute__((ext_vector_type(8)));
typedef float f32x16 __attribute__((ext_vector_type(16)));
typedef float f32x4 __attribute__((ext_vector_type(4)));
typedef float f32x2 __attribute__((ext_vector_type(2)));
typedef unsigned u32x4 __attribute__((ext_vector_type(4)));
typedef unsigned u32x2 __attribute__((ext_vector_type(2)));
#define DEV __device__ __forceinline__
#define MFMA32(a, b, c) __builtin_amdgcn_mfma_f32_32x32x16_bf16((a), (b), (c), 0, 0, 0)

constexpr int T = 16896, NP = 16384, DM = 1024, E = 2048, NBLK = 256;
constexpr int NPHASE = 11;
constexpr size_t SLOT = 69206016;
constexpr size_t OFF_A = 0;
constexpr size_t OFF_B = SLOT;
constexpr size_t OFF_C = 2 * SLOT;
constexpr size_t OFF_D = 3 * SLOT;
constexpr size_t OFF_E = 4 * SLOT;
constexpr size_t OFF_F = 5 * SLOT;
constexpr size_t OFF_W1 = 6 * SLOT;
constexpr size_t OFF_W2 = OFF_W1 + 12582912;
constexpr size_t OFF_W3 = OFF_W2 + 4194304;
constexpr size_t OFF_W4 = OFF_W3 + 8388608;
constexpr size_t OFF_WM = OFF_W4 + 4194304;
constexpr size_t OFF_WMS = OFF_WM + 262144;
constexpr size_t OFF_SW = OFF_WMS + 262144;
constexpr size_t OFF_VST = OFF_SW + 69206016;
constexpr size_t OFF_RS0 = OFF_VST + 4325376;
constexpr size_t OFF_SS1 = OFF_RS0 + 67584;
constexpr size_t OFF_SS2 = OFF_SS1 + 1081344;
constexpr size_t OFF_GB = OFF_SS2 + 1081344;
constexpr size_t OFF_GU = OFF_GB + 270336;
constexpr size_t OFF_GA = OFF_GU + 270336;
constexpr size_t OFF_WINTER = OFF_GA + 270336;
constexpr size_t OFF_WUPD = OFF_WINTER + 270336;
constexpr size_t OFF_DENI = OFF_WUPD + 270336;
constexpr size_t OFF_ENEGM = OFF_DENI + 270336;
constexpr size_t OFF_DINV = OFF_ENEGM + 270336;
constexpr size_t OFF_CHS = OFF_DINV + 270336;
constexpr size_t OFF_DECAY = OFF_CHS + 8192;
constexpr size_t OFF_GP = OFF_DECAY + 8192;
constexpr size_t OFF_BAR = OFF_GP + 1081344;
constexpr size_t OFF_GT = OFF_BAR + 16384;
constexpr size_t WS_END = OFF_GT + 524288;
constexpr size_t O_Y = 0;
constexpr size_t O_SGUV = 17301504;
constexpr size_t O_CP = 18350080;
constexpr size_t O_NP = 20447232;
constexpr size_t O_MP = 20451328;
constexpr size_t O_CONVP = 20451336;
constexpr size_t O_CS = 20463624;
constexpr size_t O_NS = 54018056;
constexpr size_t O_MS = 54083592;
constexpr size_t O_CONVS = 54083720;

struct Params {
  const float* in[25];
  float* out;
  char* ws;
  int ph_lo, ph_hi;
};

typedef __bf16 bf16v2 __attribute__((ext_vector_type(2)));
DEV unsigned cvt_pk_bf16(float lo, float hi) { f32x2 v = {lo, hi}; bf16v2 b = __builtin_convertvector(v, bf16v2); return __builtin_bit_cast(unsigned, b); }
DEV float bf_lo(unsigned u) { return __uint_as_float(u << 16); }
DEV float bf_hi(unsigned u) { return __uint_as_float(u & 0xffff0000u); }
DEV float bf1(bf16_t b) { return __uint_as_float(((unsigned)b) << 16); }
DEV bf16_t f2bf(float x) { return (bf16_t)(cvt_pk_bf16(x, 0.f) & 0xffffu); }
DEV float sigmoidf_(float x) { return __builtin_amdgcn_rcpf(1.f + __builtin_amdgcn_exp2f(-1.4426950408889634f * x)); }
DEV float siluf_(float x) { return x * __builtin_amdgcn_rcpf(1.f + __builtin_amdgcn_exp2f(-1.4426950408889634f * x)); }
DEV float geluf_(float x) { const float x2 = x * x; const float t = x * (-2.302208198092545f - 0.10294324517f * x2); return x * __builtin_amdgcn_rcpf(1.f + __builtin_amdgcn_exp2f(t)); }
DEV int crow(int reg, int h) { return (reg & 3) + 8 * (reg >> 2) + 4 * h; }
DEV float wave_sum(float v) {
#pragma unroll
  for (int o = 1; o < 64; o <<= 1) v += __shfl_xor(v, o);
  return v;
}
DEV bf16x8 as_bf16x8(u32x4 v) { return __builtin_bit_cast(bf16x8, v); }

DEV void transpose_tile(const float* __restrict__ W, int K, int N, const float* __restrict__ gain, bf16_t* __restrict__ WT, int tile, float* scr) {
  const int tid = threadIdx.x;
  const int ntn = N / 64, kb = tile / ntn, nb = tile % ntn, k0 = kb * 64, n0 = nb * 64;
#pragma unroll
  for (int j = 0; j < 4; ++j) {
    const int c = tid + 256 * j, r = c >> 4, c4 = (c & 15) * 4;
    f32x4 v = *(const f32x4*)(W + (size_t)(k0 + r) * N + n0 + c4);
    const float g = gain ? gain[k0 + r] : 1.f;
    scr[r * 65 + c4 + 0] = v.x * g; scr[r * 65 + c4 + 1] = v.y * g; scr[r * 65 + c4 + 2] = v.z * g; scr[r * 65 + c4 + 3] = v.w * g;
  }
  __syncthreads();
  {
    const int n = tid >> 2, ks = (tid & 3) * 16;
    u32x4 o0, o1;
    const float* s = scr + ks * 65 + n;
    o0.x = cvt_pk_bf16(s[0 * 65], s[1 * 65]); o0.y = cvt_pk_bf16(s[2 * 65], s[3 * 65]); o0.z = cvt_pk_bf16(s[4 * 65], s[5 * 65]); o0.w = cvt_pk_bf16(s[6 * 65], s[7 * 65]);
    o1.x = cvt_pk_bf16(s[8 * 65], s[9 * 65]); o1.y = cvt_pk_bf16(s[10 * 65], s[11 * 65]); o1.z = cvt_pk_bf16(s[12 * 65], s[13 * 65]); o1.w = cvt_pk_bf16(s[14 * 65], s[15 * 65]);
    bf16_t* dst = WT + (size_t)(n0 + n) * K + k0 + ks;
    *(u32x4*)dst = o0; *(u32x4*)(dst + 8) = o1;
  }
  __syncthreads();
}

DEV void phase0(const Params& p, char* smem) {
  float* scr = (float*)smem;
  const int nb = gridDim.x, bid = blockIdx.x, tid = threadIdx.x;
  bf16_t* W1 = (bf16_t*)(p.ws + OFF_W1); bf16_t* W2 = (bf16_t*)(p.ws + OFF_W2); bf16_t* W3 = (bf16_t*)(p.ws + OFF_W3); bf16_t* W4 = (bf16_t*)(p.ws + OFF_W4);
  constexpr int T1 = 16 * 96, T2 = 32 * 16, T3 = 16 * 64, T4 = 32 * 16;
  for (int it = bid; it < T1 + T2 + T3 + T4; it += nb) {
    int r = it;
    if (r < T1) { transpose_tile(p.in[8], 1024, 6144, p.in[6], W1, r, scr); continue; } r -= T1;
    if (r < T2) { transpose_tile(p.in[13], 2048, 1024, nullptr, W2, r, scr); continue; } r -= T2;
    if (r < T3) { transpose_tile(p.in[14], 1024, 4096, p.in[6] + 1024, W3, r, scr); continue; } r -= T3;
    transpose_tile(p.in[24], 2048, 1024, nullptr, W4, r, scr);
  }
  {
    bf16_t* XB = (bf16_t*)(p.ws + OFF_E); float* RS0 = (float*)(p.ws + OFF_RS0);
    const int lane = tid & 63, wid = tid >> 6;
    for (int row = bid * 4 + wid; row < T; row += nb * 4) {
      const float* xr = row < NP ? p.in[0] + (size_t)row * DM : p.in[1] + (size_t)(row - NP) * DM;
      f32x4 v[4]; float ss = 0.f;
#pragma unroll
      for (int j = 0; j < 4; ++j) { v[j] = *(const f32x4*)(xr + j * 256 + lane * 4); ss += v[j].x * v[j].x + v[j].y * v[j].y + v[j].z * v[j].z + v[j].w * v[j].w; }
      ss = wave_sum(ss);
#pragma unroll
      for (int j = 0; j < 4; ++j) { u32x2 o; o.x = cvt_pk_bf16(v[j].x, v[j].y); o.y = cvt_pk_bf16(v[j].z, v[j].w); *(u32x2*)(XB + (size_t)row * DM + j * 256 + lane * 4) = o; }
      if (lane == 0) RS0[row] = rsqrtf(ss * (1.f / DM) + 1e-6f);
    }
  }
  {
    bf16_t* GT = (bf16_t*)(p.ws + OFF_GT);
    const float* wq = p.in[17]; const float* wk = p.in[18]; const float* wv = p.in[19]; const float* wgt = p.in[20];
    for (int idx = bid * 256 + tid; idx < 32 * 4096; idx += nb * 256) {
      const int j = idx >> 12, k = idx & 4095;
      bf16_t hi = 0, lo = 0;
      if (j < 8) {
        const int part = k >> 11, ch = k & 2047, nbk = ch >> 2, i = ch & 3, cb4 = ch & ~3;
        float g = 0.f;
#pragma unroll
        for (int o = 0; o < 4; ++o) {
          if (part == 0) g += wq[nbk * 16 + i * 4 + o] * wgt[(size_t)(cb4 + o) * 8 + j] + wk[nbk * 16 + i * 4 + o] * wgt[(size_t)(E + cb4 + o) * 8 + j];
          else g += wv[nbk * 16 + i * 4 + o] * wgt[(size_t)(2 * E + cb4 + o) * 8 + j];
        }
        hi = f2bf(g); lo = f2bf(g - bf1(hi));
      }
      GT[(size_t)j * 4096 + k] = hi; GT[(size_t)(32 + j) * 4096 + k] = lo;
    }
  }
  {
    bf16_t* WM = (bf16_t*)(p.ws + OFF_WM); bf16_t* WMS = (bf16_t*)(p.ws + OFF_WMS);
    const float* ws_ = p.in[11];
    for (int i = bid * 256 + tid; i < 8 * 128 * 128; i += nb * 256) {
      const int g = i >> 14, t = (i >> 7) & 127, s = i & 127;
      WM[i] = f2bf(s <= t ? ws_[i] : 0.f);
      const int tl = t & 15, sl = s & 15;
      WMS[i] = f2bf(((t >> 4) == (s >> 4) && sl <= tl) ? ws_[(g << 14) + tl * 128 + sl] : 0.f);
    }
  }
}

constexpr int LDS_ST = 72;
constexpr int TILE_E = 128 * LDS_ST;

constexpr int TILE_G = 128 * 64;

template <int MI, class Epi>
DEV void gemm_tile(const bf16_t* __restrict__ X, const bf16_t* __restrict__ W, const int K, const int row0, const int col0, const Epi& epi, bf16_t* sm) {
  int tid_ = threadIdx.x; asm volatile("" : "+v"(tid_));
  const int tid = tid_, lane = tid & 63, wid = tid >> 6, wr = wid >> 1, wc = wid & 1;
  const int l31 = lane & 31, hh = lane >> 5;
  bf16_t* sa = sm; bf16_t* sb = sm + 2 * TILE_G;
  f32x16 acc[MI][2];
#pragma unroll
  for (int a = 0; a < MI; ++a)
#pragma unroll
    for (int b = 0; b < 2; ++b)
#pragma unroll
      for (int i = 0; i < 16; ++i) acc[a][b][i] = 0.f;
  const int srow = wid * 8 + (lane >> 3);
  const int sc8 = ((lane & 7) ^ (((wid & 1) << 2) | (lane >> 4))) * 8;
  const bf16_t* xp = X + (size_t)(row0 + srow) * K + sc8;
  const bf16_t* wp = W + (size_t)(col0 + srow) * K + sc8;
  const int sdst = wid * 8 * 64 + lane * 8;
#define GEMM_STAGE(bufi, k0) do { _Pragma("unroll") for (int j = 0; j < 4; ++j) { \
      if (j < 2 * MI) __builtin_amdgcn_global_load_lds((const unsigned*)(xp + (size_t)(32 * j) * K + (k0)), (unsigned*)(sa + (bufi) * TILE_G + sdst + j * 2048), 16, 0, 0); \
      __builtin_amdgcn_global_load_lds((const unsigned*)(wp + (size_t)(32 * j) * K + (k0)), (unsigned*)(sb + (bufi) * TILE_G + sdst + j * 2048), 16, 0, 0); } } while (0)
  GEMM_STAGE(0, 0); GEMM_STAGE(1, 64);
  const int swz = (l31 >> 1) & 7;
  int koff[4];
#pragma unroll
  for (int kk = 0; kk < 4; ++kk) koff[kk] = ((2 * kk + hh) ^ swz) * 8;
  const int nk = K >> 6;
  for (int kt = 0; kt < nk; ++kt) {
    const int buf = kt & 1;
    if (kt + 1 < nk) { if (MI == 2) asm volatile("s_waitcnt vmcnt(8)" ::: "memory"); else asm volatile("s_waitcnt vmcnt(6)" ::: "memory"); }
    else asm volatile("s_waitcnt vmcnt(0)" ::: "memory");
    __builtin_amdgcn_s_barrier();
    const bf16_t* ca = sa + buf * TILE_G + (wr * 32 * MI + l31) * 64;
    const bf16_t* cb = sb + buf * TILE_G + (wc * 64 + l31) * 64;
    bf16x8 fa[4][MI], fb[4][2];
#pragma unroll
    for (int kk = 0; kk < 4; ++kk) {
#pragma unroll
      for (int mi = 0; mi < MI; ++mi) fa[kk][mi] = *(const bf16x8*)(ca + mi * 32 * 64 + koff[kk]);
      fb[kk][0] = *(const bf16x8*)(cb + koff[kk]); fb[kk][1] = *(const bf16x8*)(cb + 32 * 64 + koff[kk]);
    }
    asm volatile("s_waitcnt lgkmcnt(0)" ::: "memory");
    __builtin_amdgcn_s_barrier();
    if (kt + 2 < nk) GEMM_STAGE(buf, (kt + 2) * 64);
    __builtin_amdgcn_sched_barrier(0);
    __builtin_amdgcn_s_setprio(1);
#pragma unroll
    for (int kk = 0; kk < 4; ++kk)
#pragma unroll
      for (int mi = 0; mi < MI; ++mi) {
        acc[mi][0] = MFMA32(fb[kk][0], fa[kk][mi], acc[mi][0]); acc[mi][1] = MFMA32(fb[kk][1], fa[kk][mi], acc[mi][1]);
      }
    __builtin_amdgcn_s_setprio(0);
  }
#undef GEMM_STAGE
  epi.template run<MI>(acc, row0 + wr * 32 * MI, col0 + wc * 64, l31, hh);
}

template <class Epi>
DEV void gemm_phase(const bf16_t* X, const bf16_t* W, int N, int K, const Epi& epi, bf16_t* sm, bool half_tail = false) {
  const int ntn = N / 128, ntm = T / 128, nt = ntn * ntm;
  const int rem = nt % (int)gridDim.x;
  const int full_rows = (half_tail && rem > 0 && rem % ntn == 0) ? ntm - rem / ntn : ntm;
  for (int t = blockIdx.x; t < full_rows * ntn; t += gridDim.x) {
    const int tm = t / ntn, tn = t % ntn;
    gemm_tile<2>(X, W, K, tm * 128, tn * 128, epi, sm);
  }
  if (full_rows < ntm) {
    for (int t = blockIdx.x; t < (ntm - full_rows) * 2 * ntn; t += gridDim.x) {
      const int tmh = t / ntn, tn = t % ntn;
      gemm_tile<1>(X, W, K, full_rows * 128 + tmh * 64, tn * 128, epi, sm);
    }
  }
}

struct Epi1 {
  const float* rs0; bf16_t* U; bf16_t* VT; bf16_t* Z; float* VST;
  template <int MI> DEV void run(const f32x16 (&acc)[MI][2], int rbase, int cbase, int l31, int hh) const {
    const float rr[2] = {rs0[rbase + l31], rs0[rbase + 32 + l31]};
#pragma unroll
    for (int mi = 0; mi < MI; ++mi) {
      const int tok = rbase + mi * 32 + l31;
      const float r = rr[mi];
      if (cbase < 2048) {
#pragma unroll
        for (int ni = 0; ni < 2; ++ni)
#pragma unroll
          for (int g = 0; g < 4; ++g) {
            const int ch = cbase + ni * 32 + 8 * g + 4 * hh;
            u32x2 o; o.x = cvt_pk_bf16(geluf_(acc[mi][ni][4 * g] * r), geluf_(acc[mi][ni][4 * g + 1] * r));
            o.y = cvt_pk_bf16(geluf_(acc[mi][ni][4 * g + 2] * r), geluf_(acc[mi][ni][4 * g + 3] * r));
            *(u32x2*)(U + (size_t)tok * E + ch) = o;
          }
      } else if (cbase < 4096) {
        float s = 0.f, ss = 0.f;
#pragma unroll
        for (int ni = 0; ni < 2; ++ni)
#pragma unroll
          for (int i = 0; i < 16; ++i) {
            const int ch = cbase - 2048 + ni * 32 + crow(i, hh);
            const float v = geluf_(acc[mi][ni][i] * r);
            s += v; ss += v * v;
            VT[(size_t)ch * T + tok] = f2bf(v);
          }
        s += __shfl_xor(s, 32); ss += __shfl_xor(ss, 32);
        if (hh == 0) { f32x2 o; o.x = s; o.y = ss; *(f32x2*)(VST + ((size_t)tok * 32 + ((cbase - 2048) >> 6)) * 2) = o; }
      } else {
#pragma unroll
        for (int ni = 0; ni < 2; ++ni)
#pragma unroll
          for (int g = 0; g < 4; ++g) {
            const int ch = cbase - 4096 + ni * 32 + 8 * g + 4 * hh;
            u32x2 o; o.x = cvt_pk_bf16(acc[mi][ni][4 * g] * r, acc[mi][ni][4 * g + 1] * r);
            o.y = cvt_pk_bf16(acc[mi][ni][4 * g + 2] * r, acc[mi][ni][4 * g + 3] * r);
            *(u32x2*)(Z + (size_t)tok * E + ch) = o;
          }
      }
    }
  }
};

struct EpiRes {
  const float* res_p; const float* res_s;
  float* OUT; bf16_t* OUTB; float* SS;
  template <int MI> DEV void run(const f32x16 (&acc)[MI][2], int rbase, int cbase, int l31, int hh) const {
#pragma unroll
    for (int mi = 0; mi < MI; ++mi) {
      const int tok = rbase + mi * 32 + l31;
      const float* rp = tok < NP ? res_p + (size_t)tok * DM : res_s + (size_t)(tok - NP) * DM;
      f32x4 rva[2][4];
#pragma unroll
      for (int ni = 0; ni < 2; ++ni)
#pragma unroll
        for (int g = 0; g < 4; ++g) rva[ni][g] = *(const f32x4*)(rp + cbase + ni * 32 + 8 * g + 4 * hh);
      float ss = 0.f;
#pragma unroll
      for (int ni = 0; ni < 2; ++ni)
#pragma unroll
        for (int g = 0; g < 4; ++g) {
          const int ch = cbase + ni * 32 + 8 * g + 4 * hh;
          const f32x4 rv = rva[ni][g];
          f32x4 o; o.x = acc[mi][ni][4 * g] + rv.x; o.y = acc[mi][ni][4 * g + 1] + rv.y; o.z = acc[mi][ni][4 * g + 2] + rv.z; o.w = acc[mi][ni][4 * g + 3] + rv.w;
          ss += o.x * o.x + o.y * o.y + o.z * o.z + o.w * o.w;
          *(f32x4*)(OUT + (size_t)tok * DM + ch) = o;
          if (OUTB) { u32x2 b; b.x = cvt_pk_bf16(o.x, o.y); b.y = cvt_pk_bf16(o.z, o.w); *(u32x2*)(OUTB + (size_t)tok * DM + ch) = b; }
        }
      ss += __shfl_xor(ss, 32);
      if (hh == 0) SS[(size_t)tok * 16 + (cbase >> 6)] = ss;
    }
  }
};

struct Epi3 {
  const float* SS1; bf16_t* XM; bf16_t* Z2;
  template <int MI> DEV void run(const f32x16 (&acc)[MI][2], int rbase, int cbase, int l31, int hh) const {
    float sums[2];
#pragma unroll
    for (int mi = 0; mi < MI; ++mi) {
      float s = 0.f;
#pragma unroll
      for (int j = 0; j < 4; ++j) { const f32x4 v = *(const f32x4*)(SS1 + (size_t)(rbase + mi * 32 + l31) * 16 + 4 * j); s += v.x + v.y + v.z + v.w; }
      sums[mi] = s;
    }
#pragma unroll
    for (int mi = 0; mi < MI; ++mi) {
      const int tok = rbase + mi * 32 + l31;
      const float r = rsqrtf(sums[mi] * (1.f / DM) + 1e-6f);
      bf16_t* dst = cbase < 2048 ? XM + (size_t)tok * E + cbase : Z2 + (size_t)tok * E + cbase - 2048;
#pragma unroll
      for (int ni = 0; ni < 2; ++ni)
#pragma unroll
        for (int g = 0; g < 4; ++g) {
          u32x2 o; o.x = cvt_pk_bf16(acc[mi][ni][4 * g] * r, acc[mi][ni][4 * g + 1] * r);
          o.y = cvt_pk_bf16(acc[mi][ni][4 * g + 2] * r, acc[mi][ni][4 * g + 3] * r);
          *(u32x2*)(dst + ni * 32 + 8 * g + 4 * hh) = o;
        }
    }
  }
};

DEV void sgu_phase(const Params& p, char* smem) {
  const int tid = threadIdx.x, lane = tid & 63, wid = tid >> 6, l31 = lane & 31, hh = lane >> 5;
  float* smu = (float*)smem; float* srs = smu + 128;
  const bf16_t* U = (const bf16_t*)(p.ws + OFF_A); const bf16_t* VT = (const bf16_t*)(p.ws + OFF_B); const bf16_t* Z = (const bf16_t*)(p.ws + OFF_C);
  bf16_t* G = (bf16_t*)(p.ws + OFF_D);
  const float* VST = (const float*)(p.ws + OFF_VST);
  const float* lng = p.in[9]; const float* lnb = p.in[10]; const float* bs = p.in[12];
  for (int unit = blockIdx.x; unit < 132 * 8; unit += gridDim.x) {
    const int ci = unit >> 3, g = unit & 7, tok0 = ci * 128;
    const bool samp = ci >= 128;
    const bf16_t* WMg = (const bf16_t*)(p.ws + (samp ? OFF_WMS : OFF_WM)) + g * 16384;
    __syncthreads();
    if (tid < 128) {
      float s = 0.f, ss = 0.f;
      const f32x4* q = (const f32x4*)(VST + (size_t)(tok0 + tid) * 64);
#pragma unroll
      for (int j = 0; j < 16; ++j) { const f32x4 v = q[j]; s += v.x + v.z; ss += v.y + v.w; }
      const float mean = s * (1.f / E); const float var = ss * (1.f / E) - mean * mean;
      smu[tid] = mean; srs[tid] = rsqrtf(var + 1e-5f);
    }
    __syncthreads();
    const int cbase = g * 256 + wid * 64;
    bf16x8 af[2][8];
#pragma unroll
    for (int mi = 0; mi < 2; ++mi) {
      const int c = cbase + mi * 32 + l31;
      const float gg = lng[c], bb = lnb[c];
      u32x4 raws[8];
#pragma unroll
      for (int kk = 0; kk < 8; ++kk) raws[kk] = *(const u32x4*)(VT + (size_t)c * T + tok0 + kk * 16 + 8 * hh);
      __builtin_amdgcn_sched_barrier(0);
#pragma unroll
      for (int kk = 0; kk < 8; ++kk) {
        const int s0 = kk * 16 + 8 * hh;
        const u32x4 raw = raws[kk];
        const f32x4 m0 = *(const f32x4*)(smu + s0), m1 = *(const f32x4*)(smu + s0 + 4);
        const f32x4 r0 = *(const f32x4*)(srs + s0), r1 = *(const f32x4*)(srs + s0 + 4);
        float v[8];
        v[0] = (bf_lo(raw.x) - m0.x) * r0.x * gg + bb; v[1] = (bf_hi(raw.x) - m0.y) * r0.y * gg + bb;
        v[2] = (bf_lo(raw.y) - m0.z) * r0.z * gg + bb; v[3] = (bf_hi(raw.y) - m0.w) * r0.w * gg + bb;
        v[4] = (bf_lo(raw.z) - m1.x) * r1.x * gg + bb; v[5] = (bf_hi(raw.z) - m1.y) * r1.y * gg + bb;
        v[6] = (bf_lo(raw.w) - m1.z) * r1.z * gg + bb; v[7] = (bf_hi(raw.w) - m1.w) * r1.w * gg + bb;
        u32x4 pk; pk.x = cvt_pk_bf16(v[0], v[1]); pk.y = cvt_pk_bf16(v[2], v[3]); pk.z = cvt_pk_bf16(v[4], v[5]); pk.w = cvt_pk_bf16(v[6], v[7]);
        af[mi][kk] = as_bf16x8(pk);
        if (samp) {
          float* sv = p.out + O_SGUV + (size_t)(tok0 - NP + s0) * E + c;
#pragma unroll
          for (int j = 0; j < 8; ++j) sv[(size_t)j * E] = v[j];
        }
      }
    }
#pragma unroll
    for (int nt = 0; nt < 4; ++nt) {
      f32x16 acc[2];
#pragma unroll
      for (int i = 0; i < 16; ++i) { acc[0][i] = 0.f; acc[1][i] = 0.f; }
      const int tl = nt * 32 + l31;
      u32x4 bfrs[8];
#pragma unroll
      for (int kk = 0; kk < 8; ++kk) if (kk <= 2 * nt + 1) bfrs[kk] = *(const u32x4*)(WMg + tl * 128 + kk * 16 + 8 * hh);
      __builtin_amdgcn_sched_barrier(0);
#pragma unroll
      for (int kk = 0; kk < 8; ++kk) {
        if (kk <= 2 * nt + 1) {
          acc[0] = MFMA32(af[0][kk], as_bf16x8(bfrs[kk]), acc[0]);
          acc[1] = MFMA32(af[1][kk], as_bf16x8(bfrs[kk]), acc[1]);
        }
      }
      const int tok = tok0 + tl;
      const float bias = bs[g * 128 + (samp ? (tl & 15) : tl)];
      u32x2 uus[2][4], zzs[2][4];
#pragma unroll
      for (int mi = 0; mi < 2; ++mi)
#pragma unroll
        for (int q = 0; q < 4; ++q) {
          const int c = cbase + mi * 32 + 8 * q + 4 * hh;
          uus[mi][q] = *(const u32x2*)(U + (size_t)tok * E + c);
          zzs[mi][q] = *(const u32x2*)(Z + (size_t)tok * E + c);
        }
#pragma unroll
      for (int mi = 0; mi < 2; ++mi)
#pragma unroll
        for (int q = 0; q < 4; ++q) {
          const int c = cbase + mi * 32 + 8 * q + 4 * hh;
          const u32x2 uu = uus[mi][q];
          const u32x2 zz = zzs[mi][q];
          const float o0 = bf_lo(uu.x) * (acc[mi][4 * q] + bias) * siluf_(bf_lo(zz.x));
          const float o1 = bf_hi(uu.x) * (acc[mi][4 * q + 1] + bias) * siluf_(bf_hi(zz.x));
          const float o2 = bf_lo(uu.y) * (acc[mi][4 * q + 2] + bias) * siluf_(bf_lo(zz.y));
          const float o3 = bf_hi(uu.y) * (acc[mi][4 * q + 3] + bias) * siluf_(bf_hi(zz.y));
          u32x2 o; o.x = cvt_pk_bf16(o0, o1); o.y = cvt_pk_bf16(o2, o3);
          *(u32x2*)(G + (size_t)tok * E + c) = o;
        }
    }
  }
}

DEV int perm4(int g) { return ((g & 1) << 1) | (g >> 1); }

struct ConvHist { float x1[4], x2[4], x3[4]; };
DEV void conv_hist_init(ConvHist& H, const bf16_t* XM, const float* conv0, int t, int tt, int pos, bool samp, int ch) {
  if (pos == 0) {
    if (samp) {
      const float* c0 = conv0 + (size_t)((t - NP) >> 4) * 3 * E + ch;
      const f32x4 a = *(const f32x4*)(c0), b = *(const f32x4*)(c0 + E), c = *(const f32x4*)(c0 + 2 * E);
      H.x3[0] = a.x; H.x3[1] = a.y; H.x3[2] = a.z; H.x3[3] = a.w; H.x2[0] = b.x; H.x2[1] = b.y; H.x2[2] = b.z; H.x2[3] = b.w; H.x1[0] = c.x; H.x1[1] = c.y; H.x1[2] = c.z; H.x1[3] = c.w;
    } else {
#pragma unroll
      for (int i = 0; i < 4; ++i) { H.x1[i] = 0.f; H.x2[i] = 0.f; H.x3[i] = 0.f; }
    }
  } else if (tt == 0) {
    const u32x2 a = *(const u32x2*)(XM + (size_t)(t - 1) * E + ch), b = *(const u32x2*)(XM + (size_t)(t - 2) * E + ch), c = *(const u32x2*)(XM + (size_t)(t - 3) * E + ch);
    H.x1[0] = bf_lo(a.x); H.x1[1] = bf_hi(a.x); H.x1[2] = bf_lo(a.y); H.x1[3] = bf_hi(a.y);
    H.x2[0] = bf_lo(b.x); H.x2[1] = bf_hi(b.x); H.x2[2] = bf_lo(b.y); H.x2[3] = bf_hi(b.y);
    H.x3[0] = bf_lo(c.x); H.x3[1] = bf_hi(c.x); H.x3[2] = bf_lo(c.y); H.x3[3] = bf_hi(c.y);
  }
}

DEV float reduce16(float (&r16)[16], int lane) {
#pragma unroll
  for (int i = 0; i < 8; ++i) { const bool up = lane & 8; const float send = up ? r16[i] : r16[i + 8]; const float keep = up ? r16[i + 8] : r16[i]; r16[i] = keep + __shfl_xor(send, 8); }
#pragma unroll
  for (int i = 0; i < 4; ++i) { const bool up = lane & 4; const float send = up ? r16[i] : r16[i + 4]; const float keep = up ? r16[i + 4] : r16[i]; r16[i] = keep + __shfl_xor(send, 4); }
#pragma unroll
  for (int i = 0; i < 2; ++i) { const bool up = lane & 2; const float send = up ? r16[i] : r16[i + 2]; const float keep = up ? r16[i + 2] : r16[i]; r16[i] = keep + __shfl_xor(send, 2); }
  { const bool up = lane & 1; const float send = up ? r16[0] : r16[1]; const float keep = up ? r16[1] : r16[0]; r16[0] = keep + __shfl_xor(send, 1); }
  float tot = r16[0];
  tot += __shfl_xor(tot, 16); tot += __shfl_xor(tot, 32);
  return tot;
}

DEV void conv_phase(const Params& p, char* smem) {
  const int tid = threadIdx.x;
  const bf16_t* XM = (const bf16_t*)(p.ws + OFF_B);
  bf16_t* XC = (bf16_t*)(p.ws + OFF_D); bf16_t* QF = (bf16_t*)(p.ws + OFF_E); bf16_t* VF = (bf16_t*)(p.ws + OFF_F);
  bf16_t* KF = (bf16_t*)(p.out + O_CS); bf16_t* KTF = (bf16_t*)(p.out + O_Y);
  const float* conv0 = p.in[5]; const float* convw = p.in[15]; const float* convb = p.in[16];
  const float* wq = p.in[17]; const float* wk = p.in[18]; const float* wv = p.in[19];
  const float kscale = 0.04419417382415922f;
  bf16_t* QS = (bf16_t*)(smem + 4096); bf16_t* KS = QS + 128 * 136;
  for (int unit = blockIdx.x; unit < (T / 16) * 2; unit += gridDim.x) {
    const int hf = unit & 1, tok0 = (unit >> 1) * 16, cg = tok0 >> 6, tt0 = tok0 & 63;
    const bool samp = tok0 >= NP;
    const int nb = hf * 256 + tid, ch = nb * 4, h = nb >> 7, nl = nb & 127;
    const int pd = (nl & ~3) * 4 + perm4(nl & 3) * 4, kstep = pd >> 4, hhq = (pd >> 3) & 1, j0 = pd & 7;
    float cw[4][4], cb[4], q_w[4][4], k_w[4][4], v_w[4][4];
#pragma unroll
    for (int j = 0; j < 4; ++j) { const f32x4 v = *(const f32x4*)(convw + j * E + ch); cw[j][0] = v.x; cw[j][1] = v.y; cw[j][2] = v.z; cw[j][3] = v.w; }
    { const f32x4 v = *(const f32x4*)(convb + ch); cb[0] = v.x; cb[1] = v.y; cb[2] = v.z; cb[3] = v.w; }
#pragma unroll
    for (int i = 0; i < 4; ++i) {
      const f32x4 a = *(const f32x4*)(wq + nb * 16 + i * 4), b = *(const f32x4*)(wk + nb * 16 + i * 4), c = *(const f32x4*)(wv + nb * 16 + i * 4);
      q_w[i][0] = a.x; q_w[i][1] = a.y; q_w[i][2] = a.z; q_w[i][3] = a.w;
      k_w[i][0] = b.x * kscale; k_w[i][1] = b.y * kscale; k_w[i][2] = b.z * kscale; k_w[i][3] = b.w * kscale;
      v_w[i][0] = c.x; v_w[i][1] = c.y; v_w[i][2] = c.z; v_w[i][3] = c.w;
    }
    u32x2 xrow[16];
#pragma unroll
    for (int i = 0; i < 16; ++i) xrow[i] = *(const u32x2*)(XM + (size_t)(tok0 + i) * E + ch);
    __syncthreads();
    ConvHist H;
    const int srun = (((tid >> 7) * 32 + kstep) * 2 + hhq) * 136 + j0;
#pragma unroll
    for (int tb8 = 0; tb8 < 2; ++tb8) {
      unsigned kacc[4][4], vacc[4][4];
#pragma unroll
      for (int pr = 0; pr < 4; ++pr) {
        float kq[2][4], vq[2][4];
#pragma unroll
        for (int u = 0; u < 2; ++u) {
          const int ttl = tb8 * 8 + pr * 2 + u, t = tok0 + ttl;
          const int pos = samp ? ttl : (t & 8191);
          conv_hist_init(H, XM, conv0, t, ttl, pos, samp, ch);
          const u32x2 xr = xrow[ttl];
          float x0[4] = {bf_lo(xr.x), bf_hi(xr.x), bf_lo(xr.y), bf_hi(xr.y)};
          float xc[4];
#pragma unroll
          for (int i = 0; i < 4; ++i) xc[i] = siluf_(cb[i] + cw[0][i] * H.x3[i] + cw[1][i] * H.x2[i] + cw[2][i] * H.x1[i] + cw[3][i] * x0[i]);
          float qv[4];
#pragma unroll
          for (int o = 0; o < 4; ++o) {
            qv[o] = xc[0] * q_w[0][o] + xc[1] * q_w[1][o] + xc[2] * q_w[2][o] + xc[3] * q_w[3][o];
            kq[u][o] = xc[0] * k_w[0][o] + xc[1] * k_w[1][o] + xc[2] * k_w[2][o] + xc[3] * k_w[3][o];
            vq[u][o] = x0[0] * v_w[0][o] + x0[1] * v_w[1][o] + x0[2] * v_w[2][o] + x0[3] * v_w[3][o];
          }
          { u32x2 o; o.x = cvt_pk_bf16(xc[0], xc[1]); o.y = cvt_pk_bf16(xc[2], xc[3]); *(u32x2*)(XC + (size_t)t * E + ch) = o; }
          { u32x2 o; o.x = cvt_pk_bf16(qv[0], qv[1]); o.y = cvt_pk_bf16(qv[2], qv[3]); *(u32x2*)(QS + srun + ttl * 8) = o; }
          { u32x2 o; o.x = cvt_pk_bf16(kq[u][0], kq[u][1]); o.y = cvt_pk_bf16(kq[u][2], kq[u][3]); *(u32x2*)(KS + srun + ttl * 8) = o; }
          if (samp) { if (pos >= 13) { f32x4 o; o.x = x0[0]; o.y = x0[1]; o.z = x0[2]; o.w = x0[3]; *(f32x4*)(p.out + O_CONVS + ((size_t)((t - NP) >> 4) * 3 + (pos - 13)) * E + ch) = o; } }
          else if (pos >= 8189) { f32x4 o; o.x = x0[0]; o.y = x0[1]; o.z = x0[2]; o.w = x0[3]; *(f32x4*)(p.out + O_CONVP + ((size_t)(t >> 13) * 3 + (pos - 8189)) * E + ch) = o; }
#pragma unroll
          for (int i = 0; i < 4; ++i) { H.x3[i] = H.x2[i]; H.x2[i] = H.x1[i]; H.x1[i] = x0[i]; }
        }
#pragma unroll
        for (int o = 0; o < 4; ++o) { kacc[o][pr] = cvt_pk_bf16(kq[0][o], kq[1][o]); vacc[o][pr] = cvt_pk_bf16(vq[0][o], vq[1][o]); }
      }
      const int tg = tt0 + tb8 * 8, ks = tg >> 4, hht = (tg >> 3) & 1;
#pragma unroll
      for (int o = 0; o < 4; ++o) {
        const int d = nl * 4 + o;
        const size_t fo = ((((size_t)(cg * 4 + h) * 16 + (d >> 5)) * 4 + ks) * 64 + (d & 31) + 32 * hht) * 8;
        u32x4 kk_; kk_.x = kacc[o][0]; kk_.y = kacc[o][1]; kk_.z = kacc[o][2]; kk_.w = kacc[o][3];
        u32x4 vv_; vv_.x = vacc[o][0]; vv_.y = vacc[o][1]; vv_.z = vacc[o][2]; vv_.w = vacc[o][3];
        *(u32x4*)(KTF + fo) = kk_;
        *(u32x4*)(VF + fo) = vv_;
      }
    }
    __syncthreads();
#pragma unroll 2
    for (int i = 0; i < 8; ++i) {
      const int pc = i * 256 + tid, run = pc >> 4, l16 = pc & 15;
      const int hl = run >> 6, ks_ = (run >> 1) & 31, hq_ = run & 1;
      const size_t dst = ((size_t)((cg * 4 + 2 * hf + hl) * 64 + (tt0 >> 5) * 32 + ks_)) * 512 + ((tt0 & 31) + l16 + 32 * hq_) * 8;
      *(u32x4*)(QF + dst) = *(const u32x4*)(QS + run * 136 + l16 * 8);
      *(u32x4*)(KF + dst) = *(const u32x4*)(KS + run * 136 + l16 * 8);
    }
  }
}

DEV void gate_phase(const Params& p, char* smem) {
  const int tid = threadIdx.x, lane = tid & 63, wid = tid >> 6, l31 = lane & 31, hh = lane >> 5;
  float* sig = (float*)smem; float* slf = sig + 256;
  float* red = (float*)(smem + 2048);
  const bf16_t* XMb = (const bf16_t*)(p.ws + OFF_B); const bf16_t* XCb = (const bf16_t*)(p.ws + OFF_D);
  const bf16_t* GT = (const bf16_t*)(p.ws + OFF_GT);
  const float* bgt = p.in[21];
  float* GB = (float*)(p.ws + OFF_GB); float* GU = (float*)(p.ws + OFF_GU); float* GA = (float*)(p.ws + OFF_GA); float* CHS = (float*)(p.ws + OFF_CHS);
  for (int unit = blockIdx.x; unit < T / 64; unit += gridDim.x) {
    const int tok0 = unit * 64;
    const bool samp = tok0 >= NP;
    __syncthreads();
    {
      bf16_t* slab = (bf16_t*)smem;
      f32x16 a0, a1;
#pragma unroll
      for (int i = 0; i < 16; ++i) { a0[i] = 0.f; a1[i] = 0.f; }
      const int lrow = tid >> 5, lc8 = (tid & 31) * 8;
      const bf16_t* gxc = XCb + (size_t)(tok0 + lrow) * E + lc8;
      const bf16_t* gxm = XMb + (size_t)(tok0 + lrow) * E + lc8;
      const bf16_t* gtp = GT + (size_t)(l31 < 8 ? l31 : 8) * 4096 + wid * 64 + 8 * hh;
      u32x4 ar[8], bcur[8], bnxt[8];
#pragma unroll
      for (int i = 0; i < 8; ++i) ar[i] = *(const u32x4*)(gxc + (size_t)(8 * i) * E);
#pragma unroll
      for (int i = 0; i < 4; ++i) { bcur[i] = *(const u32x4*)(gtp + i * 16); bcur[4 + i] = *(const u32x4*)(gtp + (size_t)32 * 4096 + i * 16); }
#pragma unroll
      for (int i = 0; i < 8; ++i) *(u32x4*)(slab + (lrow + 8 * i) * 264 + lc8) = ar[i];
      __syncthreads();
#pragma unroll 1
      for (int s = 0; s < 16; ++s) {
        const int buf = s & 1;
        if (s + 1 < 16) {
          const bf16_t* g = ((s + 1) < 8 ? gxc : gxm) + ((s + 1) & 7) * 256;
#pragma unroll
          for (int i = 0; i < 8; ++i) ar[i] = *(const u32x4*)(g + (size_t)(8 * i) * E);
#pragma unroll
          for (int i = 0; i < 4; ++i) { bnxt[i] = *(const u32x4*)(gtp + (s + 1) * 256 + i * 16); bnxt[4 + i] = *(const u32x4*)(gtp + (size_t)32 * 4096 + (s + 1) * 256 + i * 16); }
        }
        const bf16_t* sb0 = slab + buf * (64 * 264) + l31 * 264 + wid * 64 + 8 * hh;
#pragma unroll
        for (int i = 0; i < 4; ++i) {
          const bf16x8 x0 = *(const bf16x8*)(sb0 + i * 16), x1 = *(const bf16x8*)(sb0 + 32 * 264 + i * 16);
          a0 = MFMA32(x0, as_bf16x8(bcur[i]), a0); a1 = MFMA32(x1, as_bf16x8(bcur[i]), a1);
          a0 = MFMA32(x0, as_bf16x8(bcur[4 + i]), a0); a1 = MFMA32(x1, as_bf16x8(bcur[4 + i]), a1);
        }
        if (s + 1 < 16) {
#pragma unroll
          for (int i = 0; i < 8; ++i) *(u32x4*)(slab + (buf ^ 1) * (64 * 264) + (lrow + 8 * i) * 264 + lc8) = ar[i];
#pragma unroll
          for (int i = 0; i < 8; ++i) bcur[i] = bnxt[i];
        }
        __syncthreads();
      }
      if (l31 < 8) {
        float* rb = red + (wid * 64 + 4 * hh) * 8 + l31;
#pragma unroll
        for (int i = 0; i < 16; ++i) {
          const int t0 = (i & 3) + 8 * (i >> 2);
          rb[t0 * 8] = a0[i]; rb[(32 + t0) * 8] = a1[i];
        }
      }
    }
    __syncthreads();
    {
      const int tt = tid >> 2, h = tid & 3;
      float gi = bgt[h], gf = bgt[4 + h];
#pragma unroll
      for (int w = 0; w < 4; ++w) { gi += red[(w * 64 + tt) * 8 + h]; gf += red[(w * 64 + tt) * 8 + 4 + h]; }
      sig[h * 64 + tt] = gi;
      slf[h * 64 + tt] = fminf(gf, 0.f) - log1pf(__expf(-fabsf(gf)));
    }
    __syncthreads();
    {
      const int seglen = samp ? 16 : 64, nseg = 64 / seglen;
      if (tid < 4 * nseg) {
        const int h = tid & 3, sg = tid >> 2;
        float b = 0.f, a = -INFINITY;
        for (int j = 0; j < seglen; ++j) {
          const int tt = sg * seglen + j;
          b += slf[h * 64 + tt];
          const float u = sig[h * 64 + tt] - b;
          a = fmaxf(a, u);
          const size_t o = (size_t)(tok0 + tt) * 4 + h;
          GB[o] = b; GU[o] = u; GA[o] = a;
        }
        if (!samp) { CHS[(unit * 4 + h) * 2] = b; CHS[(unit * 4 + h) * 2 + 1] = a; }
      }
    }
  }
}

DEV size_t numidx(int row, int h, int e) { return ((((size_t)(row >> 1) * 4 + h) * 16 + (e >> 5)) * 2 + (row & 1)) * 32 + (e & 31); }

DEV u32x4 coherent_load16(const bf16_t* ptr) {
  unsigned* q = (unsigned*)ptr; u32x4 r;
  r.x = __hip_atomic_load(q, __ATOMIC_RELAXED, __HIP_MEMORY_SCOPE_AGENT); r.y = __hip_atomic_load(q + 1, __ATOMIC_RELAXED, __HIP_MEMORY_SCOPE_AGENT);
  r.z = __hip_atomic_load(q + 2, __ATOMIC_RELAXED, __HIP_MEMORY_SCOPE_AGENT); r.w = __hip_atomic_load(q + 3, __ATOMIC_RELAXED, __HIP_MEMORY_SCOPE_AGENT);
  return r;
}

constexpr int NSUB = 4;

DEV float mscan_prefix(const float* CHS, int pb, int h, int c, int lane) {
  float P[2], Q[2];
#pragma unroll
  for (int j = 0; j < 2; ++j) {
    const int i = 2 * lane + j;
    if (i < c) { const float bl = CHS[((pb * 128 + i) * 4 + h) * 2], al = CHS[((pb * 128 + i) * 4 + h) * 2 + 1]; P[j] = bl; Q[j] = al + bl; }
    else { P[j] = 0.f; Q[j] = -INFINITY; }
  }
  float Pc = P[0] + P[1], Qc = fmaxf(Q[0] + P[1], Q[1]);
#pragma unroll
  for (int off = 1; off < 64; off <<= 1) {
    const float Po = __shfl_xor(Pc, off), Qo = __shfl_xor(Qc, off);
    if (lane & off) { Qc = fmaxf(Qo + Pc, Qc); Pc = Po + Pc; }
    else { Qc = fmaxf(Qc + Po, Qo); Pc = Pc + Po; }
  }
  return fmaxf(Pc, Qc);
}

DEV void intra_phase(const Params& p, char* smem) {
  const int tid = threadIdx.x, lane = tid & 63, wid = tid >> 6, l31 = lane & 31, hh = lane >> 5;
  float* su = (float*)smem;
  float* sM = su + NSUB * 64;
  float* sden = sM + 64;
  bf16_t* SWL = (bf16_t*)(smem + 2048);
  const bf16_t* QF = (const bf16_t*)(p.ws + OFF_E); const bf16_t* KF = (const bf16_t*)(p.out + O_CS); const bf16_t* VF = (const bf16_t*)(p.ws + OFF_F);
  bf16_t* NUMI = (bf16_t*)(p.ws + OFF_SW);
  const float* GB = (const float*)(p.ws + OFF_GB); const float* GU = (const float*)(p.ws + OFF_GU); const float* GA = (const float*)(p.ws + OFF_GA);
  const float* CHS = (const float*)(p.ws + OFF_CHS);
  float* WINTER = (float*)(p.ws + OFF_WINTER); float* WUPD = (float*)(p.ws + OFF_WUPD); float* DENI = (float*)(p.ws + OFF_DENI); float* ENEGM = (float*)(p.ws + OFF_ENEGM);
  float* DECAY = (float*)(p.ws + OFF_DECAY);
  const int si = wid >> 1, ti = wid & 1;
  for (int u0 = blockIdx.x; u0 < 1152; u0 += gridDim.x) {
    const int uid = (u0 >= 512 && u0 < 1024) ? (u0 ^ 12) : u0;
    const bool samp = uid >= 1024;
    const int h = uid & 3;
    __syncthreads();
    if (!samp) {
      const int cg = uid >> 2, pb = cg >> 7, cseq = cg & 127, tb = cseq & (NSUB - 1), cg0 = cg - tb, row0 = cg * 64;
      if (wid == 0) {
        const float mprev = mscan_prefix(CHS, pb, h, cseq - tb, lane);
        float B[NSUB + 1]; B[0] = 0.f; float Apre = -INFINITY, Aall = -INFINITY;
#pragma unroll
        for (int i = 0; i < NSUB; ++i) {
          const float bl = CHS[((cg0 + i) * 4 + h) * 2], al = CHS[((cg0 + i) * 4 + h) * 2 + 1];
          if (i < tb) Apre = fmaxf(Apre, al - B[i]);
          Aall = fmaxf(Aall, al - B[i]);
          B[i + 1] = B[i] + bl;
        }
        float Btb = 0.f;
#pragma unroll
        for (int i = 0; i < NSUB; ++i) if (i == tb) Btb = B[i];
        const float Mlast = fmaxf(mprev, Aall);
        const size_t o = (size_t)(row0 + lane) * 4 + h;
        const float bt = GB[o] + Btb, ut = GU[o] - Btb, at = fmaxf(Apre, GA[o] - Btb);
        const float Mt = fmaxf(mprev, at);
        sM[lane] = Mt;
        WINTER[o] = __expf(mprev - Mt);
        ENEGM[o] = __expf(-(bt + Mt));
        WUPD[o] = __expf(ut - Mlast);
#pragma unroll
        for (int i = 0; i < NSUB; ++i) if (i <= tb) su[i * 64 + lane] = GU[(size_t)((cg0 + i) * 64 + lane) * 4 + h] - B[i];
        if (lane == 0) {
          if (tb == 0) DECAY[uid] = __expf(mprev - Mlast);
          if (cseq == 127) p.out[O_MP + pb * 4 + h] = B[NSUB] + Mlast;
        }
      }
      __syncthreads();
      float dpart = 0.f;
      const int t = 32 * ti + l31;
      const float Mt = sM[t];
      for (int jj = 0; jj <= tb; ++jj) {
        bf16_t* swb = SWL + (size_t)((jj * 2 + ti) * 4) * 512;
        if (jj < tb || si <= ti) {
          f32x16 acc;
#pragma unroll
          for (int i = 0; i < 16; ++i) acc[i] = 0.f;
          const bf16_t* ka = KF + ((size_t)((cg0 + jj) * 4 + h) * 2 + si) * 32 * 512 + lane * 8;
          const bf16_t* qb = QF + ((size_t)(cg * 4 + h) * 2 + ti) * 32 * 512 + lane * 8;
#pragma unroll 1
          for (int kb = 0; kb < 2; ++kb) {
            u32x4 fa[16], fb[16];
#pragma unroll
            for (int i = 0; i < 16; ++i) { fa[i] = *(const u32x4*)(ka + (kb * 16 + i) * 512); fb[i] = *(const u32x4*)(qb + (kb * 16 + i) * 512); }
            __builtin_amdgcn_sched_barrier(0);
#pragma unroll
            for (int i = 0; i < 16; ++i) acc = MFMA32(as_bf16x8(fa[i]), as_bf16x8(fb[i]), acc);
            __builtin_amdgcn_sched_barrier(0);
          }
#pragma unroll
          for (int g = 0; g < 4; ++g) {
            float w4[4];
#pragma unroll
            for (int x = 0; x < 4; ++x) {
              const int s = 32 * si + 8 * g + 4 * hh + x;
              const float v = (jj < tb || s <= t) ? acc[4 * g + x] * __expf(su[jj * 64 + s] - Mt) : 0.f;
              w4[x] = v; dpart += v;
            }
            u32x2 o; o.x = cvt_pk_bf16(w4[0], w4[1]); o.y = cvt_pk_bf16(w4[2], w4[3]);
            *(u32x2*)(swb + (2 * si + (g >> 1)) * 512 + (l31 + 32 * (g & 1)) * 8 + 4 * hh) = o;
          }
        } else {
          u32x2 z; z.x = 0u; z.y = 0u;
#pragma unroll
          for (int g = 0; g < 4; ++g) *(u32x2*)(swb + (2 * si + (g >> 1)) * 512 + (l31 + 32 * (g & 1)) * 8 + 4 * hh) = z;
        }
      }
      dpart += __shfl_xor(dpart, 32);
      if (hh == 0) sden[si * 64 + t] = dpart;
      __syncthreads();
      if (tid < 64) DENI[(size_t)(row0 + tid) * 4 + h] = sden[tid] + sden[64 + tid];
#pragma unroll 1
      for (int eti = 0; eti < 4; ++eti) {
        const int et = wid + 4 * eti;
        f32x16 a0, a1;
#pragma unroll
        for (int i = 0; i < 16; ++i) { a0[i] = 0.f; a1[i] = 0.f; }
        u32x4 vfr[NSUB][4];
#pragma unroll
        for (int jj = 0; jj < NSUB; ++jj) {
          if (jj <= tb) {
            const bf16_t* vf = VF + ((((size_t)((cg0 + jj) * 4 + h) * 16 + et) * 4) * 64 + lane) * 8;
#pragma unroll
            for (int ks = 0; ks < 4; ++ks) vfr[jj][ks] = *(const u32x4*)(vf + ks * 512);
          }
        }
        __builtin_amdgcn_sched_barrier(0);
#pragma unroll
        for (int jj = 0; jj < NSUB; ++jj) {
          if (jj <= tb) {
            const bf16_t* sw = SWL + (size_t)(jj * 8) * 512 + lane * 8;
#pragma unroll
            for (int ks = 0; ks < 4; ++ks) {
              const bf16x8 v = as_bf16x8(vfr[jj][ks]);
              a0 = MFMA32(v, *(const bf16x8*)(sw + ks * 512), a0);
              a1 = MFMA32(v, *(const bf16x8*)(sw + (4 + ks) * 512), a1);
            }
          }
        }
        bf16_t* dst0 = NUMI + numidx(row0 + l31, h, et * 32) + 4 * hh;
        bf16_t* dst1 = NUMI + numidx(row0 + 32 + l31, h, et * 32) + 4 * hh;
#pragma unroll
        for (int g = 0; g < 4; ++g) {
          u32x2 o0; o0.x = cvt_pk_bf16(a0[4 * g], a0[4 * g + 1]); o0.y = cvt_pk_bf16(a0[4 * g + 2], a0[4 * g + 3]);
          u32x2 o1; o1.x = cvt_pk_bf16(a1[4 * g], a1[4 * g + 1]); o1.y = cvt_pk_bf16(a1[4 * g + 2], a1[4 * g + 3]);
          *(u32x2*)(dst0 + 8 * g) = o0;
          *(u32x2*)(dst1 + 8 * g) = o1;
        }
      }
    } else {
      const int sb = (uid - 1024) >> 2, row0 = NP + sb * 16, cg = row0 >> 6, r0 = (sb & 3) * 16, mts = r0 >> 5, r0t = r0 & 31, ksq = sb & 3;
      if (wid == 0) {
        const float mprev = p.in[4][uid - 1024];
        const bool valid = lane < 16;
        const size_t o = (size_t)(row0 + (valid ? lane : 0)) * 4 + h;
        const float bt = GB[o], ut = GU[o], at = GA[o];
        const float Mt = fmaxf(mprev, at);
        const float alast = __shfl(at, 15), blast = __shfl(bt, 15);
        const float Mlast = fmaxf(mprev, alast);
        sM[lane] = Mt; su[lane] = ut;
        if (valid) { WINTER[o] = __expf(mprev - Mt); ENEGM[o] = __expf(-(bt + Mt)); WUPD[o] = __expf(ut - Mlast); }
        if (lane == 0) { DECAY[uid] = __expf(mprev - Mlast); p.out[O_MS + (uid - 1024)] = blast + Mlast; }
      }
      __syncthreads();
      if (wid == 0) {
        f32x16 acc;
#pragma unroll
        for (int i = 0; i < 16; ++i) acc[i] = 0.f;
        const bf16_t* ka = KF + ((size_t)(cg * 4 + h) * 2 + mts) * 32 * 512 + lane * 8;
        const bf16_t* qb = QF + ((size_t)(cg * 4 + h) * 2 + mts) * 32 * 512 + lane * 8;
#pragma unroll 1
        for (int kb = 0; kb < 2; ++kb) {
          u32x4 fa[16], fb[16];
#pragma unroll
          for (int i = 0; i < 16; ++i) { fa[i] = *(const u32x4*)(ka + (kb * 16 + i) * 512); fb[i] = *(const u32x4*)(qb + (kb * 16 + i) * 512); }
          __builtin_amdgcn_sched_barrier(0);
#pragma unroll
          for (int i = 0; i < 16; ++i) acc = MFMA32(as_bf16x8(fa[i]), as_bf16x8(fb[i]), acc);
          __builtin_amdgcn_sched_barrier(0);
        }
        const int tl = l31 - r0t;
        const bool tv = tl >= 0 && tl < 16;
        const float Mt = sM[tv ? tl : 0];
        float dpart = 0.f;
#pragma unroll
        for (int g = 0; g < 4; ++g) {
          float w4[4];
#pragma unroll
          for (int x = 0; x < 4; ++x) {
            const int s = 8 * g + 4 * hh + x, sl = s - r0t;
            const bool ok = tv && sl >= 0 && s <= l31;
            const float v = ok ? acc[4 * g + x] * __expf(su[ok ? sl : 0] - Mt) : 0.f;
            w4[x] = v; dpart += v;
          }
          u32x2 o; o.x = cvt_pk_bf16(w4[0], w4[1]); o.y = cvt_pk_bf16(w4[2], w4[3]);
          *(u32x2*)(SWL + (g >> 1) * 512 + (l31 + 32 * (g & 1)) * 8 + 4 * hh) = o;
        }
        dpart += __shfl_xor(dpart, 32);
        if (hh == 0 && tv) DENI[(size_t)(row0 + tl) * 4 + h] = dpart;
      }
      __syncthreads();
      {
        const int tl = l31 - r0t;
        const bool tv = tl >= 0 && tl < 16;
        const bf16x8 swf = *(const bf16x8*)(SWL + (r0t >> 4) * 512 + lane * 8);
#pragma unroll 1
        for (int eti = 0; eti < 4; ++eti) {
          const int et = wid + 4 * eti;
          f32x16 a0;
#pragma unroll
          for (int i = 0; i < 16; ++i) a0[i] = 0.f;
          const bf16x8 v = as_bf16x8(*(const u32x4*)(VF + ((((size_t)(cg * 4 + h) * 16 + et) * 4 + ksq) * 64 + lane) * 8));
          a0 = MFMA32(v, swf, a0);
          if (tv) {
            bf16_t* dst = NUMI + numidx(row0 + tl, h, et * 32) + 4 * hh;
#pragma unroll
            for (int g = 0; g < 4; ++g) { u32x2 o0; o0.x = cvt_pk_bf16(a0[4 * g], a0[4 * g + 1]); o0.y = cvt_pk_bf16(a0[4 * g + 2], a0[4 * g + 3]); *(u32x2*)(dst + 8 * g) = o0; }
          }
        }
      }
    }
  }
}

DEV bf16x8 pack_acc(const f32x16& x, int s) {
  u32x4 pk;
  if (s == 0) { pk.x = cvt_pk_bf16(x[0], x[1]); pk.y = cvt_pk_bf16(x[2], x[3]); pk.z = cvt_pk_bf16(x[4], x[5]); pk.w = cvt_pk_bf16(x[6], x[7]); }
  else { pk.x = cvt_pk_bf16(x[8], x[9]); pk.y = cvt_pk_bf16(x[10], x[11]); pk.z = cvt_pk_bf16(x[12], x[13]); pk.w = cvt_pk_bf16(x[14], x[15]); }
  return as_bf16x8(pk);
}
DEV bf16x8 scale_frag(u32x4 raw, const float* w) {
  const f32x4 w0 = *(const f32x4*)(w), w1 = *(const f32x4*)(w + 4);
  u32x4 pk;
  pk.x = cvt_pk_bf16(bf_lo(raw.x) * w0.x, bf_hi(raw.x) * w0.y); pk.y = cvt_pk_bf16(bf_lo(raw.y) * w0.z, bf_hi(raw.y) * w0.w);
  pk.z = cvt_pk_bf16(bf_lo(raw.z) * w1.x, bf_hi(raw.z) * w1.y); pk.w = cvt_pk_bf16(bf_lo(raw.w) * w1.z, bf_hi(raw.w) * w1.w);
  return as_bf16x8(pk);
}

DEV void store_ctile(float* base, const f32x16 (&C)[4]) {
  float* cptr = base;
#pragma unroll
  for (int dt = 0; dt < 4; ++dt)
#pragma unroll
    for (int q = 0; q < 4; ++q) {
      cptr[0] = C[dt][4 * q]; cptr[512] = C[dt][4 * q + 1]; cptr[1024] = C[dt][4 * q + 2]; cptr[1536] = C[dt][4 * q + 3];
      cptr += 8 * 512; asm volatile("" : "+v"(cptr));
    }
}
DEV void load_ctile(const float* base, f32x16 (&C)[4]) {
  const float* cptr = base;
#pragma unroll
  for (int dt = 0; dt < 4; ++dt)
#pragma unroll
    for (int q = 0; q < 4; ++q) {
      C[dt][4 * q] = cptr[0]; C[dt][4 * q + 1] = cptr[512]; C[dt][4 * q + 2] = cptr[1024]; C[dt][4 * q + 3] = cptr[1536];
      cptr += 8 * 512; asm volatile("" : "+v"(cptr));
    }
}

constexpr unsigned BF_ONES = 0x3F803F80u;

DEV void lds_barrier() { asm volatile("s_waitcnt lgkmcnt(0)\n\ts_barrier" ::: "memory"); }

DEV void scan_prompt(const Params& p, char* smem, int pb, int h, int sl, unsigned* prog) {
  int tid_ = threadIdx.x; asm volatile("" : "+v"(tid_));
  const int tid = tid_, lane = tid & 63, wid = tid >> 6, l31 = lane & 31, hh = lane >> 5;
  float* red = (float*)smem;
  float* swi = red + 2 * 4 * 64 * 32;
  float* swu = swi + 256;
  const bf16_t* QF = (const bf16_t*)(p.ws + OFF_E); const bf16_t* VF = (const bf16_t*)(p.ws + OFF_F); const bf16_t* KTF = (const bf16_t*)(p.out + O_Y);
  bf16_t* NUM = (bf16_t*)(p.ws + OFF_B);
  const float* WINTER = (const float*)(p.ws + OFF_WINTER); const float* WUPD = (const float*)(p.ws + OFF_WUPD); const float* DECAY = (const float*)(p.ws + OFF_DECAY);
  const float* DENI = (const float*)(p.ws + OFF_DENI); const float* ENEGM = (const float*)(p.ws + OFF_ENEGM); float* DINV = (float*)(p.ws + OFF_DINV);
  const bool ns = sl == 16;
  const int slv = ns ? 0 : sl;
  f32x16 C[4];
#pragma unroll
  for (int dt = 0; dt < 4; ++dt)
#pragma unroll
    for (int i = 0; i < 16; ++i) C[dt][i] = 0.f;
  const int e0 = slv * 32;
  const u32x4 ones = {BF_ONES, BF_ONES, BF_ONES, BF_ONES};
  constexpr int RQ = 8;
  const int rt = tid >> 2, re8 = (tid & 3) * 8;
  float nwi, nwu, ndecay;
  { const size_t o = (size_t)(pb * 8192 + tid) * 4 + h; nwi = WINTER[o]; nwu = WUPD[o]; ndecay = DECAY[(pb * 128) * 4 + h]; }
  for (int sc = 0; sc < 128 / NSUB; ++sc) {
    const int cg0 = pb * 128 + sc * NSUB, rows = cg0 * 64;
    if (sl == 0 && tid == 0) __hip_atomic_store(prog + pb * 4 + h, (unsigned)sc, __ATOMIC_RELAXED, __HIP_MEMORY_SCOPE_AGENT);
    const bf16_t* qbase = QF + ((size_t)(cg0 * 4 + h) * 64 + 8 * wid) * 512 + lane * 8;
    u32x4 qf[RQ];
#pragma unroll
    for (int q = 0; q < RQ; ++q) qf[q] = *(const u32x4*)(qbase + (size_t)(q >> 4) * (4 * 64 * 512) + (size_t)(((q >> 3) & 1) * 32 + (q & 7)) * 512);
    lds_barrier();
    swi[tid] = nwi; swu[tid] = nwu;
    const float decay = ndecay;
    if (sc + 1 < 128 / NSUB) {
      const size_t o = (size_t)(rows + NSUB * 64 + tid) * 4 + h;
      nwi = WINTER[o]; nwu = WUPD[o]; ndecay = DECAY[(cg0 + NSUB) * 4 + h];
    }
    lds_barrier();
#pragma unroll
    for (int it = 0; it < 2 * NSUB; ++it) {
      const int j = it >> 1, mt = it & 1;
      const int cgj = cg0 + j;
      bf16_t* nump = NUM + numidx(cgj * 64 + rt, h, e0 + re8);
      f32x16 ai;
#pragma unroll
      for (int i = 0; i < 16; ++i) ai[i] = 0.f;
#pragma unroll
      for (int kk = 0; kk < 8; ++kk) {
        const int q = it * 8 + kk;
        ai = MFMA32(as_bf16x8(qf[q % RQ]), pack_acc(C[kk >> 1], kk & 1), ai);
        if (q + RQ < 16 * NSUB) {
          const int qn = q + RQ;
          qf[q % RQ] = *(const u32x4*)(qbase + (size_t)(qn >> 4) * (4 * 64 * 512) + (size_t)(((qn >> 3) & 1) * 32 + (qn & 7)) * 512);
        }
      }
      float* rb = red + (j & 1) * (4 * 64 * 32);
      {
        float* rbt = rb + (wid * 64 + 4 * hh) * 32 + l31;
        const float* swij = swi + j * 64 + 4 * hh + 32 * mt;
        f32x4 w4[4];
#pragma unroll
        for (int q = 0; q < 4; ++q) w4[q] = *(const f32x4*)(swij + 8 * q);
#pragma unroll
        for (int i = 0; i < 16; ++i) {
          const int t0 = 32 * mt + (i & 3) + 8 * (i >> 2);
          rbt[t0 * 32] = w4[i >> 2][i & 3] * ai[i];
        }
      }
      if (mt == 1) {
        lds_barrier();
        f32x4 s0 = *(const f32x4*)(rb + rt * 32 + re8), s1 = *(const f32x4*)(rb + rt * 32 + re8 + 4);
#pragma unroll
        for (int w = 1; w < 4; ++w) { s0 += *(const f32x4*)(rb + (w * 64 + rt) * 32 + re8); s1 += *(const f32x4*)(rb + (w * 64 + rt) * 32 + re8 + 4); }
        if (!ns) {
          u32x4 o;
          o.x = cvt_pk_bf16(s0.x, s0.y); o.y = cvt_pk_bf16(s0.z, s0.w); o.z = cvt_pk_bf16(s1.x, s1.y); o.w = cvt_pk_bf16(s1.z, s1.w);
          *(u32x4*)nump = o;
        } else if (re8 == 0) {
          const size_t o = (size_t)(cgj * 64 + rt) * 4 + h;
          DINV[o] = s0.x;
        }
      }
    }
#pragma unroll
    for (int dt = 0; dt < 4; ++dt)
#pragma unroll
      for (int i = 0; i < 16; ++i) C[dt][i] *= decay;
    constexpr int PF = 4;
    u32x4 vb[PF], kb[PF][4];
    const bf16_t* vbase = VF + ((((size_t)(cg0 * 4 + h) * 16 + slv) * 4) * 64 + lane) * 8;
    const bf16_t* kbase = KTF + ((((size_t)(cg0 * 4 + h) * 16 + 4 * wid) * 4) * 64 + lane) * 8;
#pragma unroll
    for (int k16 = 0; k16 < PF; ++k16) {
      const size_t off = (size_t)(k16 >> 2) * (4 * 16 * 4 * 512) + (size_t)(k16 & 3) * 512;
      vb[k16] = ns ? ones : *(const u32x4*)(vbase + off);
#pragma unroll
      for (int dt = 0; dt < 4; ++dt) kb[k16][dt] = *(const u32x4*)(kbase + off + (size_t)dt * 4 * 512);
    }
#pragma unroll
    for (int k16 = 0; k16 < NSUB * 4; ++k16) {
      const bf16x8 b = scale_frag(vb[k16 % PF], swu + k16 * 16 + 8 * hh);
#pragma unroll
      for (int dt = 0; dt < 4; ++dt) C[dt] = MFMA32(as_bf16x8(kb[k16 % PF][dt]), b, C[dt]);
      if (k16 + PF < NSUB * 4) {
        const int kn = k16 + PF;
        const size_t off = (size_t)(kn >> 2) * (4 * 16 * 4 * 512) + (size_t)(kn & 3) * 512;
        vb[k16 % PF] = ns ? ones : *(const u32x4*)(vbase + off);
#pragma unroll
        for (int dt = 0; dt < 4; ++dt) kb[k16 % PF][dt] = *(const u32x4*)(kbase + off + (size_t)dt * 4 * 512);
      }
    }
  }
  if (!ns) store_ctile(p.out + O_CP + (size_t)(pb * 4 + h) * 262144 + (size_t)(128 * wid + 4 * hh) * 512 + e0 + l31, C);
  else if (l31 == 0) {
    float* nout = p.out + O_NP + (size_t)(pb * 4 + h) * 512 + 128 * wid + 4 * hh;
#pragma unroll
    for (int dt = 0; dt < 4; ++dt)
#pragma unroll
      for (int i = 0; i < 16; ++i) nout[32 * dt + (i & 3) + 8 * (i >> 2)] = C[dt][i];
  }
}

DEV void scan_sample(const Params& p_, char* smem, int sbh, int sl) {
  Params p = p_;
  asm volatile("" : "+s"(p.ws), "+s"(p.out), "+s"(p.in[2]), "+s"(p.in[3]));
  const int tid = threadIdx.x, lane = tid & 63, wid = tid >> 6, l31 = lane & 31, hh = lane >> 5;
  float* red = (float*)smem;
  float* swi = red + 2 * 4 * 64 * 32;
  float* swu = swi + 256;
  const bf16_t* QF = (const bf16_t*)(p.ws + OFF_E); const bf16_t* VF = (const bf16_t*)(p.ws + OFF_F); const bf16_t* KTF = (const bf16_t*)(p.out + O_Y);
  const bf16_t* SWF = (const bf16_t*)(p.ws + OFF_SW);
  bf16_t* NUM = (bf16_t*)(p.ws + OFF_B);
  const float* WINTER = (const float*)(p.ws + OFF_WINTER); const float* WUPD = (const float*)(p.ws + OFF_WUPD); const float* DECAY = (const float*)(p.ws + OFF_DECAY);
  const float* DENI = (const float*)(p.ws + OFF_DENI); const float* ENEGM = (const float*)(p.ws + OFF_ENEGM); float* DINV = (float*)(p.ws + OFF_DINV);
  const int sb = sbh >> 2, h = sbh & 3, row0 = NP + sb * 16, cg = row0 >> 6, r0 = (sb & 3) * 16, mts = r0 >> 5, r0t = r0 & 31, ksq = sb & 3;
  const bool ns = sl == 16;
  const int slv = ns ? 0 : sl;
  const int uid = 1024 + sbh, e0 = slv * 32;
  f32x16 C[4];
  if (!ns) load_ctile(p.in[2] + (size_t)sbh * 262144 + (size_t)(128 * wid + 4 * hh) * 512 + e0 + l31, C);
  else {
    const float* n0 = p.in[3] + (size_t)sbh * 512 + 128 * wid + 4 * hh;
#pragma unroll
    for (int dt = 0; dt < 4; ++dt)
#pragma unroll
      for (int i = 0; i < 16; ++i) C[dt][i] = n0[32 * dt + (i & 3) + 8 * (i >> 2)];
  }
  __syncthreads();
  if (tid < 32) { const int tl = tid - r0t; swi[tid] = (tl >= 0 && tl < 16) ? WINTER[(size_t)(row0 + tl) * 4 + h] : 0.f; }
  if (tid >= 64 && tid < 80) swu[tid - 64] = WUPD[(size_t)(row0 + tid - 64) * 4 + h];
  const float decay = DECAY[uid];
  f32x16 ai, aa;
#pragma unroll
  for (int i = 0; i < 16; ++i) { ai[i] = 0.f; aa[i] = 0.f; }
  const bf16_t* qa = QF + ((size_t)((cg * 4 + h) * 2 + mts) * 32 + 8 * wid) * 512 + lane * 8;
#pragma unroll
  for (int kk = 0; kk < 8; ++kk) {
    const bf16x8 a = as_bf16x8(*(const u32x4*)(qa + (size_t)kk * 512));
    ai = MFMA32(a, pack_acc(C[kk >> 1], kk & 1), ai);
  }
  u32x4 vraw = {BF_ONES, BF_ONES, BF_ONES, BF_ONES};
  if (!ns) vraw = *(const u32x4*)(VF + ((((size_t)(cg * 4 + h) * 16 + slv) * 4 + ksq) * 64 + lane) * 8);
  __syncthreads();
  {
    float* rbt = red + (wid * 32 + 4 * hh) * 32 + l31;
    const float* swij = swi + 4 * hh;
    f32x4 w4[4];
#pragma unroll
    for (int q = 0; q < 4; ++q) w4[q] = *(const f32x4*)(swij + 8 * q);
#pragma unroll
    for (int i = 0; i < 16; ++i) {
      const int t0 = (i & 3) + 8 * (i >> 2);
      rbt[t0 * 32] = aa[i] + w4[i >> 2][i & 3] * ai[i];
    }
  }
#pragma unroll
  for (int dt = 0; dt < 4; ++dt)
#pragma unroll
    for (int i = 0; i < 16; ++i) C[dt][i] *= decay;
  {
    const bf16x8 b = scale_frag(vraw, swu + 8 * hh);
    const bf16_t* ka = KTF + ((((size_t)(cg * 4 + h) * 16 + 4 * wid) * 4 + ksq) * 64 + lane) * 8;
#pragma unroll
    for (int dt = 0; dt < 4; ++dt) C[dt] = MFMA32(as_bf16x8(*(const u32x4*)(ka + (size_t)dt * 4 * 512)), b, C[dt]);
  }
  __syncthreads();
  if (tid < 64) {
    const int t = tid >> 2, e8 = (tid & 3) * 8, tr = r0t + t;
    f32x4 s0 = *(const f32x4*)(red + tr * 32 + e8), s1 = *(const f32x4*)(red + tr * 32 + e8 + 4);
#pragma unroll
    for (int w = 1; w < 4; ++w) { s0 += *(const f32x4*)(red + (w * 32 + tr) * 32 + e8); s1 += *(const f32x4*)(red + (w * 32 + tr) * 32 + e8 + 4); }
    if (!ns) {
      bf16_t* nump = NUM + numidx(row0 + t, h, e0 + e8);
      u32x4 o;
      o.x = cvt_pk_bf16(s0.x, s0.y); o.y = cvt_pk_bf16(s0.z, s0.w); o.z = cvt_pk_bf16(s1.x, s1.y); o.w = cvt_pk_bf16(s1.z, s1.w);
      *(u32x4*)nump = o;
    } else if (e8 == 0) {
      const size_t o = (size_t)(row0 + t) * 4 + h;
      DINV[o] = s0.x;
    }
  }
  if (!ns) store_ctile(p.out + O_CS + (size_t)sbh * 262144 + (size_t)(128 * wid + 4 * hh) * 512 + e0 + l31, C);
  else if (l31 == 0) {
    float* nout = p.out + O_NS + (size_t)sbh * 512 + 128 * wid + 4 * hh;
#pragma unroll
    for (int dt = 0; dt < 4; ++dt)
#pragma unroll
      for (int i = 0; i < 16; ++i) nout[32 * dt + (i & 3) + 8 * (i >> 2)] = C[dt][i];
  }
}

DEV unsigned hw_xcc_id() { return (unsigned)__builtin_amdgcn_s_getreg((3 << 11) | 20) & 0xFu; }

constexpr int NPF = 6;
constexpr int PF_AHEAD = 2;
DEV void scan_prefetch(const Params& p, int bh, int part, unsigned* prog, volatile int* flag) {
  const int tid = threadIdx.x, pb = bh >> 2, h = bh & 3;
  const bf16_t* QF = (const bf16_t*)(p.ws + OFF_E); const bf16_t* VF = (const bf16_t*)(p.ws + OFF_F); const bf16_t* KTF = (const bf16_t*)(p.out + O_Y);
  unsigned sink = 0u;
  for (int sc = 0; sc < 128 / NSUB; ++sc) {
    if (tid == 0) {
      unsigned spins = 0; int dead = 0;
      while ((int)__hip_atomic_load(prog + bh, __ATOMIC_RELAXED, __HIP_MEMORY_SCOPE_AGENT) + PF_AHEAD < sc) { __builtin_amdgcn_s_sleep(8); if (++spins > (1u << 15)) { dead = 1; break; } }
      flag[0] = dead;
    }
    __syncthreads();
    if (flag[0]) break;
    __syncthreads();
    const int cg0 = pb * 128 + sc * NSUB;
    for (int r = part; r < 3 * NSUB; r += NPF) {
      const int which = r / NSUB, j = r % NSUB;
      const bf16_t* base = (which == 0 ? QF : (which == 1 ? KTF : VF)) + (size_t)((cg0 + j) * 4 + h) * 32768;
      u32x4 v[16];
#pragma unroll
      for (int i = 0; i < 16; ++i) v[i] = *(const u32x4*)(base + (size_t)(i * 256 + tid) * 8);
#pragma unroll
      for (int i = 0; i < 16; ++i) sink ^= v[i].x ^ v[i].w;
    }
  }
  asm volatile("" :: "v"(sink));
}


DEV void scan_phase(const Params& p, char* smem) {
  const int tid = threadIdx.x, bid = blockIdx.x;
  unsigned* cnt = (unsigned*)(p.ws + OFF_BAR + 14336);
  volatile int* sunit = (volatile int*)(smem + 73728 - 16);
  constexpr int NSS = 128 * 17;
  int stage = 0, bh_try = 0;
  for (;;) {
    __syncthreads();
    if (tid == 0) {
      int kind = -1, a = 0, b = 0;
      for (;;) {
        if (stage == 0) {
          stage = 1;
          const unsigned x = hw_xcc_id() & 7u;
          if (bid < 256) { const unsigned t = atomicAdd(&cnt[x], 1u); if (t < 17u) { kind = 0; a = (int)x; b = (int)t; break; } }
          else { const unsigned t = atomicAdd(&cnt[8 + x], 1u); if (t < (unsigned)NPF) { kind = 2; a = (int)x; b = (int)t; break; } }
        } else if (stage == 1) {
          const unsigned u = atomicAdd(&cnt[16], 1u);
          if (u < (unsigned)NSS) { kind = 1; a = (int)u; break; }
          stage = 2;
        } else {
          if (bh_try >= 8) break;
          const unsigned t = atomicAdd(&cnt[bh_try], 1u);
          if (t < 17u) { kind = 0; a = bh_try; b = (int)t; break; }
          ++bh_try;
        }
      }
      sunit[0] = kind; sunit[1] = a; sunit[2] = b;
    }
    __syncthreads();
    const int kind = sunit[0], a = sunit[1], b = sunit[2];
    if (kind < 0) break;
    if (kind == 0) scan_prompt(p, smem, a >> 2, a & 3, b, cnt + 32);
    else if (kind == 1) scan_sample(p, smem, a / 17, a % 17);
    else scan_prefetch(p, a, b, cnt + 32, sunit + 3);
  }
}

DEV void hnorm_phase(const Params& p) {
  const int tid = threadIdx.x, lane = tid & 63, h = tid >> 6;
  const bf16_t* NUM = (const bf16_t*)(p.ws + OFF_B); const bf16_t* XC = (const bf16_t*)(p.ws + OFF_D); const bf16_t* Z2 = (const bf16_t*)(p.ws + OFF_C);
  const float* DINV = (const float*)(p.ws + OFF_DINV); const float* DENI = (const float*)(p.ws + OFF_DENI); const float* ENEGM = (const float*)(p.ws + OFF_ENEGM);
  bf16_t* A4 = (bf16_t*)(p.ws + OFF_F);
  const int ch = h * 512 + lane * 8;
  float hg[8], sk[8];
  { const f32x4 a = *(const f32x4*)(p.in[22] + ch), b = *(const f32x4*)(p.in[22] + ch + 4); hg[0] = a.x; hg[1] = a.y; hg[2] = a.z; hg[3] = a.w; hg[4] = b.x; hg[5] = b.y; hg[6] = b.z; hg[7] = b.w; }
  { const f32x4 a = *(const f32x4*)(p.in[23] + ch), b = *(const f32x4*)(p.in[23] + ch + 4); sk[0] = a.x; sk[1] = a.y; sk[2] = a.z; sk[3] = a.w; sk[4] = b.x; sk[5] = b.y; sk[6] = b.z; sk[7] = b.w; }
  const bf16_t* NUMI = (const bf16_t*)(p.ws + OFF_SW);
  int tok = blockIdx.x;
  float dinv_n = 0.f; u32x4 nr_n = {0u, 0u, 0u, 0u}, ni_n = nr_n, xr_n = nr_n, zr_n = nr_n;
  if (tok < T) {
    dinv_n = 1.f / fmaxf(fabsf(DENI[(size_t)tok * 4 + h] + DINV[(size_t)tok * 4 + h]), ENEGM[(size_t)tok * 4 + h]);
    nr_n = *(const u32x4*)(NUM + numidx(tok, h, lane * 8)); ni_n = *(const u32x4*)(NUMI + numidx(tok, h, lane * 8));
    xr_n = *(const u32x4*)(XC + (size_t)tok * E + ch); zr_n = *(const u32x4*)(Z2 + (size_t)tok * E + ch);
  }
  for (; tok < T; tok += gridDim.x) {
    const float dinv = dinv_n; const u32x4 nr = nr_n, ni = ni_n, xr = xr_n, zr = zr_n;
    const int tn = tok + gridDim.x;
    if (tn < T) {
      dinv_n = 1.f / fmaxf(fabsf(DENI[(size_t)tn * 4 + h] + DINV[(size_t)tn * 4 + h]), ENEGM[(size_t)tn * 4 + h]);
      nr_n = *(const u32x4*)(NUM + numidx(tn, h, lane * 8)); ni_n = *(const u32x4*)(NUMI + numidx(tn, h, lane * 8));
      xr_n = *(const u32x4*)(XC + (size_t)tn * E + ch); zr_n = *(const u32x4*)(Z2 + (size_t)tn * E + ch);
    }
    float v[8] = {(bf_lo(nr.x) + bf_lo(ni.x)) * dinv, (bf_hi(nr.x) + bf_hi(ni.x)) * dinv, (bf_lo(nr.y) + bf_lo(ni.y)) * dinv, (bf_hi(nr.y) + bf_hi(ni.y)) * dinv, (bf_lo(nr.z) + bf_lo(ni.z)) * dinv, (bf_hi(nr.z) + bf_hi(ni.z)) * dinv, (bf_lo(nr.w) + bf_lo(ni.w)) * dinv, (bf_hi(nr.w) + bf_hi(ni.w)) * dinv};
    const float xc[8] = {bf_lo(xr.x), bf_hi(xr.x), bf_lo(xr.y), bf_hi(xr.y), bf_lo(xr.z), bf_hi(xr.z), bf_lo(xr.w), bf_hi(xr.w)};
    const float z[8] = {bf_lo(zr.x), bf_hi(zr.x), bf_lo(zr.y), bf_hi(zr.y), bf_lo(zr.z), bf_hi(zr.z), bf_lo(zr.w), bf_hi(zr.w)};
    float s = 0.f;
#pragma unroll
    for (int j = 0; j < 8; ++j) s += v[j];
    const float mean = wave_sum(s) * (1.f / 512.f);
    float s2 = 0.f;
#pragma unroll
    for (int j = 0; j < 8; ++j) { v[j] -= mean; s2 += v[j] * v[j]; }
    const float rstd = rsqrtf(wave_sum(s2) * (1.f / 512.f) + 1e-5f);
    float o[8];
#pragma unroll
    for (int j = 0; j < 8; ++j) o[j] = (v[j] * rstd * hg[j] + sk[j] * xc[j]) * siluf_(z[j]);
    u32x4 ov; ov.x = cvt_pk_bf16(o[0], o[1]); ov.y = cvt_pk_bf16(o[2], o[3]); ov.z = cvt_pk_bf16(o[4], o[5]); ov.w = cvt_pk_bf16(o[6], o[7]);
    *(u32x4*)(A4 + (size_t)tok * E + ch) = ov;
  }
}

DEV void final_phase(const Params& p) {
  const int tid = threadIdx.x, lane = tid & 63, wid = tid >> 6;
  const float* SS2 = (const float*)(p.ws + OFF_SS2);
  const float* g = p.in[7];
  f32x4 gv[4];
#pragma unroll
  for (int j = 0; j < 4; ++j) gv[j] = *(const f32x4*)(g + j * 256 + lane * 4);
  for (int row = blockIdx.x * 4 + wid; row < T; row += gridDim.x * 4) {
    float s = 0.f;
#pragma unroll
    for (int j = 0; j < 4; ++j) { const f32x4 v = *(const f32x4*)(SS2 + (size_t)row * 16 + 4 * j); s += v.x + v.y + v.z + v.w; }
    const float r = rsqrtf(s * (1.f / DM) + 1e-6f);
    float* y = p.out + O_Y + (size_t)row * DM;
#pragma unroll
    for (int j = 0; j < 4; ++j) { f32x4 v = *(const f32x4*)(y + j * 256 + lane * 4); v.x *= r * gv[j].x; v.y *= r * gv[j].y; v.z *= r * gv[j].z; v.w *= r * gv[j].w; *(f32x4*)(y + j * 256 + lane * 4) = v; }
  }
}

#define XB_TMO      128
#define XB_XCNT(j)  (256  + 64 * (j))
#define XB_XSUB(j)  (1280 + 64 * (j))
#define XB_XGEN(j)  (2304 + 64 * (j))
#define XB_TOP      3328
#define XB_TOPGEN   3392
#define XCD_BAR_WORDS 3456
#define XB_SPIN_CAP (1u << 18)
#define LAS __attribute__((address_space(3)))
DEV unsigned xb_ld(unsigned* p)              { return __hip_atomic_load(p, __ATOMIC_RELAXED, __HIP_MEMORY_SCOPE_AGENT); }
DEV unsigned xb_add(unsigned* p, unsigned v) { return __hip_atomic_fetch_add(p, v, __ATOMIC_RELAXED, __HIP_MEMORY_SCOPE_AGENT); }
DEV unsigned xb_xcc_id() { return (unsigned)__builtin_amdgcn_s_getreg((3 << 11) | 20) & 0xFu; }
#define XB_SPIN(cond, bar) do { unsigned _sp = 0; while (cond) { __builtin_amdgcn_s_sleep(1); \
    if ((++_sp & 255u) == 0u) { if (xb_ld(&(bar)[XB_TMO])) break; if (_sp > XB_SPIN_CAP) { atomicAdd(&(bar)[XB_TMO], 1u); break; } } } } while (0)
struct XcdBarrier { unsigned* bar; unsigned x; volatile LAS unsigned* st; };
DEV XcdBarrier xcd_barrier_post(unsigned* bar, volatile LAS unsigned* st) {
  XcdBarrier b; b.bar = bar; b.x = xb_xcc_id(); b.st = st;
  if (threadIdx.x == 0) (void)xb_add(&bar[XB_XCNT(b.x)], 1u);
  return b;
}
DEV void xcd_barrier_complete(unsigned* bar, unsigned x, unsigned& nloc, unsigned& nx) {
  const unsigned G = gridDim.x * gridDim.y * gridDim.z;
  unsigned sum, cnt, mine, sp = 0u;
  for (;;) {
    sum = 0u; cnt = 0u; mine = 0u;
#pragma unroll
    for (unsigned j = 0; j < 16; ++j) { const unsigned c = xb_ld(&bar[XB_XCNT(j)]); sum += c; cnt += (c > 0u) ? 1u : 0u; mine = (j == x) ? c : mine; }
    if (sum == G) break;
    __builtin_amdgcn_s_sleep(1);
    if ((++sp & 255u) == 0u) { if (xb_ld(&bar[XB_TMO])) break; if (sp > XB_SPIN_CAP) { atomicAdd(&bar[XB_TMO], 1u); break; } }
  }
  nloc = mine > 0u ? mine : 1u; nx = cnt > 0u ? cnt : 1u;
}
DEV void xcd_barrier(const XcdBarrier& b) {
  asm volatile("s_waitcnt vmcnt(0)" ::: "memory");
  __syncthreads();
  if (threadIdx.x == 0) {
    unsigned* bar = b.bar;
    __builtin_amdgcn_s_waitcnt(0);
    unsigned nloc = b.st[0], nx = b.st[1];
    if (nloc == 0u) { xcd_barrier_complete(bar, b.x, nloc, nx); b.st[0] = nloc; b.st[1] = nx; }
    const unsigned old = xb_add(&bar[XB_XSUB(b.x)], 1u);
    const unsigned gen = old / nloc;
    if (old + 1u == (gen + 1u) * nloc) {
      __builtin_amdgcn_fence(__ATOMIC_RELEASE, "agent");
      asm volatile("s_waitcnt vmcnt(0)" ::: "memory");
      const unsigned og = xb_add(&bar[XB_TOP], 1u);
      const unsigned tg = og / nx;
      if (og + 1u == (tg + 1u) * nx) xb_add(&bar[XB_TOPGEN], 1u);
      else XB_SPIN(xb_ld(&bar[XB_TOPGEN]) == tg, bar);
      __builtin_amdgcn_fence(__ATOMIC_ACQUIRE, "agent");
      xb_add(&bar[XB_XGEN(b.x)], 1u);
      asm volatile("s_waitcnt vmcnt(0)" ::: "memory");
    } else {
      XB_SPIN(xb_ld(&bar[XB_XGEN(b.x)]) == gen, bar);
      __builtin_amdgcn_fence(__ATOMIC_ACQUIRE, "agent");
      asm volatile("s_waitcnt vmcnt(0)" ::: "memory");
    }
  }
  __syncthreads();
}

template <bool COOP>
__global__ void __launch_bounds__(NBLK, 2) fwd_kernel(Params p) {
  __shared__ __attribute__((aligned(16))) char smem[73728 + 16];
  XcdBarrier xb;
  if (COOP) {
    if (threadIdx.x == 0) *(uint4*)(smem + 73728) = make_uint4(0u, 0u, 0u, 0u);
    __syncthreads();
    xb = xcd_barrier_post((unsigned*)(p.ws + OFF_BAR), (volatile LAS unsigned*)(smem + 73728));
    if (p.ph_hi > 1000) cg::this_grid().sync();
  }
#ifndef REPMASK
#define REPMASK 0
#endif
#define PH_BEGIN(k) if (p.ph_lo <= (k) && (k) < p.ph_hi) for (int rep_ = 0; rep_ < (((REPMASK >> (k)) & 1) ? 2 : 1); ++rep_) { if (rep_) __syncthreads();
#define PH_END(k) } if (COOP) { if (p.ph_lo <= (k) && (k) + 1 < p.ph_hi) xcd_barrier(xb); }
  PH_BEGIN(0) phase0(p, smem); PH_END(0)
  PH_BEGIN(1) { Epi1 e{(const float*)(p.ws + OFF_RS0), (bf16_t*)(p.ws + OFF_A), (bf16_t*)(p.ws + OFF_B), (bf16_t*)(p.ws + OFF_C), (float*)(p.ws + OFF_VST)};
                gemm_phase((const bf16_t*)(p.ws + OFF_E), (const bf16_t*)(p.ws + OFF_W1), 6144, 1024, e, (bf16_t*)smem); } PH_END(1)
  PH_BEGIN(2) sgu_phase(p, smem); PH_END(2)
  PH_BEGIN(3) { EpiRes e{p.in[0], p.in[1], (float*)(p.ws + OFF_A), (bf16_t*)(p.ws + OFF_E + 34603008), (float*)(p.ws + OFF_SS1)};
                gemm_phase((const bf16_t*)(p.ws + OFF_D), (const bf16_t*)(p.ws + OFF_W2), 1024, 2048, e, (bf16_t*)smem, true); } PH_END(3)
  PH_BEGIN(4) { Epi3 e{(const float*)(p.ws + OFF_SS1), (bf16_t*)(p.ws + OFF_B), (bf16_t*)(p.ws + OFF_C)};
                gemm_phase((const bf16_t*)(p.ws + OFF_E + 34603008), (const bf16_t*)(p.ws + OFF_W3), 4096, 1024, e, (bf16_t*)smem); } PH_END(4)
  PH_BEGIN(5) conv_phase(p, smem); } if (COOP) xcd_barrier(xb); if (p.ph_lo <= 5 && 5 < p.ph_hi) { gate_phase(p, smem); PH_END(5)
  PH_BEGIN(6) intra_phase(p, smem); PH_END(6)
  PH_BEGIN(7) scan_phase(p, smem); PH_END(7)
  PH_BEGIN(8) hnorm_phase(p); PH_END(8)
  PH_BEGIN(9) { const float* x1 = (const float*)(p.ws + OFF_A);
                EpiRes e{x1, x1 + (size_t)NP * DM, p.out + O_Y, nullptr, (float*)(p.ws + OFF_SS2)};
                gemm_phase((const bf16_t*)(p.ws + OFF_F), (const bf16_t*)(p.ws + OFF_W4), 1024, 2048, e, (bf16_t*)smem, true); } PH_END(9)
  PH_BEGIN(10) final_phase(p); }
}

extern "C" void kernel_launch(void* const* d_in, const int* in_sizes, int n_in, void* d_out, int out_size, void* d_ws, size_t ws_size, hipStream_t stream) {
  static int grid = 0;
  if (grid == 0) {
    int dev = 0, cus = 0, per_cu = 0;
    hipGetDevice(&dev);
    hipDeviceGetAttribute(&cus, hipDeviceAttributeMultiprocessorCount, dev);
    hipOccupancyMaxActiveBlocksPerMultiprocessor(&per_cu, (const void*)fwd_kernel<true>, NBLK, 0);
    if (per_cu < 1) per_cu = 1;
    if (per_cu > 2) per_cu = 2;
    grid = cus * per_cu;
    if (ws_size < WS_END) { fprintf(stderr, "kernel_launch: workspace too small (%zu < %zu)\n", ws_size, (size_t)WS_END); grid = -1; }
  }
  if (grid < 0) return;
  Params p{};
  for (int i = 0; i < 25; ++i) p.in[i] = (const float*)d_in[i];
  p.out = (float*)d_out; p.ws = (char*)d_ws;
#if MULTI_LAUNCH
  for (int ph = 0; ph < NPHASE; ++ph) {
    p.ph_lo = ph; p.ph_hi = ph + 1;
    hipLaunchKernelGGL(fwd_kernel<false>, dim3(grid), dim3(NBLK), 0, stream, p);
  }
#else
  p.ph_lo = 0; p.ph_hi = NPHASE;
  (void)hipMemsetAsync((char*)d_ws + OFF_BAR, 0, 16384, stream);
  void* args[] = {&p};
  hipError_t e = hipLaunchCooperativeKernel((const void*)fwd_kernel<true>, dim3(grid), dim3(NBLK), args, 0, stream);
  if (e != hipSuccess) fprintf(stderr, "cooperative launch failed: %s (grid %d)\n", hipGetErrorString(e), grid);
#endif
}
```

```cpp
#include <hip/hip_runtime.h>
#include <hip/hip_cooperative_groups.h>
#include <cstdio>
#include <cstdint>
namespace cg = cooperative_groups;

#ifndef MULTI_LAUNCH
#define MULTI_LAUNCH 0
#endif

typedef unsigned short bf16_t;
typedef short bf16x8 __attribute__((ext_vector_type(8)));
typedef float f32x16 __attribute__((ext_vector_type(16)));
typedef float f32x4 __attribute__((ext_vector_type(4)));
typedef float f32x2 __attribute__((ext_vector_type(2)));
typedef unsigned u32x4 __attribute__((ext_vector_type(4)));
typedef unsigned u32x2 __attribute__((ext_vector_type(2)));
#define DEV __device__ __forceinline__
#define MFMA32(a, b, c) __builtin_amdgcn_mfma_f32_32x32x16_bf16((a), (b), (c), 0, 0, 0)

constexpr int T = 16896, NP = 16384, DM = 1024, E = 2048, NBLK = 256;
constexpr int NPHASE = 11;
constexpr size_t SLOT = 69206016;
constexpr size_t OFF_A = 0;
constexpr size_t OFF_B = SLOT;
constexpr size_t OFF_C = 2 * SLOT;
constexpr size_t OFF_D = 3 * SLOT;
constexpr size_t OFF_E = 4 * SLOT;
constexpr size_t OFF_F = 5 * SLOT;
constexpr size_t OFF_W1 = 6 * SLOT;
constexpr size_t OFF_W2 = OFF_W1 + 12582912;
constexpr size_t OFF_W3 = OFF_W2 + 4194304;
constexpr size_t OFF_W4 = OFF_W3 + 8388608;
constexpr size_t OFF_WM = OFF_W4 + 4194304;
constexpr size_t OFF_WMS = OFF_WM + 262144;
constexpr size_t OFF_SW = OFF_WMS + 262144;
constexpr size_t OFF_VST = OFF_SW + 69206016;
constexpr size_t OFF_RS0 = OFF_VST + 4325376;
constexpr size_t OFF_SS1 = OFF_RS0 + 67584;
constexpr size_t OFF_SS2 = OFF_SS1 + 1081344;
constexpr size_t OFF_GB = OFF_SS2 + 1081344;
constexpr size_t OFF_GU = OFF_GB + 270336;
constexpr size_t OFF_GA = OFF_GU + 270336;
constexpr size_t OFF_WINTER = OFF_GA + 270336;
constexpr size_t OFF_WUPD = OFF_WINTER + 270336;
constexpr size_t OFF_DENI = OFF_WUPD + 270336;
constexpr size_t OFF_ENEGM = OFF_DENI + 270336;
constexpr size_t OFF_DINV = OFF_ENEGM + 270336;
constexpr size_t OFF_CHS = OFF_DINV + 270336;
constexpr size_t OFF_DECAY = OFF_CHS + 8192;
constexpr size_t OFF_GP = OFF_DECAY + 8192;
constexpr size_t OFF_BAR = OFF_GP + 1081344;
constexpr size_t OFF_GT = OFF_BAR + 16384;
constexpr size_t WS_END = OFF_GT + 524288;
constexpr size_t O_Y = 0;
constexpr size_t O_SGUV = 17301504;
constexpr size_t O_CP = 18350080;
constexpr size_t O_NP = 20447232;
constexpr size_t O_MP = 20451328;
constexpr size_t O_CONVP = 20451336;
constexpr size_t O_CS = 20463624;
constexpr size_t O_NS = 54018056;
constexpr size_t O_MS = 54083592;
constexpr size_t O_CONVS = 54083720;

struct Params {
  const float* in[25];
  float* out;
  char* ws;
  int ph_lo, ph_hi;
};

typedef __bf16 bf16v2 __attribute__((ext_vector_type(2)));
DEV unsigned cvt_pk_bf16(float lo, float hi) { f32x2 v = {lo, hi}; bf16v2 b = __builtin_convertvector(v, bf16v2); return __builtin_bit_cast(unsigned, b); }
DEV float bf_lo(unsigned u) { return __uint_as_float(u << 16); }
DEV float bf_hi(unsigned u) { return __uint_as_float(u & 0xffff0000u); }
DEV float bf1(bf16_t b) { return __uint_as_float(((unsigned)b) << 16); }
DEV bf16_t f2bf(float x) { return (bf16_t)(cvt_pk_bf16(x, 0.f) & 0xffffu); }
DEV float sigmoidf_(float x) { return __builtin_amdgcn_rcpf(1.f + __builtin_amdgcn_exp2f(-1.4426950408889634f * x)); }
DEV float siluf_(float x) { return x * __builtin_amdgcn_rcpf(1.f + __builtin_amdgcn_exp2f(-1.4426950408889634f * x)); }
DEV float geluf_(float x) { const float x2 = x * x; const float t = x * (-2.302208198092545f - 0.10294324517f * x2); return x * __builtin_amdgcn_rcpf(1.f + __builtin_amdgcn_exp2f(t)); }
DEV int crow(int reg, int h) { return (reg & 3) + 8 * (reg >> 2) + 4 * h; }
DEV float wave_sum(float v) {
#pragma unroll
  for (int o = 1; o < 64; o <<= 1) v += __shfl_xor(v, o);
  return v;
}
DEV bf16x8 as_bf16x8(u32x4 v) { return __builtin_bit_cast(bf16x8, v); }

DEV void transpose_tile(const float* __restrict__ W, int K, int N, const float* __restrict__ gain, bf16_t* __restrict__ WT, int tile, float* scr) {
  const int tid = threadIdx.x;
  const int ntn = N / 64, kb = tile / ntn, nb = tile % ntn, k0 = kb * 64, n0 = nb * 64;
#pragma unroll
  for (int j = 0; j < 4; ++j) {
    const int c = tid + 256 * j, r = c >> 4, c4 = (c & 15) * 4;
    f32x4 v = *(const f32x4*)(W + (size_t)(k0 + r) * N + n0 + c4);
    const float g = gain ? gain[k0 + r] : 1.f;
    scr[r * 65 + c4 + 0] = v.x * g; scr[r * 65 + c4 + 1] = v.y * g; scr[r * 65 + c4 + 2] = v.z * g; scr[r * 65 + c4 + 3] = v.w * g;
  }
  __syncthreads();
  {
    const int n = tid >> 2, ks = (tid & 3) * 16;
    u32x4 o0, o1;
    const float* s = scr + ks * 65 + n;
    o0.x = cvt_pk_bf16(s[0 * 65], s[1 * 65]); o0.y = cvt_pk_bf16(s[2 * 65], s[3 * 65]); o0.z = cvt_pk_bf16(s[4 * 65], s[5 * 65]); o0.w = cvt_pk_bf16(s[6 * 65], s[7 * 65]);
    o1.x = cvt_pk_bf16(s[8 * 65], s[9 * 65]); o1.y = cvt_pk_bf16(s[10 * 65], s[11 * 65]); o1.z = cvt_pk_bf16(s[12 * 65], s[13 * 65]); o1.w = cvt_pk_bf16(s[14 * 65], s[15 * 65]);
    bf16_t* dst = WT + (size_t)(n0 + n) * K + k0 + ks;
    *(u32x4*)dst = o0; *(u32x4*)(dst + 8) = o1;
  }
  __syncthreads();
}

DEV void phase0(const Params& p, char* smem) {
  float* scr = (float*)smem;
  const int nb = gridDim.x, bid = blockIdx.x, tid = threadIdx.x;
  bf16_t* W1 = (bf16_t*)(p.ws + OFF_W1); bf16_t* W2 = (bf16_t*)(p.ws + OFF_W2); bf16_t* W3 = (bf16_t*)(p.ws + OFF_W3); bf16_t* W4 = (bf16_t*)(p.ws + OFF_W4);
  constexpr int T1 = 16 * 96, T2 = 32 * 16, T3 = 16 * 64, T4 = 32 * 16;
  for (int it = bid; it < T1 + T2 + T3 + T4; it += nb) {
    int r = it;
    if (r < T1) { transpose_tile(p.in[8], 1024, 6144, p.in[6], W1, r, scr); continue; } r -= T1;
    if (r < T2) { transpose_tile(p.in[13], 2048, 1024, nullptr, W2, r, scr); continue; } r -= T2;
    if (r < T3) { transpose_tile(p.in[14], 1024, 4096, p.in[6] + 1024, W3, r, scr); continue; } r -= T3;
    transpose_tile(p.in[24], 2048, 1024, nullptr, W4, r, scr);
  }
  {
    bf16_t* XB = (bf16_t*)(p.ws + OFF_E); float* RS0 = (float*)(p.ws + OFF_RS0);
    const int lane = tid & 63, wid = tid >> 6;
    for (int row = bid * 4 + wid; row < T; row += nb * 4) {
      const float* xr = row < NP ? p.in[0] + (size_t)row * DM : p.in[1] + (size_t)(row - NP) * DM;
      f32x4 v[4]; float ss = 0.f;
#pragma unroll
      for (int j = 0; j < 4; ++j) { v[j] = *(const f32x4*)(xr + j * 256 + lane * 4); ss += v[j].x * v[j].x + v[j].y * v[j].y + v[j].z * v[j].z + v[j].w * v[j].w; }
      ss = wave_sum(ss);
#pragma unroll
      for (int j = 0; j < 4; ++j) { u32x2 o; o.x = cvt_pk_bf16(v[j].x, v[j].y); o.y = cvt_pk_bf16(v[j].z, v[j].w); *(u32x2*)(XB + (size_t)row * DM + j * 256 + lane * 4) = o; }
      if (lane == 0) RS0[row] = rsqrtf(ss * (1.f / DM) + 1e-6f);
    }
  }
  {
    bf16_t* GT = (bf16_t*)(p.ws + OFF_GT);
    const float* wq = p.in[17]; const float* wk = p.in[18]; const float* wv = p.in[19]; const float* wgt = p.in[20];
    for (int idx = bid * 256 + tid; idx < 32 * 4096; idx += nb * 256) {
      const int j = idx >> 12, k = idx & 4095;
      bf16_t hi = 0, lo = 0;
      if (j < 8) {
        const int part = k >> 11, ch = k & 2047, nbk = ch >> 2, i = ch & 3, cb4 = ch & ~3;
        float g = 0.f;
#pragma unroll
        for (int o = 0; o < 4; ++o) {
          if (part == 0) g += wq[nbk * 16 + i * 4 + o] * wgt[(size_t)(cb4 + o) * 8 + j] + wk[nbk * 16 + i * 4 + o] * wgt[(size_t)(E + cb4 + o) * 8 + j];
          else g += wv[nbk * 16 + i * 4 + o] * wgt[(size_t)(2 * E + cb4 + o) * 8 + j];
        }
        hi = f2bf(g); lo = f2bf(g - bf1(hi));
      }
      GT[(size_t)j * 4096 + k] = hi; GT[(size_t)(32 + j) * 4096 + k] = lo;
    }
  }
  {
    bf16_t* WM = (bf16_t*)(p.ws + OFF_WM); bf16_t* WMS = (bf16_t*)(p.ws + OFF_WMS);
    const float* ws_ = p.in[11];
    for (int i = bid * 256 + tid; i < 8 * 128 * 128; i += nb * 256) {
      const int g = i >> 14, t = (i >> 7) & 127, s = i & 127;
      WM[i] = f2bf(s <= t ? ws_[i] : 0.f);
      const int tl = t & 15, sl = s & 15;
      WMS[i] = f2bf(((t >> 4) == (s >> 4) && sl <= tl) ? ws_[(g << 14) + tl * 128 + sl] : 0.f);
    }
  }
}

constexpr int LDS_ST = 72;
constexpr int TILE_E = 128 * LDS_ST;

constexpr int TILE_G = 128 * 64;

template <int MI, class Epi>
DEV void gemm_tile(const bf16_t* __restrict__ X, const bf16_t* __restrict__ W, const int K, const int row0, const int col0, const Epi& epi, bf16_t* sm) {
  int tid_ = threadIdx.x; asm volatile("" : "+v"(tid_));
  const int tid = tid_, lane = tid & 63, wid = tid >> 6, wr = wid >> 1, wc = wid & 1;
  const int l31 = lane & 31, hh = lane >> 5;
  bf16_t* sa = sm; bf16_t* sb = sm + 2 * TILE_G;
  f32x16 acc[MI][2];
#pragma unroll
  for (int a = 0; a < MI; ++a)
#pragma unroll
    for (int b = 0; b < 2; ++b)
#pragma unroll
      for (int i = 0; i < 16; ++i) acc[a][b][i] = 0.f;
  const int srow = wid * 8 + (lane >> 3);
  const int sc8 = ((lane & 7) ^ (((wid & 1) << 2) | (lane >> 4))) * 8;
  const bf16_t* xp = X + (size_t)(row0 + srow) * K + sc8;
  const bf16_t* wp = W + (size_t)(col0 + srow) * K + sc8;
  const int sdst = wid * 8 * 64 + lane * 8;
#define GEMM_STAGE(bufi, k0) do { _Pragma("unroll") for (int j = 0; j < 4; ++j) { \
      if (j < 2 * MI) __builtin_amdgcn_global_load_lds((const unsigned*)(xp + (size_t)(32 * j) * K + (k0)), (unsigned*)(sa + (bufi) * TILE_G + sdst + j * 2048), 16, 0, 0); \
      __builtin_amdgcn_global_load_lds((const unsigned*)(wp + (size_t)(32 * j) * K + (k0)), (unsigned*)(sb + (bufi) * TILE_G + sdst + j * 2048), 16, 0, 0); } } while (0)
  GEMM_STAGE(0, 0); GEMM_STAGE(1, 64);
  const int swz = (l31 >> 1) & 7;
  int koff[4];
#pragma unroll
  for (int kk = 0; kk < 4; ++kk) koff[kk] = ((2 * kk + hh) ^ swz) * 8;
  const int nk = K >> 6;
  for (int kt = 0; kt < nk; ++kt) {
    const int buf = kt & 1;
    if (kt + 1 < nk) { if (MI == 2) asm volatile("s_waitcnt vmcnt(8)" ::: "memory"); else asm volatile("s_waitcnt vmcnt(6)" ::: "memory"); }
    else asm volatile("s_waitcnt vmcnt(0)" ::: "memory");
    __builtin_amdgcn_s_barrier();
    const bf16_t* ca = sa + buf * TILE_G + (wr * 32 * MI + l31) * 64;
    const bf16_t* cb = sb + buf * TILE_G + (wc * 64 + l31) * 64;
    bf16x8 fa[4][MI], fb[4][2];
#pragma unroll
    for (int kk = 0; kk < 4; ++kk) {
#pragma unroll
      for (int mi = 0; mi < MI; ++mi) fa[kk][mi] = *(const bf16x8*)(ca + mi * 32 * 64 + koff[kk]);
      fb[kk][0] = *(const bf16x8*)(cb + koff[kk]); fb[kk][1] = *(const bf16x8*)(cb + 32 * 64 + koff[kk]);
    }
    asm volatile("s_waitcnt lgkmcnt(0)" ::: "memory");
    __builtin_amdgcn_s_barrier();
    if (kt + 2 < nk) GEMM_STAGE(buf, (kt + 2) * 64);
    __builtin_amdgcn_sched_barrier(0);
    __builtin_amdgcn_s_setprio(1);
#pragma unroll
    for (int kk = 0; kk < 4; ++kk)
#pragma unroll
      for (int mi = 0; mi < MI; ++mi) {
        acc[mi][0] = MFMA32(fb[kk][0], fa[kk][mi], acc[mi][0]); acc[mi][1] = MFMA32(fb[kk][1], fa[kk][mi], acc[mi][1]);
      }
    __builtin_amdgcn_s_setprio(0);
  }
#undef GEMM_STAGE
  epi.template run<MI>(acc, row0 + wr * 32 * MI, col0 + wc * 64, l31, hh);
}

template <class Epi>
DEV void gemm_phase(const bf16_t* X, const bf16_t* W, int N, int K, const Epi& epi, bf16_t* sm, bool half_tail = false) {
  const int ntn = N / 128, ntm = T / 128, nt = ntn * ntm;
  const int rem = nt % (int)gridDim.x;
  const int full_rows = (half_tail && rem > 0 && rem % ntn == 0) ? ntm - rem / ntn : ntm;
  const int G = gridDim.x;
  if (half_tail && ntn == 8 && (G & 7) == 0 && (full_rows & 1) == 0) {
    const int x = blockIdx.x & 7, cgrp = x & 3, rsub = x >> 2, nbx = G >> 3, nloc = (full_rows >> 1) * 2;
    for (int li = blockIdx.x >> 3; li < nloc; li += nbx) {
      const int tm = 2 * (li >> 1) + rsub, tn = 2 * cgrp + (li & 1);
      gemm_tile<2>(X, W, K, tm * 128, tn * 128, epi, sm);
    }
  } else {
    for (int t = blockIdx.x; t < full_rows * ntn; t += gridDim.x) {
      const int tm = t / ntn, tn = t % ntn;
      gemm_tile<2>(X, W, K, tm * 128, tn * 128, epi, sm);
    }
  }
  if (full_rows < ntm) {
    for (int t = blockIdx.x; t < (ntm - full_rows) * 2 * ntn; t += gridDim.x) {
      const int tmh = t / ntn, tn = t % ntn;
      gemm_tile<1>(X, W, K, full_rows * 128 + tmh * 64, tn * 128, epi, sm);
    }
  }
}

struct Epi1 {
  const float* rs0; bf16_t* U; bf16_t* VT; bf16_t* Z; float* VST;
  template <int MI> DEV void run(const f32x16 (&acc)[MI][2], int rbase, int cbase, int l31, int hh) const {
    const float rr[2] = {rs0[rbase + l31], rs0[rbase + 32 + l31]};
#pragma unroll
    for (int mi = 0; mi < MI; ++mi) {
      const int tok = rbase + mi * 32 + l31;
      const float r = rr[mi];
      if (cbase < 2048) {
#pragma unroll
        for (int ni = 0; ni < 2; ++ni)
#pragma unroll
          for (int g = 0; g < 4; ++g) {
            const int ch = cbase + ni * 32 + 8 * g + 4 * hh;
            u32x2 o; o.x = cvt_pk_bf16(geluf_(acc[mi][ni][4 * g] * r), geluf_(acc[mi][ni][4 * g + 1] * r));
            o.y = cvt_pk_bf16(geluf_(acc[mi][ni][4 * g + 2] * r), geluf_(acc[mi][ni][4 * g + 3] * r));
            *(u32x2*)(U + (size_t)tok * E + ch) = o;
          }
      } else if (cbase < 4096) {
        float s = 0.f, ss = 0.f;
#pragma unroll
        for (int ni = 0; ni < 2; ++ni)
#pragma unroll
          for (int i = 0; i < 16; ++i) {
            const int ch = cbase - 2048 + ni * 32 + crow(i, hh);
            const float v = geluf_(acc[mi][ni][i] * r);
            s += v; ss += v * v;
            VT[(size_t)ch * T + tok] = f2bf(v);
          }
        s += __shfl_xor(s, 32); ss += __shfl_xor(ss, 32);
        if (hh == 0) { f32x2 o; o.x = s; o.y = ss; *(f32x2*)(VST + ((size_t)tok * 32 + ((cbase - 2048) >> 6)) * 2) = o; }
      } else {
#pragma unroll
        for (int ni = 0; ni < 2; ++ni)
#pragma unroll
          for (int g = 0; g < 4; ++g) {
            const int ch = cbase - 4096 + ni * 32 + 8 * g + 4 * hh;
            u32x2 o; o.x = cvt_pk_bf16(acc[mi][ni][4 * g] * r, acc[mi][ni][4 * g + 1] * r);
            o.y = cvt_pk_bf16(acc[mi][ni][4 * g + 2] * r, acc[mi][ni][4 * g + 3] * r);
            *(u32x2*)(Z + (size_t)tok * E + ch) = o;
          }
      }
    }
  }
};

struct EpiRes {
  const float* res_p; const float* res_s;
  float* OUT; bf16_t* OUTB; float* SS;
  template <int MI> DEV void run(const f32x16 (&acc)[MI][2], int rbase, int cbase, int l31, int hh) const {
#pragma unroll
    for (int mi = 0; mi < MI; ++mi) {
      const int tok = rbase + mi * 32 + l31;
      const float* rp = tok < NP ? res_p + (size_t)tok * DM : res_s + (size_t)(tok - NP) * DM;
      f32x4 rva[2][4];
#pragma unroll
      for (int ni = 0; ni < 2; ++ni)
#pragma unroll
        for (int g = 0; g < 4; ++g) rva[ni][g] = *(const f32x4*)(rp + cbase + ni * 32 + 8 * g + 4 * hh);
      float ss = 0.f;
#pragma unroll
      for (int ni = 0; ni < 2; ++ni)
#pragma unroll
        for (int g = 0; g < 4; ++g) {
          const int ch = cbase + ni * 32 + 8 * g + 4 * hh;
          const f32x4 rv = rva[ni][g];
          f32x4 o; o.x = acc[mi][ni][4 * g] + rv.x; o.y = acc[mi][ni][4 * g + 1] + rv.y; o.z = acc[mi][ni][4 * g + 2] + rv.z; o.w = acc[mi][ni][4 * g + 3] + rv.w;
          ss += o.x * o.x + o.y * o.y + o.z * o.z + o.w * o.w;
          *(f32x4*)(OUT + (size_t)tok * DM + ch) = o;
          if (OUTB) { u32x2 b; b.x = cvt_pk_bf16(o.x, o.y); b.y = cvt_pk_bf16(o.z, o.w); *(u32x2*)(OUTB + (size_t)tok * DM + ch) = b; }
        }
      ss += __shfl_xor(ss, 32);
      if (hh == 0) SS[(size_t)tok * 16 + (cbase >> 6)] = ss;
    }
  }
};

struct Epi3 {
  const float* SS1; bf16_t* XM; bf16_t* Z2;
  template <int MI> DEV void run(const f32x16 (&acc)[MI][2], int rbase, int cbase, int l31, int hh) const {
    float sums[2];
#pragma unroll
    for (int mi = 0; mi < MI; ++mi) {
      float s = 0.f;
#pragma unroll
      for (int j = 0; j < 4; ++j) { const f32x4 v = *(const f32x4*)(SS1 + (size_t)(rbase + mi * 32 + l31) * 16 + 4 * j); s += v.x + v.y + v.z + v.w; }
      sums[mi] = s;
    }
#pragma unroll
    for (int mi = 0; mi < MI; ++mi) {
      const int tok = rbase + mi * 32 + l31;
      const float r = rsqrtf(sums[mi] * (1.f / DM) + 1e-6f);
      bf16_t* dst = cbase < 2048 ? XM + (size_t)tok * E + cbase : Z2 + (size_t)tok * E + cbase - 2048;
#pragma unroll
      for (int ni = 0; ni < 2; ++ni)
#pragma unroll
        for (int g = 0; g < 4; ++g) {
          u32x2 o; o.x = cvt_pk_bf16(acc[mi][ni][4 * g] * r, acc[mi][ni][4 * g + 1] * r);
          o.y = cvt_pk_bf16(acc[mi][ni][4 * g + 2] * r, acc[mi][ni][4 * g + 3] * r);
          *(u32x2*)(dst + ni * 32 + 8 * g + 4 * hh) = o;
        }
    }
  }
};

DEV void sgu_phase(const Params& p, char* smem) {
  const int tid = threadIdx.x, lane = tid & 63, wid = tid >> 6, l31 = lane & 31, hh = lane >> 5;
  float* smu = (float*)smem; float* srs = smu + 128;
  const bf16_t* U = (const bf16_t*)(p.ws + OFF_A); const bf16_t* VT = (const bf16_t*)(p.ws + OFF_B); const bf16_t* Z = (const bf16_t*)(p.ws + OFF_C);
  bf16_t* G = (bf16_t*)(p.ws + OFF_D);
  const float* VST = (const float*)(p.ws + OFF_VST);
  const float* lng = p.in[9]; const float* lnb = p.in[10]; const float* bs = p.in[12];
  for (int unit = blockIdx.x; unit < 132 * 8; unit += gridDim.x) {
    const int ci = unit >> 3, g = unit & 7, tok0 = ci * 128;
    const bool samp = ci >= 128;
    const bf16_t* WMg = (const bf16_t*)(p.ws + (samp ? OFF_WMS : OFF_WM)) + g * 16384;
    __syncthreads();
    if (tid < 128) {
      float s = 0.f, ss = 0.f;
      const f32x4* q = (const f32x4*)(VST + (size_t)(tok0 + tid) * 64);
#pragma unroll
      for (int j = 0; j < 16; ++j) { const f32x4 v = q[j]; s += v.x + v.z; ss += v.y + v.w; }
      const float mean = s * (1.f / E); const float var = ss * (1.f / E) - mean * mean;
      smu[tid] = mean; srs[tid] = rsqrtf(var + 1e-5f);
    }
    __syncthreads();
    const int cbase = g * 256 + wid * 64;
    bf16x8 af[2][8];
#pragma unroll
    for (int mi = 0; mi < 2; ++mi) {
      const int c = cbase + mi * 32 + l31;
      const float gg = lng[c], bb = lnb[c];
      u32x4 raws[8];
#pragma unroll
      for (int kk = 0; kk < 8; ++kk) raws[kk] = *(const u32x4*)(VT + (size_t)c * T + tok0 + kk * 16 + 8 * hh);
      __builtin_amdgcn_sched_barrier(0);
#pragma unroll
      for (int kk = 0; kk < 8; ++kk) {
        const int s0 = kk * 16 + 8 * hh;
        const u32x4 raw = raws[kk];
        const f32x4 m0 = *(const f32x4*)(smu + s0), m1 = *(const f32x4*)(smu + s0 + 4);
        const f32x4 r0 = *(const f32x4*)(srs + s0), r1 = *(const f32x4*)(srs + s0 + 4);
        float v[8];
        v[0] = (bf_lo(raw.x) - m0.x) * r0.x * gg + bb; v[1] = (bf_hi(raw.x) - m0.y) * r0.y * gg + bb;
        v[2] = (bf_lo(raw.y) - m0.z) * r0.z * gg + bb; v[3] = (bf_hi(raw.y) - m0.w) * r0.w * gg + bb;
        v[4] = (bf_lo(raw.z) - m1.x) * r1.x * gg + bb; v[5] = (bf_hi(raw.z) - m1.y) * r1.y * gg + bb;
        v[6] = (bf_lo(raw.w) - m1.z) * r1.z * gg + bb; v[7] = (bf_hi(raw.w) - m1.w) * r1.w * gg + bb;
        u32x4 pk; pk.x = cvt_pk_bf16(v[0], v[1]); pk.y = cvt_pk_bf16(v[2], v[3]); pk.z = cvt_pk_bf16(v[4], v[5]); pk.w = cvt_pk_bf16(v[6], v[7]);
        af[mi][kk] = as_bf16x8(pk);
        if (samp) {
          float* sv = p.out + O_SGUV + (size_t)(tok0 - NP + s0) * E + c;
#pragma unroll
          for (int j = 0; j < 8; ++j) sv[(size_t)j * E] = v[j];
        }
      }
    }
#pragma unroll
    for (int nt = 0; nt < 4; ++nt) {
      f32x16 acc[2];
#pragma unroll
      for (int i = 0; i < 16; ++i) { acc[0][i] = 0.f; acc[1][i] = 0.f; }
      const int tl = nt * 32 + l31;
      u32x4 bfrs[8];
#pragma unroll
      for (int kk = 0; kk < 8; ++kk) if (kk <= 2 * nt + 1) bfrs[kk] = *(const u32x4*)(WMg + tl * 128 + kk * 16 + 8 * hh);
      __builtin_amdgcn_sched_barrier(0);
#pragma unroll
      for (int kk = 0; kk < 8; ++kk) {
        if (kk <= 2 * nt + 1) {
          acc[0] = MFMA32(af[0][kk], as_bf16x8(bfrs[kk]), acc[0]);
          acc[1] = MFMA32(af[1][kk], as_bf16x8(bfrs[kk]), acc[1]);
        }
      }
      const int tok = tok0 + tl;
      const float bias = bs[g * 128 + (samp ? (tl & 15) : tl)];
      u32x2 uus[2][4], zzs[2][4];
#pragma unroll
      for (int mi = 0; mi < 2; ++mi)
#pragma unroll
        for (int q = 0; q < 4; ++q) {
          const int c = cbase + mi * 32 + 8 * q + 4 * hh;
          uus[mi][q] = *(const u32x2*)(U + (size_t)tok * E + c);
          zzs[mi][q] = *(const u32x2*)(Z + (size_t)tok * E + c);
        }
#pragma unroll
      for (int mi = 0; mi < 2; ++mi)
#pragma unroll
        for (int q = 0; q < 4; ++q) {
          const int c = cbase + mi * 32 + 8 * q + 4 * hh;
          const u32x2 uu = uus[mi][q];
          const u32x2 zz = zzs[mi][q];
          const float o0 = bf_lo(uu.x) * (acc[mi][4 * q] + bias) * siluf_(bf_lo(zz.x));
          const float o1 = bf_hi(uu.x) * (acc[mi][4 * q + 1] + bias) * siluf_(bf_hi(zz.x));
          const float o2 = bf_lo(uu.y) * (acc[mi][4 * q + 2] + bias) * siluf_(bf_lo(zz.y));
          const float o3 = bf_hi(uu.y) * (acc[mi][4 * q + 3] + bias) * siluf_(bf_hi(zz.y));
          u32x2 o; o.x = cvt_pk_bf16(o0, o1); o.y = cvt_pk_bf16(o2, o3);
          *(u32x2*)(G + (size_t)tok * E + c) = o;
        }
    }
  }
}

DEV int perm4(int g) { return ((g & 1) << 1) | (g >> 1); }

struct ConvHist { float x1[4], x2[4], x3[4]; };
DEV void conv_hist_init(ConvHist& H, const bf16_t* XM, const float* conv0, int t, int tt, int pos, bool samp, int ch) {
  if (pos == 0) {
    if (samp) {
      const float* c0 = conv0 + (size_t)((t - NP) >> 4) * 3 * E + ch;
      const f32x4 a = *(const f32x4*)(c0), b = *(const f32x4*)(c0 + E), c = *(const f32x4*)(c0 + 2 * E);
      H.x3[0] = a.x; H.x3[1] = a.y; H.x3[2] = a.z; H.x3[3] = a.w; H.x2[0] = b.x; H.x2[1] = b.y; H.x2[2] = b.z; H.x2[3] = b.w; H.x1[0] = c.x; H.x1[1] = c.y; H.x1[2] = c.z; H.x1[3] = c.w;
    } else {
#pragma unroll
      for (int i = 0; i < 4; ++i) { H.x1[i] = 0.f; H.x2[i] = 0.f; H.x3[i] = 0.f; }
    }
  } else if (tt == 0) {
    const u32x2 a = *(const u32x2*)(XM + (size_t)(t - 1) * E + ch), b = *(const u32x2*)(XM + (size_t)(t - 2) * E + ch), c = *(const u32x2*)(XM + (size_t)(t - 3) * E + ch);
    H.x1[0] = bf_lo(a.x); H.x1[1] = bf_hi(a.x); H.x1[2] = bf_lo(a.y); H.x1[3] = bf_hi(a.y);
    H.x2[0] = bf_lo(b.x); H.x2[1] = bf_hi(b.x); H.x2[2] = bf_lo(b.y); H.x2[3] = bf_hi(b.y);
    H.x3[0] = bf_lo(c.x); H.x3[1] = bf_hi(c.x); H.x3[2] = bf_lo(c.y); H.x3[3] = bf_hi(c.y);
  }
}

DEV float reduce16(float (&r16)[16], int lane) {
#pragma unroll
  for (int i = 0; i < 8; ++i) { const bool up = lane & 8; const float send = up ? r16[i] : r16[i + 8]; const float keep = up ? r16[i + 8] : r16[i]; r16[i] = keep + __shfl_xor(send, 8); }
#pragma unroll
  for (int i = 0; i < 4; ++i) { const bool up = lane & 4; const float send = up ? r16[i] : r16[i + 4]; const float keep = up ? r16[i + 4] : r16[i]; r16[i] = keep + __shfl_xor(send, 4); }
#pragma unroll
  for (int i = 0; i < 2; ++i) { const bool up = lane & 2; const float send = up ? r16[i] : r16[i + 2]; const float keep = up ? r16[i + 2] : r16[i]; r16[i] = keep + __shfl_xor(send, 2); }
  { const bool up = lane & 1; const float send = up ? r16[0] : r16[1]; const float keep = up ? r16[1] : r16[0]; r16[0] = keep + __shfl_xor(send, 1); }
  float tot = r16[0];
  tot += __shfl_xor(tot, 16); tot += __shfl_xor(tot, 32);
  return tot;
}

DEV void conv_phase(const Params& p, char* smem) {
  const int tid = threadIdx.x;
  const bf16_t* XM = (const bf16_t*)(p.ws + OFF_B);
  bf16_t* XC = (bf16_t*)(p.ws + OFF_D); bf16_t* QF = (bf16_t*)(p.ws + OFF_E); bf16_t* VF = (bf16_t*)(p.ws + OFF_F);
  bf16_t* KF = (bf16_t*)(p.out + O_CS); bf16_t* KTF = (bf16_t*)(p.out + O_Y);
  const float* conv0 = p.in[5]; const float* convw = p.in[15]; const float* convb = p.in[16];
  const float* wq = p.in[17]; const float* wk = p.in[18]; const float* wv = p.in[19];
  const float kscale = 0.04419417382415922f;
  bf16_t* QS = (bf16_t*)(smem + 4096); bf16_t* KS = QS + 128 * 136;
  for (int unit = blockIdx.x; unit < (T / 16) * 2; unit += gridDim.x) {
    const int hf = unit & 1, tok0 = (unit >> 1) * 16, cg = tok0 >> 6, tt0 = tok0 & 63;
    const bool samp = tok0 >= NP;
    const int nb = hf * 256 + tid, ch = nb * 4, h = nb >> 7, nl = nb & 127;
    const int pd = (nl & ~3) * 4 + perm4(nl & 3) * 4, kstep = pd >> 4, hhq = (pd >> 3) & 1, j0 = pd & 7;
    float cw[4][4], cb[4], q_w[4][4], k_w[4][4], v_w[4][4];
#pragma unroll
    for (int j = 0; j < 4; ++j) { const f32x4 v = *(const f32x4*)(convw + j * E + ch); cw[j][0] = v.x; cw[j][1] = v.y; cw[j][2] = v.z; cw[j][3] = v.w; }
    { const f32x4 v = *(const f32x4*)(convb + ch); cb[0] = v.x; cb[1] = v.y; cb[2] = v.z; cb[3] = v.w; }
#pragma unroll
    for (int i = 0; i < 4; ++i) {
      const f32x4 a = *(const f32x4*)(wq + nb * 16 + i * 4), b = *(const f32x4*)(wk + nb * 16 + i * 4), c = *(const f32x4*)(wv + nb * 16 + i * 4);
      q_w[i][0] = a.x; q_w[i][1] = a.y; q_w[i][2] = a.z; q_w[i][3] = a.w;
      k_w[i][0] = b.x * kscale; k_w[i][1] = b.y * kscale; k_w[i][2] = b.z * kscale; k_w[i][3] = b.w * kscale;
      v_w[i][0] = c.x; v_w[i][1] = c.y; v_w[i][2] = c.z; v_w[i][3] = c.w;
    }
    u32x2 xrow[16];
#pragma unroll
    for (int i = 0; i < 16; ++i) xrow[i] = *(const u32x2*)(XM + (size_t)(tok0 + i) * E + ch);
    __syncthreads();
    ConvHist H;
    const int srun = (((tid >> 7) * 32 + kstep) * 2 + hhq) * 136 + j0;
#pragma unroll
    for (int tb8 = 0; tb8 < 2; ++tb8) {
      unsigned kacc[4][4], vacc[4][4];
#pragma unroll
      for (int pr = 0; pr < 4; ++pr) {
        float kq[2][4], vq[2][4];
#pragma unroll
        for (int u = 0; u < 2; ++u) {
          const int ttl = tb8 * 8 + pr * 2 + u, t = tok0 + ttl;
          const int pos = samp ? ttl : (t & 8191);
          conv_hist_init(H, XM, conv0, t, ttl, pos, samp, ch);
          const u32x2 xr = xrow[ttl];
          float x0[4] = {bf_lo(xr.x), bf_hi(xr.x), bf_lo(xr.y), bf_hi(xr.y)};
          float xc[4];
#pragma unroll
          for (int i = 0; i < 4; ++i) xc[i] = siluf_(cb[i] + cw[0][i] * H.x3[i] + cw[1][i] * H.x2[i] + cw[2][i] * H.x1[i] + cw[3][i] * x0[i]);
          float qv[4];
#pragma unroll
          for (int o = 0; o < 4; ++o) {
            qv[o] = xc[0] * q_w[0][o] + xc[1] * q_w[1][o] + xc[2] * q_w[2][o] + xc[3] * q_w[3][o];
            kq[u][o] = xc[0] * k_w[0][o] + xc[1] * k_w[1][o] + xc[2] * k_w[2][o] + xc[3] * k_w[3][o];
            vq[u][o] = x0[0] * v_w[0][o] + x0[1] * v_w[1][o] + x0[2] * v_w[2][o] + x0[3] * v_w[3][o];
          }
          { u32x2 o; o.x = cvt_pk_bf16(xc[0], xc[1]); o.y = cvt_pk_bf16(xc[2], xc[3]); *(u32x2*)(XC + (size_t)t * E + ch) = o; }
          { u32x2 o; o.x = cvt_pk_bf16(qv[0], qv[1]); o.y = cvt_pk_bf16(qv[2], qv[3]); *(u32x2*)(QS + srun + ttl * 8) = o; }
          { u32x2 o; o.x = cvt_pk_bf16(kq[u][0], kq[u][1]); o.y = cvt_pk_bf16(kq[u][2], kq[u][3]); *(u32x2*)(KS + srun + ttl * 8) = o; }
          if (samp) { if (pos >= 13) { f32x4 o; o.x = x0[0]; o.y = x0[1]; o.z = x0[2]; o.w = x0[3]; *(f32x4*)(p.out + O_CONVS + ((size_t)((t - NP) >> 4) * 3 + (pos - 13)) * E + ch) = o; } }
          else if (pos >= 8189) { f32x4 o; o.x = x0[0]; o.y = x0[1]; o.z = x0[2]; o.w = x0[3]; *(f32x4*)(p.out + O_CONVP + ((size_t)(t >> 13) * 3 + (pos - 8189)) * E + ch) = o; }
#pragma unroll
          for (int i = 0; i < 4; ++i) { H.x3[i] = H.x2[i]; H.x2[i] = H.x1[i]; H.x1[i] = x0[i]; }
        }
#pragma unroll
        for (int o = 0; o < 4; ++o) { kacc[o][pr] = cvt_pk_bf16(kq[0][o], kq[1][o]); vacc[o][pr] = cvt_pk_bf16(vq[0][o], vq[1][o]); }
      }
      const int tg = tt0 + tb8 * 8, ks = tg >> 4, hht = (tg >> 3) & 1;
#pragma unroll
      for (int o = 0; o < 4; ++o) {
        const int d = nl * 4 + o;
        const size_t fo = ((((size_t)(cg * 4 + h) * 16 + (d >> 5)) * 4 + ks) * 64 + (d & 31) + 32 * hht) * 8;
        u32x4 kk_; kk_.x = kacc[o][0]; kk_.y = kacc[o][1]; kk_.z = kacc[o][2]; kk_.w = kacc[o][3];
        u32x4 vv_; vv_.x = vacc[o][0]; vv_.y = vacc[o][1]; vv_.z = vacc[o][2]; vv_.w = vacc[o][3];
        *(u32x4*)(KTF + fo) = kk_;
        *(u32x4*)(VF + fo) = vv_;
      }
    }
    __syncthreads();
#pragma unroll 2
    for (int i = 0; i < 8; ++i) {
      const int pc = i * 256 + tid, run = pc >> 4, l16 = pc & 15;
      const int hl = run >> 6, ks_ = (run >> 1) & 31, hq_ = run & 1;
      const size_t dst = ((size_t)((cg * 4 + 2 * hf + hl) * 64 + (tt0 >> 5) * 32 + ks_)) * 512 + ((tt0 & 31) + l16 + 32 * hq_) * 8;
      *(u32x4*)(QF + dst) = *(const u32x4*)(QS + run * 136 + l16 * 8);
      *(u32x4*)(KF + dst) = *(const u32x4*)(KS + run * 136 + l16 * 8);
    }
  }
}

DEV void gate_phase(const Params& p, char* smem) {
  const int tid = threadIdx.x, lane = tid & 63, wid = tid >> 6, l31 = lane & 31, hh = lane >> 5;
  float* sig = (float*)smem; float* slf = sig + 256;
  float* red = (float*)(smem + 2048);
  const bf16_t* XMb = (const bf16_t*)(p.ws + OFF_B); const bf16_t* XCb = (const bf16_t*)(p.ws + OFF_D);
  const bf16_t* GT = (const bf16_t*)(p.ws + OFF_GT);
  const float* bgt = p.in[21];
  float* GB = (float*)(p.ws + OFF_GB); float* GU = (float*)(p.ws + OFF_GU); float* GA = (float*)(p.ws + OFF_GA); float* CHS = (float*)(p.ws + OFF_CHS);
  for (int unit = blockIdx.x; unit < T / 64; unit += gridDim.x) {
    const int tok0 = unit * 64;
    const bool samp = tok0 >= NP;
    __syncthreads();
    {
      bf16_t* slab = (bf16_t*)smem;
      f32x16 a0, a1;
#pragma unroll
      for (int i = 0; i < 16; ++i) { a0[i] = 0.f; a1[i] = 0.f; }
      const int lrow = tid >> 5, lc8 = (tid & 31) * 8;
      const bf16_t* gxc = XCb + (size_t)(tok0 + lrow) * E + lc8;
      const bf16_t* gxm = XMb + (size_t)(tok0 + lrow) * E + lc8;
      const bf16_t* gtp = GT + (size_t)(l31 < 8 ? l31 : 8) * 4096 + wid * 64 + 8 * hh;
      u32x4 ar[8], bcur[8], bnxt[8];
#pragma unroll
      for (int i = 0; i < 8; ++i) ar[i] = *(const u32x4*)(gxc + (size_t)(8 * i) * E);
#pragma unroll
      for (int i = 0; i < 4; ++i) { bcur[i] = *(const u32x4*)(gtp + i * 16); bcur[4 + i] = *(const u32x4*)(gtp + (size_t)32 * 4096 + i * 16); }
#pragma unroll
      for (int i = 0; i < 8; ++i) *(u32x4*)(slab + (lrow + 8 * i) * 264 + lc8) = ar[i];
      __syncthreads();
#pragma unroll 1
      for (int s = 0; s < 16; ++s) {
        const int buf = s & 1;
        if (s + 1 < 16) {
          const bf16_t* g = ((s + 1) < 8 ? gxc : gxm) + ((s + 1) & 7) * 256;
#pragma unroll
          for (int i = 0; i < 8; ++i) ar[i] = *(const u32x4*)(g + (size_t)(8 * i) * E);
#pragma unroll
          for (int i = 0; i < 4; ++i) { bnxt[i] = *(const u32x4*)(gtp + (s + 1) * 256 + i * 16); bnxt[4 + i] = *(const u32x4*)(gtp + (size_t)32 * 4096 + (s + 1) * 256 + i * 16); }
        }
        const bf16_t* sb0 = slab + buf * (64 * 264) + l31 * 264 + wid * 64 + 8 * hh;
#pragma unroll
        for (int i = 0; i < 4; ++i) {
          const bf16x8 x0 = *(const bf16x8*)(sb0 + i * 16), x1 = *(const bf16x8*)(sb0 + 32 * 264 + i * 16);
          a0 = MFMA32(x0, as_bf16x8(bcur[i]), a0); a1 = MFMA32(x1, as_bf16x8(bcur[i]), a1);
          a0 = MFMA32(x0, as_bf16x8(bcur[4 + i]), a0); a1 = MFMA32(x1, as_bf16x8(bcur[4 + i]), a1);
        }
        if (s + 1 < 16) {
#pragma unroll
          for (int i = 0; i < 8; ++i) *(u32x4*)(slab + (buf ^ 1) * (64 * 264) + (lrow + 8 * i) * 264 + lc8) = ar[i];
#pragma unroll
          for (int i = 0; i < 8; ++i) bcur[i] = bnxt[i];
        }
        __syncthreads();
      }
      if (l31 < 8) {
        float* rb = red + (wid * 64 + 4 * hh) * 8 + l31;
#pragma unroll
        for (int i = 0; i < 16; ++i) {
          const int t0 = (i & 3) + 8 * (i >> 2);
          rb[t0 * 8] = a0[i]; rb[(32 + t0) * 8] = a1[i];
        }
      }
    }
    __syncthreads();
    {
      const int tt = tid >> 2, h = tid & 3;
      float gi = bgt[h], gf = bgt[4 + h];
#pragma unroll
      for (int w = 0; w < 4; ++w) { gi += red[(w * 64 + tt) * 8 + h]; gf += red[(w * 64 + tt) * 8 + 4 + h]; }
      sig[h * 64 + tt] = gi;
      slf[h * 64 + tt] = fminf(gf, 0.f) - log1pf(__expf(-fabsf(gf)));
    }
    __syncthreads();
    {
      const int seglen = samp ? 16 : 64, nseg = 64 / seglen;
      if (tid < 4 * nseg) {
        const int h = tid & 3, sg = tid >> 2;
        float b = 0.f, a = -INFINITY;
        for (int j = 0; j < seglen; ++j) {
          const int tt = sg * seglen + j;
          b += slf[h * 64 + tt];
          const float u = sig[h * 64 + tt] - b;
          a = fmaxf(a, u);
          const size_t o = (size_t)(tok0 + tt) * 4 + h;
          GB[o] = b; GU[o] = u; GA[o] = a;
        }
        if (!samp) { CHS[(unit * 4 + h) * 2] = b; CHS[(unit * 4 + h) * 2 + 1] = a; }
      }
    }
  }
}

DEV size_t numidx(int row, int h, int e) { return ((((size_t)(row >> 1) * 4 + h) * 16 + (e >> 5)) * 2 + (row & 1)) * 32 + (e & 31); }

DEV u32x4 coherent_load16(const bf16_t* ptr) {
  unsigned* q = (unsigned*)ptr; u32x4 r;
  r.x = __hip_atomic_load(q, __ATOMIC_RELAXED, __HIP_MEMORY_SCOPE_AGENT); r.y = __hip_atomic_load(q + 1, __ATOMIC_RELAXED, __HIP_MEMORY_SCOPE_AGENT);
  r.z = __hip_atomic_load(q + 2, __ATOMIC_RELAXED, __HIP_MEMORY_SCOPE_AGENT); r.w = __hip_atomic_load(q + 3, __ATOMIC_RELAXED, __HIP_MEMORY_SCOPE_AGENT);
  return r;
}

constexpr int NSUB = 4;

DEV float mscan_prefix(const float* CHS, int pb, int h, int c, int lane) {
  float P[2], Q[2];
#pragma unroll
  for (int j = 0; j < 2; ++j) {
    const int i = 2 * lane + j;
    if (i < c) { const float bl = CHS[((pb * 128 + i) * 4 + h) * 2], al = CHS[((pb * 128 + i) * 4 + h) * 2 + 1]; P[j] = bl; Q[j] = al + bl; }
    else { P[j] = 0.f; Q[j] = -INFINITY; }
  }
  float Pc = P[0] + P[1], Qc = fmaxf(Q[0] + P[1], Q[1]);
#pragma unroll
  for (int off = 1; off < 64; off <<= 1) {
    const float Po = __shfl_xor(Pc, off), Qo = __shfl_xor(Qc, off);
    if (lane & off) { Qc = fmaxf(Qo + Pc, Qc); Pc = Po + Pc; }
    else { Qc = fmaxf(Qc + Po, Qo); Pc = Pc + Po; }
  }
  return fmaxf(Pc, Qc);
}

DEV void intra_phase(const Params& p, char* smem) {
  const int tid = threadIdx.x, lane = tid & 63, wid = tid >> 6, l31 = lane & 31, hh = lane >> 5;
  float* su = (float*)smem;
  float* sM = su + NSUB * 64;
  float* sden = sM + 64;
  bf16_t* SWL = (bf16_t*)(smem + 2048);
  const bf16_t* QF = (const bf16_t*)(p.ws + OFF_E); const bf16_t* KF = (const bf16_t*)(p.out + O_CS); const bf16_t* VF = (const bf16_t*)(p.ws + OFF_F);
  bf16_t* NUMI = (bf16_t*)(p.ws + OFF_SW);
  const float* GB = (const float*)(p.ws + OFF_GB); const float* GU = (const float*)(p.ws + OFF_GU); const float* GA = (const float*)(p.ws + OFF_GA);
  const float* CHS = (const float*)(p.ws + OFF_CHS);
  float* WINTER = (float*)(p.ws + OFF_WINTER); float* WUPD = (float*)(p.ws + OFF_WUPD); float* DENI = (float*)(p.ws + OFF_DENI); float* ENEGM = (float*)(p.ws + OFF_ENEGM);
  float* DECAY = (float*)(p.ws + OFF_DECAY);
  const int si = wid >> 1, ti = wid & 1;
  for (int u0 = blockIdx.x; u0 < 1152; u0 += gridDim.x) {
    const int uid = (u0 >= 512 && u0 < 1024) ? (u0 ^ 12) : u0;
    const bool samp = uid >= 1024;
    const int h = uid & 3;
    __syncthreads();
    if (!samp) {
      const int cg = uid >> 2, pb = cg >> 7, cseq = cg & 127, tb = cseq & (NSUB - 1), cg0 = cg - tb, row0 = cg * 64;
      if (wid == 0) {
        const float mprev = mscan_prefix(CHS, pb, h, cseq - tb, lane);
        float B[NSUB + 1]; B[0] = 0.f; float Apre = -INFINITY, Aall = -INFINITY;
#pragma unroll
        for (int i = 0; i < NSUB; ++i) {
          const float bl = CHS[((cg0 + i) * 4 + h) * 2], al = CHS[((cg0 + i) * 4 + h) * 2 + 1];
          if (i < tb) Apre = fmaxf(Apre, al - B[i]);
          Aall = fmaxf(Aall, al - B[i]);
          B[i + 1] = B[i] + bl;
        }
        float Btb = 0.f;
#pragma unroll
        for (int i = 0; i < NSUB; ++i) if (i == tb) Btb = B[i];
        const float Mlast = fmaxf(mprev, Aall);
        const size_t o = (size_t)(row0 + lane) * 4 + h;
        const float bt = GB[o] + Btb, ut = GU[o] - Btb, at = fmaxf(Apre, GA[o] - Btb);
        const float Mt = fmaxf(mprev, at);
        sM[lane] = Mt;
        WINTER[o] = __expf(mprev - Mt);
        ENEGM[o] = __expf(-(bt + Mt));
        WUPD[o] = __expf(ut - Mlast);
#pragma unroll
        for (int i = 0; i < NSUB; ++i) if (i <= tb) su[i * 64 + lane] = GU[(size_t)((cg0 + i) * 64 + lane) * 4 + h] - B[i];
        if (lane == 0) {
          if (tb == 0) DECAY[uid] = __expf(mprev - Mlast);
          if (cseq == 127) p.out[O_MP + pb * 4 + h] = B[NSUB] + Mlast;
        }
      }
      __syncthreads();
      float dpart = 0.f;
      const int t = 32 * ti + l31;
      const float Mt = sM[t];
      for (int jj = 0; jj <= tb; ++jj) {
        bf16_t* swb = SWL + (size_t)((jj * 2 + ti) * 4) * 512;
        if (jj < tb || si <= ti) {
          f32x16 acc;
#pragma unroll
          for (int i = 0; i < 16; ++i) acc[i] = 0.f;
          const bf16_t* ka = KF + ((size_t)((cg0 + jj) * 4 + h) * 2 + si) * 32 * 512 + lane * 8;
          const bf16_t* qb = QF + ((size_t)(cg * 4 + h) * 2 + ti) * 32 * 512 + lane * 8;
#pragma unroll 1
          for (int kb = 0; kb < 2; ++kb) {
            u32x4 fa[16], fb[16];
#pragma unroll
            for (int i = 0; i < 16; ++i) { fa[i] = *(const u32x4*)(ka + (kb * 16 + i) * 512); fb[i] = *(const u32x4*)(qb + (kb * 16 + i) * 512); }
            __builtin_amdgcn_sched_barrier(0);
#pragma unroll
            for (int i = 0; i < 16; ++i) acc = MFMA32(as_bf16x8(fa[i]), as_bf16x8(fb[i]), acc);
            __builtin_amdgcn_sched_barrier(0);
          }
#pragma unroll
          for (int g = 0; g < 4; ++g) {
            float w4[4];
#pragma unroll
            for (int x = 0; x < 4; ++x) {
              const int s = 32 * si + 8 * g + 4 * hh + x;
              const float v = (jj < tb || s <= t) ? acc[4 * g + x] * __expf(su[jj * 64 + s] - Mt) : 0.f;
              w4[x] = v; dpart += v;
            }
            u32x2 o; o.x = cvt_pk_bf16(w4[0], w4[1]); o.y = cvt_pk_bf16(w4[2], w4[3]);
            *(u32x2*)(swb + (2 * si + (g >> 1)) * 512 + (l31 + 32 * (g & 1)) * 8 + 4 * hh) = o;
          }
        } else {
          u32x2 z; z.x = 0u; z.y = 0u;
#pragma unroll
          for (int g = 0; g < 4; ++g) *(u32x2*)(swb + (2 * si + (g >> 1)) * 512 + (l31 + 32 * (g & 1)) * 8 + 4 * hh) = z;
        }
      }
      dpart += __shfl_xor(dpart, 32);
      if (hh == 0) sden[si * 64 + t] = dpart;
      __syncthreads();
      if (tid < 64) DENI[(size_t)(row0 + tid) * 4 + h] = sden[tid] + sden[64 + tid];
#pragma unroll 1
      for (int eti = 0; eti < 4; ++eti) {
        const int et = wid + 4 * eti;
        f32x16 a0, a1;
#pragma unroll
        for (int i = 0; i < 16; ++i) { a0[i] = 0.f; a1[i] = 0.f; }
        u32x4 vfr[NSUB][4];
#pragma unroll
        for (int jj = 0; jj < NSUB; ++jj) {
          if (jj <= tb) {
            const bf16_t* vf = VF + ((((size_t)((cg0 + jj) * 4 + h) * 16 + et) * 4) * 64 + lane) * 8;
#pragma unroll
            for (int ks = 0; ks < 4; ++ks) vfr[jj][ks] = *(const u32x4*)(vf + ks * 512);
          }
        }
        __builtin_amdgcn_sched_barrier(0);
#pragma unroll
        for (int jj = 0; jj < NSUB; ++jj) {
          if (jj <= tb) {
            const bf16_t* sw = SWL + (size_t)(jj * 8) * 512 + lane * 8;
#pragma unroll
            for (int ks = 0; ks < 4; ++ks) {
              const bf16x8 v = as_bf16x8(vfr[jj][ks]);
              a0 = MFMA32(v, *(const bf16x8*)(sw + ks * 512), a0);
              a1 = MFMA32(v, *(const bf16x8*)(sw + (4 + ks) * 512), a1);
            }
          }
        }
        bf16_t* dst0 = NUMI + numidx(row0 + l31, h, et * 32) + 4 * hh;
        bf16_t* dst1 = NUMI + numidx(row0 + 32 + l31, h, et * 32) + 4 * hh;
#pragma unroll
        for (int g = 0; g < 4; ++g) {
          u32x2 o0; o0.x = cvt_pk_bf16(a0[4 * g], a0[4 * g + 1]); o0.y = cvt_pk_bf16(a0[4 * g + 2], a0[4 * g + 3]);
          u32x2 o1; o1.x = cvt_pk_bf16(a1[4 * g], a1[4 * g + 1]); o1.y = cvt_pk_bf16(a1[4 * g + 2], a1[4 * g + 3]);
          *(u32x2*)(dst0 + 8 * g) = o0;
          *(u32x2*)(dst1 + 8 * g) = o1;
        }
      }
    } else {
      const int sb = (uid - 1024) >> 2, row0 = NP + sb * 16, cg = row0 >> 6, r0 = (sb & 3) * 16, mts = r0 >> 5, r0t = r0 & 31, ksq = sb & 3;
      if (wid == 0) {
        const float mprev = p.in[4][uid - 1024];
        const bool valid = lane < 16;
        const size_t o = (size_t)(row0 + (valid ? lane : 0)) * 4 + h;
        const float bt = GB[o], ut = GU[o], at = GA[o];
        const float Mt = fmaxf(mprev, at);
        const float alast = __shfl(at, 15), blast = __shfl(bt, 15);
        const float Mlast = fmaxf(mprev, alast);
        sM[lane] = Mt; su[lane] = ut;
        if (valid) { WINTER[o] = __expf(mprev - Mt); ENEGM[o] = __expf(-(bt + Mt)); WUPD[o] = __expf(ut - Mlast); }
        if (lane == 0) { DECAY[uid] = __expf(mprev - Mlast); p.out[O_MS + (uid - 1024)] = blast + Mlast; }
      }
      __syncthreads();
      if (wid == 0) {
        f32x16 acc;
#pragma unroll
        for (int i = 0; i < 16; ++i) acc[i] = 0.f;
        const bf16_t* ka = KF + ((size_t)(cg * 4 + h) * 2 + mts) * 32 * 512 + lane * 8;
        const bf16_t* qb = QF + ((size_t)(cg * 4 + h) * 2 + mts) * 32 * 512 + lane * 8;
#pragma unroll 1
        for (int kb = 0; kb < 2; ++kb) {
          u32x4 fa[16], fb[16];
#pragma unroll
          for (int i = 0; i < 16; ++i) { fa[i] = *(const u32x4*)(ka + (kb * 16 + i) * 512); fb[i] = *(const u32x4*)(qb + (kb * 16 + i) * 512); }
          __builtin_amdgcn_sched_barrier(0);
#pragma unroll
          for (int i = 0; i < 16; ++i) acc = MFMA32(as_bf16x8(fa[i]), as_bf16x8(fb[i]), acc);
          __builtin_amdgcn_sched_barrier(0);
        }
        const int tl = l31 - r0t;
        const bool tv = tl >= 0 && tl < 16;
        const float Mt = sM[tv ? tl : 0];
        float dpart = 0.f;
#pragma unroll
        for (int g = 0; g < 4; ++g) {
          float w4[4];
#pragma unroll
          for (int x = 0; x < 4; ++x) {
            const int s = 8 * g + 4 * hh + x, sl = s - r0t;
            const bool ok = tv && sl >= 0 && s <= l31;
            const float v = ok ? acc[4 * g + x] * __expf(su[ok ? sl : 0] - Mt) : 0.f;
            w4[x] = v; dpart += v;
          }
          u32x2 o; o.x = cvt_pk_bf16(w4[0], w4[1]); o.y = cvt_pk_bf16(w4[2], w4[3]);
          *(u32x2*)(SWL + (g >> 1) * 512 + (l31 + 32 * (g & 1)) * 8 + 4 * hh) = o;
        }
        dpart += __shfl_xor(dpart, 32);
        if (hh == 0 && tv) DENI[(size_t)(row0 + tl) * 4 + h] = dpart;
      }
      __syncthreads();
      {
        const int tl = l31 - r0t;
        const bool tv = tl >= 0 && tl < 16;
        const bf16x8 swf = *(const bf16x8*)(SWL + (r0t >> 4) * 512 + lane * 8);
#pragma unroll 1
        for (int eti = 0; eti < 4; ++eti) {
          const int et = wid + 4 * eti;
          f32x16 a0;
#pragma unroll
          for (int i = 0; i < 16; ++i) a0[i] = 0.f;
          const bf16x8 v = as_bf16x8(*(const u32x4*)(VF + ((((size_t)(cg * 4 + h) * 16 + et) * 4 + ksq) * 64 + lane) * 8));
          a0 = MFMA32(v, swf, a0);
          if (tv) {
            bf16_t* dst = NUMI + numidx(row0 + tl, h, et * 32) + 4 * hh;
#pragma unroll
            for (int g = 0; g < 4; ++g) { u32x2 o0; o0.x = cvt_pk_bf16(a0[4 * g], a0[4 * g + 1]); o0.y = cvt_pk_bf16(a0[4 * g + 2], a0[4 * g + 3]); *(u32x2*)(dst + 8 * g) = o0; }
          }
        }
      }
    }
  }
}

DEV bf16x8 pack_acc(const f32x16& x, int s) {
  u32x4 pk;
  if (s == 0) { pk.x = cvt_pk_bf16(x[0], x[1]); pk.y = cvt_pk_bf16(x[2], x[3]); pk.z = cvt_pk_bf16(x[4], x[5]); pk.w = cvt_pk_bf16(x[6], x[7]); }
  else { pk.x = cvt_pk_bf16(x[8], x[9]); pk.y = cvt_pk_bf16(x[10], x[11]); pk.z = cvt_pk_bf16(x[12], x[13]); pk.w = cvt_pk_bf16(x[14], x[15]); }
  return as_bf16x8(pk);
}
DEV bf16x8 scale_frag(u32x4 raw, const float* w) {
  const f32x4 w0 = *(const f32x4*)(w), w1 = *(const f32x4*)(w + 4);
  u32x4 pk;
  pk.x = cvt_pk_bf16(bf_lo(raw.x) * w0.x, bf_hi(raw.x) * w0.y); pk.y = cvt_pk_bf16(bf_lo(raw.y) * w0.z, bf_hi(raw.y) * w0.w);
  pk.z = cvt_pk_bf16(bf_lo(raw.z) * w1.x, bf_hi(raw.z) * w1.y); pk.w = cvt_pk_bf16(bf_lo(raw.w) * w1.z, bf_hi(raw.w) * w1.w);
  return as_bf16x8(pk);
}

DEV void store_ctile(float* base, const f32x16 (&C)[4]) {
  float* cptr = base;
#pragma unroll
  for (int dt = 0; dt < 4; ++dt)
#pragma unroll
    for (int q = 0; q < 4; ++q) {
      cptr[0] = C[dt][4 * q]; cptr[512] = C[dt][4 * q + 1]; cptr[1024] = C[dt][4 * q + 2]; cptr[1536] = C[dt][4 * q + 3];
      cptr += 8 * 512; asm volatile("" : "+v"(cptr));
    }
}
DEV void load_ctile(const float* base, f32x16 (&C)[4]) {
  const float* cptr = base;
#pragma unroll
  for (int dt = 0; dt < 4; ++dt)
#pragma unroll
    for (int q = 0; q < 4; ++q) {
      C[dt][4 * q] = cptr[0]; C[dt][4 * q + 1] = cptr[512]; C[dt][4 * q + 2] = cptr[1024]; C[dt][4 * q + 3] = cptr[1536];
      cptr += 8 * 512; asm volatile("" : "+v"(cptr));
    }
}

constexpr unsigned BF_ONES = 0x3F803F80u;

DEV void lds_barrier() { asm volatile("s_waitcnt lgkmcnt(0)\n\ts_barrier" ::: "memory"); }

DEV void scan_prompt(const Params& p, char* smem, int pb, int h, int sl, unsigned* prog) {
  int tid_ = threadIdx.x; asm volatile("" : "+v"(tid_));
  const int tid = tid_, lane = tid & 63, wid = tid >> 6, l31 = lane & 31, hh = lane >> 5;
  float* red = (float*)smem;
  float* swi = red + 2 * 4 * 64 * 32;
  float* swu = swi + 256;
  const bf16_t* QF = (const bf16_t*)(p.ws + OFF_E); const bf16_t* VF = (const bf16_t*)(p.ws + OFF_F); const bf16_t* KTF = (const bf16_t*)(p.out + O_Y);
  bf16_t* NUM = (bf16_t*)(p.ws + OFF_B);
  const float* WINTER = (const float*)(p.ws + OFF_WINTER); const float* WUPD = (const float*)(p.ws + OFF_WUPD); const float* DECAY = (const float*)(p.ws + OFF_DECAY);
  const float* DENI = (const float*)(p.ws + OFF_DENI); const float* ENEGM = (const float*)(p.ws + OFF_ENEGM); float* DINV = (float*)(p.ws + OFF_DINV);
  const bool ns = sl == 16;
  const int slv = ns ? 0 : sl;
  f32x16 C[4];
#pragma unroll
  for (int dt = 0; dt < 4; ++dt)
#pragma unroll
    for (int i = 0; i < 16; ++i) C[dt][i] = 0.f;
  const int e0 = slv * 32;
  const u32x4 ones = {BF_ONES, BF_ONES, BF_ONES, BF_ONES};
  constexpr int RQ = 8;
  const int rt = tid >> 2, re8 = (tid & 3) * 8;
  float nwi, nwu, ndecay;
  { const size_t o = (size_t)(pb * 8192 + tid) * 4 + h; nwi = WINTER[o]; nwu = WUPD[o]; ndecay = DECAY[(pb * 128) * 4 + h]; }
  for (int sc = 0; sc < 128 / NSUB; ++sc) {
    const int cg0 = pb * 128 + sc * NSUB, rows = cg0 * 64;
    if (sl == 0 && tid == 0) __hip_atomic_store(prog + pb * 4 + h, (unsigned)sc, __ATOMIC_RELAXED, __HIP_MEMORY_SCOPE_AGENT);
    const bf16_t* qbase = QF + ((size_t)(cg0 * 4 + h) * 64 + 8 * wid) * 512 + lane * 8;
    u32x4 qf[RQ];
#pragma unroll
    for (int q = 0; q < RQ; ++q) qf[q] = *(const u32x4*)(qbase + (size_t)(q >> 4) * (4 * 64 * 512) + (size_t)(((q >> 3) & 1) * 32 + (q & 7)) * 512);
    lds_barrier();
    swi[tid] = nwi; swu[tid] = nwu;
    const float decay = ndecay;
    if (sc + 1 < 128 / NSUB) {
      const size_t o = (size_t)(rows + NSUB * 64 + tid) * 4 + h;
      nwi = WINTER[o]; nwu = WUPD[o]; ndecay = DECAY[(cg0 + NSUB) * 4 + h];
    }
    lds_barrier();
#pragma unroll
    for (int it = 0; it < 2 * NSUB; ++it) {
      const int j = it >> 1, mt = it & 1;
      const int cgj = cg0 + j;
      bf16_t* nump = NUM + numidx(cgj * 64 + rt, h, e0 + re8);
      f32x16 ai;
#pragma unroll
      for (int i = 0; i < 16; ++i) ai[i] = 0.f;
#pragma unroll
      for (int kk = 0; kk < 8; ++kk) {
        const int q = it * 8 + kk;
        ai = MFMA32(as_bf16x8(qf[q % RQ]), pack_acc(C[kk >> 1], kk & 1), ai);
        if (q + RQ < 16 * NSUB) {
          const int qn = q + RQ;
          qf[q % RQ] = *(const u32x4*)(qbase + (size_t)(qn >> 4) * (4 * 64 * 512) + (size_t)(((qn >> 3) & 1) * 32 + (qn & 7)) * 512);
        }
      }
      float* rb = red + (j & 1) * (4 * 64 * 32);
      {
        float* rbt = rb + (wid * 64 + 4 * hh) * 32 + l31;
        const float* swij = swi + j * 64 + 4 * hh + 32 * mt;
        f32x4 w4[4];
#pragma unroll
        for (int q = 0; q < 4; ++q) w4[q] = *(const f32x4*)(swij + 8 * q);
#pragma unroll
        for (int i = 0; i < 16; ++i) {
          const int t0 = 32 * mt + (i & 3) + 8 * (i >> 2);
          rbt[t0 * 32] = w4[i >> 2][i & 3] * ai[i];
        }
      }
      if (mt == 1) {
        lds_barrier();
        f32x4 s0 = *(const f32x4*)(rb + rt * 32 + re8), s1 = *(const f32x4*)(rb + rt * 32 + re8 + 4);
#pragma unroll
        for (int w = 1; w < 4; ++w) { s0 += *(const f32x4*)(rb + (w * 64 + rt) * 32 + re8); s1 += *(const f32x4*)(rb + (w * 64 + rt) * 32 + re8 + 4); }
        if (!ns) {
          u32x4 o;
          o.x = cvt_pk_bf16(s0.x, s0.y); o.y = cvt_pk_bf16(s0.z, s0.w); o.z = cvt_pk_bf16(s1.x, s1.y); o.w = cvt_pk_bf16(s1.z, s1.w);
          *(u32x4*)nump = o;
        } else if (re8 == 0) {
          const size_t o = (size_t)(cgj * 64 + rt) * 4 + h;
          DINV[o] = s0.x;
        }
      }
    }
#pragma unroll
    for (int dt = 0; dt < 4; ++dt)
#pragma unroll
      for (int i = 0; i < 16; ++i) C[dt][i] *= decay;
    constexpr int PF = 4;
    u32x4 vb[PF], kb[PF][4];
    const bf16_t* vbase = VF + ((((size_t)(cg0 * 4 + h) * 16 + slv) * 4) * 64 + lane) * 8;
    const bf16_t* kbase = KTF + ((((size_t)(cg0 * 4 + h) * 16 + 4 * wid) * 4) * 64 + lane) * 8;
#pragma unroll
    for (int k16 = 0; k16 < PF; ++k16) {
      const size_t off = (size_t)(k16 >> 2) * (4 * 16 * 4 * 512) + (size_t)(k16 & 3) * 512;
      vb[k16] = ns ? ones : *(const u32x4*)(vbase + off);
#pragma unroll
      for (int dt = 0; dt < 4; ++dt) kb[k16][dt] = *(const u32x4*)(kbase + off + (size_t)dt * 4 * 512);
    }
#pragma unroll
    for (int k16 = 0; k16 < NSUB * 4; ++k16) {
      const bf16x8 b = scale_frag(vb[k16 % PF], swu + k16 * 16 + 8 * hh);
#pragma unroll
      for (int dt = 0; dt < 4; ++dt) C[dt] = MFMA32(as_bf16x8(kb[k16 % PF][dt]), b, C[dt]);
      if (k16 + PF < NSUB * 4) {
        const int kn = k16 + PF;
        const size_t off = (size_t)(kn >> 2) * (4 * 16 * 4 * 512) + (size_t)(kn & 3) * 512;
        vb[k16 % PF] = ns ? ones : *(const u32x4*)(vbase + off);
#pragma unroll
        for (int dt = 0; dt < 4; ++dt) kb[k16 % PF][dt] = *(const u32x4*)(kbase + off + (size_t)dt * 4 * 512);
      }
    }
  }
  if (!ns) store_ctile(p.out + O_CP + (size_t)(pb * 4 + h) * 262144 + (size_t)(128 * wid + 4 * hh) * 512 + e0 + l31, C);
  else if (l31 == 0) {
    float* nout = p.out + O_NP + (size_t)(pb * 4 + h) * 512 + 128 * wid + 4 * hh;
#pragma unroll
    for (int dt = 0; dt < 4; ++dt)
#pragma unroll
      for (int i = 0; i < 16; ++i) nout[32 * dt + (i & 3) + 8 * (i >> 2)] = C[dt][i];
  }
}

DEV void scan_sample(const Params& p_, char* smem, int sbh, int sl) {
  Params p = p_;
  asm volatile("" : "+s"(p.ws), "+s"(p.out), "+s"(p.in[2]), "+s"(p.in[3]));
  const int tid = threadIdx.x, lane = tid & 63, wid = tid >> 6, l31 = lane & 31, hh = lane >> 5;
  float* red = (float*)smem;
  float* swi = red + 2 * 4 * 64 * 32;
  float* swu = swi + 256;
  const bf16_t* QF = (const bf16_t*)(p.ws + OFF_E); const bf16_t* VF = (const bf16_t*)(p.ws + OFF_F); const bf16_t* KTF = (const bf16_t*)(p.out + O_Y);
  const bf16_t* SWF = (const bf16_t*)(p.ws + OFF_SW);
  bf16_t* NUM = (bf16_t*)(p.ws + OFF_B);
  const float* WINTER = (const float*)(p.ws + OFF_WINTER); const float* WUPD = (const float*)(p.ws + OFF_WUPD); const float* DECAY = (const float*)(p.ws + OFF_DECAY);
  const float* DENI = (const float*)(p.ws + OFF_DENI); const float* ENEGM = (const float*)(p.ws + OFF_ENEGM); float* DINV = (float*)(p.ws + OFF_DINV);
  const int sb = sbh >> 2, h = sbh & 3, row0 = NP + sb * 16, cg = row0 >> 6, r0 = (sb & 3) * 16, mts = r0 >> 5, r0t = r0 & 31, ksq = sb & 3;
  const bool ns = sl == 16;
  const int slv = ns ? 0 : sl;
  const int uid = 1024 + sbh, e0 = slv * 32;
  f32x16 C[4];
  if (!ns) load_ctile(p.in[2] + (size_t)sbh * 262144 + (size_t)(128 * wid + 4 * hh) * 512 + e0 + l31, C);
  else {
    const float* n0 = p.in[3] + (size_t)sbh * 512 + 128 * wid + 4 * hh;
#pragma unroll
    for (int dt = 0; dt < 4; ++dt)
#pragma unroll
      for (int i = 0; i < 16; ++i) C[dt][i] = n0[32 * dt + (i & 3) + 8 * (i >> 2)];
  }
  __syncthreads();
  if (tid < 32) { const int tl = tid - r0t; swi[tid] = (tl >= 0 && tl < 16) ? WINTER[(size_t)(row0 + tl) * 4 + h] : 0.f; }
  if (tid >= 64 && tid < 80) swu[tid - 64] = WUPD[(size_t)(row0 + tid - 64) * 4 + h];
  const float decay = DECAY[uid];
  f32x16 ai, aa;
#pragma unroll
  for (int i = 0; i < 16; ++i) { ai[i] = 0.f; aa[i] = 0.f; }
  const bf16_t* qa = QF + ((size_t)((cg * 4 + h) * 2 + mts) * 32 + 8 * wid) * 512 + lane * 8;
#pragma unroll
  for (int kk = 0; kk < 8; ++kk) {
    const bf16x8 a = as_bf16x8(*(const u32x4*)(qa + (size_t)kk * 512));
    ai = MFMA32(a, pack_acc(C[kk >> 1], kk & 1), ai);
  }
  u32x4 vraw = {BF_ONES, BF_ONES, BF_ONES, BF_ONES};
  if (!ns) vraw = *(const u32x4*)(VF + ((((size_t)(cg * 4 + h) * 16 + slv) * 4 + ksq) * 64 + lane) * 8);
  __syncthreads();
  {
    float* rbt = red + (wid * 32 + 4 * hh) * 32 + l31;
    const float* swij = swi + 4 * hh;
    f32x4 w4[4];
#pragma unroll
    for (int q = 0; q < 4; ++q) w4[q] = *(const f32x4*)(swij + 8 * q);
#pragma unroll
    for (int i = 0; i < 16; ++i) {
      const int t0 = (i & 3) + 8 * (i >> 2);
      rbt[t0 * 32] = aa[i] + w4[i >> 2][i & 3] * ai[i];
    }
  }
#pragma unroll
  for (int dt = 0; dt < 4; ++dt)
#pragma unroll
    for (int i = 0; i < 16; ++i) C[dt][i] *= decay;
  {
    const bf16x8 b = scale_frag(vraw, swu + 8 * hh);
    const bf16_t* ka = KTF + ((((size_t)(cg * 4 + h) * 16 + 4 * wid) * 4 + ksq) * 64 + lane) * 8;
#pragma unroll
    for (int dt = 0; dt < 4; ++dt) C[dt] = MFMA32(as_bf16x8(*(const u32x4*)(ka + (size_t)dt * 4 * 512)), b, C[dt]);
  }
  __syncthreads();
  if (tid < 64) {
    const int t = tid >> 2, e8 = (tid & 3) * 8, tr = r0t + t;
    f32x4 s0 = *(const f32x4*)(red + tr * 32 + e8), s1 = *(const f32x4*)(red + tr * 32 + e8 + 4);
#pragma unroll
    for (int w = 1; w < 4; ++w) { s0 += *(const f32x4*)(red + (w * 32 + tr) * 32 + e8); s1 += *(const f32x4*)(red + (w * 32 + tr) * 32 + e8 + 4); }
    if (!ns) {
      bf16_t* nump = NUM + numidx(row0 + t, h, e0 + e8);
      u32x4 o;
      o.x = cvt_pk_bf16(s0.x, s0.y); o.y = cvt_pk_bf16(s0.z, s0.w); o.z = cvt_pk_bf16(s1.x, s1.y); o.w = cvt_pk_bf16(s1.z, s1.w);
      *(u32x4*)nump = o;
    } else if (e8 == 0) {
      const size_t o = (size_t)(row0 + t) * 4 + h;
      DINV[o] = s0.x;
    }
  }
  if (!ns) store_ctile(p.out + O_CS + (size_t)sbh * 262144 + (size_t)(128 * wid + 4 * hh) * 512 + e0 + l31, C);
  else if (l31 == 0) {
    float* nout = p.out + O_NS + (size_t)sbh * 512 + 128 * wid + 4 * hh;
#pragma unroll
    for (int dt = 0; dt < 4; ++dt)
#pragma unroll
      for (int i = 0; i < 16; ++i) nout[32 * dt + (i & 3) + 8 * (i >> 2)] = C[dt][i];
  }
}

DEV unsigned hw_xcc_id() { return (unsigned)__builtin_amdgcn_s_getreg((3 << 11) | 20) & 0xFu; }

constexpr int NPF = 6;
constexpr int PF_AHEAD = 2;
DEV void scan_prefetch(const Params& p, int bh, int part, unsigned* prog, volatile int* flag) {
  const int tid = threadIdx.x, pb = bh >> 2, h = bh & 3;
  const bf16_t* QF = (const bf16_t*)(p.ws + OFF_E); const bf16_t* VF = (const bf16_t*)(p.ws + OFF_F); const bf16_t* KTF = (const bf16_t*)(p.out + O_Y);
  unsigned sink = 0u;
  for (int sc = 0; sc < 128 / NSUB; ++sc) {
    if (tid == 0) {
      unsigned spins = 0; int dead = 0;
      while ((int)__hip_atomic_load(prog + bh, __ATOMIC_RELAXED, __HIP_MEMORY_SCOPE_AGENT) + PF_AHEAD < sc) { __builtin_amdgcn_s_sleep(8); if (++spins > (1u << 15)) { dead = 1; break; } }
      flag[0] = dead;
    }
    __syncthreads();
    if (flag[0]) break;
    __syncthreads();
    const int cg0 = pb * 128 + sc * NSUB;
    for (int r = part; r < 3 * NSUB; r += NPF) {
      const int which = r / NSUB, j = r % NSUB;
      const bf16_t* base = (which == 0 ? QF : (which == 1 ? KTF : VF)) + (size_t)((cg0 + j) * 4 + h) * 32768;
      u32x4 v[16];
#pragma unroll
      for (int i = 0; i < 16; ++i) v[i] = *(const u32x4*)(base + (size_t)(i * 256 + tid) * 8);
#pragma unroll
      for (int i = 0; i < 16; ++i) sink ^= v[i].x ^ v[i].w;
    }
  }
  asm volatile("" :: "v"(sink));
}


DEV void scan_phase(const Params& p, char* smem) {
  const int tid = threadIdx.x, bid = blockIdx.x;
  unsigned* cnt = (unsigned*)(p.ws + OFF_BAR + 14336);
  volatile int* sunit = (volatile int*)(smem + 73728 - 16);
  constexpr int NSS = 128 * 17;
  int stage = 0, bh_try = 0;
  for (;;) {
    __syncthreads();
    if (tid == 0) {
      int kind = -1, a = 0, b = 0;
      for (;;) {
        if (stage == 0) {
          stage = 1;
          const unsigned x = hw_xcc_id() & 7u;
          if (bid < 256) { const unsigned t = atomicAdd(&cnt[x], 1u); if (t < 17u) { kind = 0; a = (int)x; b = (int)t; break; } }
          else { const unsigned t = atomicAdd(&cnt[8 + x], 1u); if (t < (unsigned)NPF) { kind = 2; a = (int)x; b = (int)t; break; } }
        } else if (stage == 1) {
          const unsigned u = atomicAdd(&cnt[16], 1u);
          if (u < (unsigned)NSS) { kind = 1; a = (int)u; break; }
          stage = 2;
        } else {
          if (bh_try >= 8) break;
          const unsigned t = atomicAdd(&cnt[bh_try], 1u);
          if (t < 17u) { kind = 0; a = bh_try; b = (int)t; break; }
          ++bh_try;
        }
      }
      sunit[0] = kind; sunit[1] = a; sunit[2] = b;
    }
    __syncthreads();
    const int kind = sunit[0], a = sunit[1], b = sunit[2];
    if (kind < 0) break;
    if (kind == 0) scan_prompt(p, smem, a >> 2, a & 3, b, cnt + 32);
    else if (kind == 1) scan_sample(p, smem, a / 17, a % 17);
    else scan_prefetch(p, a, b, cnt + 32, sunit + 3);
  }
}

DEV void hnorm_phase(const Params& p) {
  const int tid = threadIdx.x, lane = tid & 63, h = tid >> 6;
  const bf16_t* NUM = (const bf16_t*)(p.ws + OFF_B); const bf16_t* XC = (const bf16_t*)(p.ws + OFF_D); const bf16_t* Z2 = (const bf16_t*)(p.ws + OFF_C);
  const float* DINV = (const float*)(p.ws + OFF_DINV); const float* DENI = (const float*)(p.ws + OFF_DENI); const float* ENEGM = (const float*)(p.ws + OFF_ENEGM);
  bf16_t* A4 = (bf16_t*)(p.ws + OFF_F);
  const int ch = h * 512 + lane * 8;
  float hg[8], sk[8];
  { const f32x4 a = *(const f32x4*)(p.in[22] + ch), b = *(const f32x4*)(p.in[22] + ch + 4); hg[0] = a.x; hg[1] = a.y; hg[2] = a.z; hg[3] = a.w; hg[4] = b.x; hg[5] = b.y; hg[6] = b.z; hg[7] = b.w; }
  { const f32x4 a = *(const f32x4*)(p.in[23] + ch), b = *(const f32x4*)(p.in[23] + ch + 4); sk[0] = a.x; sk[1] = a.y; sk[2] = a.z; sk[3] = a.w; sk[4] = b.x; sk[5] = b.y; sk[6] = b.z; sk[7] = b.w; }
  const bf16_t* NUMI = (const bf16_t*)(p.ws + OFF_SW);
  int tok = blockIdx.x;
  float dinv_n = 0.f; u32x4 nr_n = {0u, 0u, 0u, 0u}, ni_n = nr_n, xr_n = nr_n, zr_n = nr_n;
  if (tok < T) {
    dinv_n = 1.f / fmaxf(fabsf(DENI[(size_t)tok * 4 + h] + DINV[(size_t)tok * 4 + h]), ENEGM[(size_t)tok * 4 + h]);
    nr_n = *(const u32x4*)(NUM + numidx(tok, h, lane * 8)); ni_n = *(const u32x4*)(NUMI + numidx(tok, h, lane * 8));
    xr_n = *(const u32x4*)(XC + (size_t)tok * E + ch); zr_n = *(const u32x4*)(Z2 + (size_t)tok * E + ch);
  }
  for (; tok < T; tok += gridDim.x) {
    const float dinv = dinv_n; const u32x4 nr = nr_n, ni = ni_n, xr = xr_n, zr = zr_n;
    const int tn = tok + gridDim.x;
    if (tn < T) {
      dinv_n = 1.f / fmaxf(fabsf(DENI[(size_t)tn * 4 + h] + DINV[(size_t)tn * 4 + h]), ENEGM[(size_t)tn * 4 + h]);
      nr_n = *(const u32x4*)(NUM + numidx(tn, h, lane * 8)); ni_n = *(const u32x4*)(NUMI + numidx(tn, h, lane * 8));
      xr_n = *(const u32x4*)(XC + (size_t)tn * E + ch); zr_n = *(const u32x4*)(Z2 + (size_t)tn * E + ch);
    }
    float v[8] = {(bf_lo(nr.x) + bf_lo(ni.x)) * dinv, (bf_hi(nr.x) + bf_hi(ni.x)) * dinv, (bf_lo(nr.y) + bf_lo(ni.y)) * dinv, (bf_hi(nr.y) + bf_hi(ni.y)) * dinv, (bf_lo(nr.z) + bf_lo(ni.z)) * dinv, (bf_hi(nr.z) + bf_hi(ni.z)) * dinv, (bf_lo(nr.w) + bf_lo(ni.w)) * dinv, (bf_hi(nr.w) + bf_hi(ni.w)) * dinv};
    const float xc[8] = {bf_lo(xr.x), bf_hi(xr.x), bf_lo(xr.y), bf_hi(xr.y), bf_lo(xr.z), bf_hi(xr.z), bf_lo(xr.w), bf_hi(xr.w)};
    const float z[8] = {bf_lo(zr.x), bf_hi(zr.x), bf_lo(zr.y), bf_hi(zr.y), bf_lo(zr.z), bf_hi(zr.z), bf_lo(zr.w), bf_hi(zr.w)};
    float s = 0.f;
#pragma unroll
    for (int j = 0; j < 8; ++j) s += v[j];
    const float mean = wave_sum(s) * (1.f / 512.f);
    float s2 = 0.f;
#pragma unroll
    for (int j = 0; j < 8; ++j) { v[j] -= mean; s2 += v[j] * v[j]; }
    const float rstd = rsqrtf(wave_sum(s2) * (1.f / 512.f) + 1e-5f);
    float o[8];
#pragma unroll
    for (int j = 0; j < 8; ++j) o[j] = (v[j] * rstd * hg[j] + sk[j] * xc[j]) * siluf_(z[j]);
    u32x4 ov; ov.x = cvt_pk_bf16(o[0], o[1]); ov.y = cvt_pk_bf16(o[2], o[3]); ov.z = cvt_pk_bf16(o[4], o[5]); ov.w = cvt_pk_bf16(o[6], o[7]);
    *(u32x4*)(A4 + (size_t)tok * E + ch) = ov;
  }
}

DEV void final_phase(const Params& p) {
  const int tid = threadIdx.x, lane = tid & 63, wid = tid >> 6;
  const float* SS2 = (const float*)(p.ws + OFF_SS2);
  const float* g = p.in[7];
  f32x4 gv[4];
#pragma unroll
  for (int j = 0; j < 4; ++j) gv[j] = *(const f32x4*)(g + j * 256 + lane * 4);
  for (int row = blockIdx.x * 4 + wid; row < T; row += gridDim.x * 4) {
    float s = 0.f;
#pragma unroll
    for (int j = 0; j < 4; ++j) { const f32x4 v = *(const f32x4*)(SS2 + (size_t)row * 16 + 4 * j); s += v.x + v.y + v.z + v.w; }
    const float r = rsqrtf(s * (1.f / DM) + 1e-6f);
    float* y = p.out + O_Y + (size_t)row * DM;
#pragma unroll
    for (int j = 0; j < 4; ++j) { f32x4 v = *(const f32x4*)(y + j * 256 + lane * 4); v.x *= r * gv[j].x; v.y *= r * gv[j].y; v.z *= r * gv[j].z; v.w *= r * gv[j].w; *(f32x4*)(y + j * 256 + lane * 4) = v; }
  }
}

#define XB_TMO      128
#define XB_XCNT(j)  (256  + 64 * (j))
#define XB_XSUB(j)  (1280 + 64 * (j))
#define XB_XGEN(j)  (2304 + 64 * (j))
#define XB_TOP      3328
#define XB_TOPGEN   3392
#define XCD_BAR_WORDS 3456
#define XB_SPIN_CAP (1u << 18)
#define LAS __attribute__((address_space(3)))
DEV unsigned xb_ld(unsigned* p)              { return __hip_atomic_load(p, __ATOMIC_RELAXED, __HIP_MEMORY_SCOPE_AGENT); }
DEV unsigned xb_add(unsigned* p, unsigned v) { return __hip_atomic_fetch_add(p, v, __ATOMIC_RELAXED, __HIP_MEMORY_SCOPE_AGENT); }
DEV unsigned xb_xcc_id() { return (unsigned)__builtin_amdgcn_s_getreg((3 << 11) | 20) & 0xFu; }
#define XB_SPIN(cond, bar) do { unsigned _sp = 0; while (cond) { __builtin_amdgcn_s_sleep(1); \
    if ((++_sp & 255u) == 0u) { if (xb_ld(&(bar)[XB_TMO])) break; if (_sp > XB_SPIN_CAP) { atomicAdd(&(bar)[XB_TMO], 1u); break; } } } } while (0)
struct XcdBarrier { unsigned* bar; unsigned x; volatile LAS unsigned* st; };
DEV XcdBarrier xcd_barrier_post(unsigned* bar, volatile LAS unsigned* st) {
  XcdBarrier b; b.bar = bar; b.x = xb_xcc_id(); b.st = st;
  if (threadIdx.x == 0) (void)xb_add(&bar[XB_XCNT(b.x)], 1u);
  return b;
}
DEV void xcd_barrier_complete(unsigned* bar, unsigned x, unsigned& nloc, unsigned& nx) {
  const unsigned G = gridDim.x * gridDim.y * gridDim.z;
  unsigned sum, cnt, mine, sp = 0u;
  for (;;) {
    sum = 0u; cnt = 0u; mine = 0u;
#pragma unroll
    for (unsigned j = 0; j < 16; ++j) { const unsigned c = xb_ld(&bar[XB_XCNT(j)]); sum += c; cnt += (c > 0u) ? 1u : 0u; mine = (j == x) ? c : mine; }
    if (sum == G) break;
    __builtin_amdgcn_s_sleep(1);
    if ((++sp & 255u) == 0u) { if (xb_ld(&bar[XB_TMO])) break; if (sp > XB_SPIN_CAP) { atomicAdd(&bar[XB_TMO], 1u); break; } }
  }
  nloc = mine > 0u ? mine : 1u; nx = cnt > 0u ? cnt : 1u;
}
DEV void xcd_barrier(const XcdBarrier& b) {
  asm volatile("s_waitcnt vmcnt(0)" ::: "memory");
  __syncthreads();
  if (threadIdx.x == 0) {
    unsigned* bar = b.bar;
    __builtin_amdgcn_s_waitcnt(0);
    unsigned nloc = b.st[0], nx = b.st[1];
    if (nloc == 0u) { xcd_barrier_complete(bar, b.x, nloc, nx); b.st[0] = nloc; b.st[1] = nx; }
    const unsigned old = xb_add(&bar[XB_XSUB(b.x)], 1u);
    const unsigned gen = old / nloc;
    if (old + 1u == (gen + 1u) * nloc) {
      __builtin_amdgcn_fence(__ATOMIC_RELEASE, "agent");
      asm volatile("s_waitcnt vmcnt(0)" ::: "memory");
      const unsigned og = xb_add(&bar[XB_TOP], 1u);
      const unsigned tg = og / nx;
      if (og + 1u == (tg + 1u) * nx) xb_add(&bar[XB_TOPGEN], 1u);
      else XB_SPIN(xb_ld(&bar[XB_TOPGEN]) == tg, bar);
      __builtin_amdgcn_fence(__ATOMIC_ACQUIRE, "agent");
      xb_add(&bar[XB_XGEN(b.x)], 1u);
      asm volatile("s_waitcnt vmcnt(0)" ::: "memory");
    } else {
      XB_SPIN(xb_ld(&bar[XB_XGEN(b.x)]) == gen, bar);
      __builtin_amdgcn_fence(__ATOMIC_ACQUIRE, "agent");
      asm volatile("s_waitcnt vmcnt(0)" ::: "memory");
    }
  }
  __syncthreads();
}

template <bool COOP>
__global__ void __launch_bounds__(NBLK, 2) fwd_kernel(Params p) {
  __shared__ __attribute__((aligned(16))) char smem[73728 + 16];
  XcdBarrier xb;
  if (COOP) {
    if (threadIdx.x == 0) *(uint4*)(smem + 73728) = make_uint4(0u, 0u, 0u, 0u);
    __syncthreads();
    xb = xcd_barrier_post((unsigned*)(p.ws + OFF_BAR), (volatile LAS unsigned*)(smem + 73728));
    if (p.ph_hi > 1000) cg::this_grid().sync();
  }
#ifndef REPMASK
#define REPMASK 0
#endif
#define PH_BEGIN(k) if (p.ph_lo <= (k) && (k) < p.ph_hi) for (int rep_ = 0; rep_ < (((REPMASK >> (k)) & 1) ? 2 : 1); ++rep_) { if (rep_) __syncthreads();
#define PH_END(k) } if (COOP) { if (p.ph_lo <= (k) && (k) + 1 < p.ph_hi) xcd_barrier(xb); }
  PH_BEGIN(0) phase0(p, smem); PH_END(0)
  PH_BEGIN(1) { Epi1 e{(const float*)(p.ws + OFF_RS0), (bf16_t*)(p.ws + OFF_A), (bf16_t*)(p.ws + OFF_B), (bf16_t*)(p.ws + OFF_C), (float*)(p.ws + OFF_VST)};
                gemm_phase((const bf16_t*)(p.ws + OFF_E), (const bf16_t*)(p.ws + OFF_W1), 6144, 1024, e, (bf16_t*)smem); } PH_END(1)
  PH_BEGIN(2) sgu_phase(p, smem); PH_END(2)
  PH_BEGIN(3) { EpiRes e{p.in[0], p.in[1], (float*)(p.ws + OFF_A), (bf16_t*)(p.ws + OFF_E + 34603008), (float*)(p.ws + OFF_SS1)};
                gemm_phase((const bf16_t*)(p.ws + OFF_D), (const bf16_t*)(p.ws + OFF_W2), 1024, 2048, e, (bf16_t*)smem, true); } PH_END(3)
  PH_BEGIN(4) { Epi3 e{(const float*)(p.ws + OFF_SS1), (bf16_t*)(p.ws + OFF_B), (bf16_t*)(p.ws + OFF_C)};
                gemm_phase((const bf16_t*)(p.ws + OFF_E + 34603008), (const bf16_t*)(p.ws + OFF_W3), 4096, 1024, e, (bf16_t*)smem); } PH_END(4)
  PH_BEGIN(5) conv_phase(p, smem); } if (COOP) xcd_barrier(xb); if (p.ph_lo <= 5 && 5 < p.ph_hi) { gate_phase(p, smem); PH_END(5)
  PH_BEGIN(6) intra_phase(p, smem); PH_END(6)
  PH_BEGIN(7) scan_phase(p, smem); PH_END(7)
  PH_BEGIN(8) hnorm_phase(p); PH_END(8)
  PH_BEGIN(9) { const float* x1 = (const float*)(p.ws + OFF_A);
                EpiRes e{x1, x1 + (size_t)NP * DM, p.out + O_Y, nullptr, (float*)(p.ws + OFF_SS2)};
                gemm_phase((const bf16_t*)(p.ws + OFF_F), (const bf16_t*)(p.ws + OFF_W4), 1024, 2048, e, (bf16_t*)smem, true); } PH_END(9)
  PH_BEGIN(10) final_phase(p); }
}

extern "C" void kernel_launch(void* const* d_in, const int* in_sizes, int n_in, void* d_out, int out_size, void* d_ws, size_t ws_size, hipStream_t stream) {
  static int grid = 0;
  if (grid == 0) {
    int dev = 0, cus = 0, per_cu = 0;
    hipGetDevice(&dev);
    hipDeviceGetAttribute(&cus, hipDeviceAttributeMultiprocessorCount, dev);
    hipOccupancyMaxActiveBlocksPerMultiprocessor(&per_cu, (const void*)fwd_kernel<true>, NBLK, 0);
    if (per_cu < 1) per_cu = 1;
    if (per_cu > 2) per_cu = 2;
    grid = cus * per_cu;
    if (ws_size < WS_END) { fprintf(stderr, "kernel_launch: workspace too small (%zu < %zu)\n", ws_size, (size_t)WS_END); grid = -1; }
  }
  if (grid < 0) return;
  Params p{};
  for (int i = 0; i < 25; ++i) p.in[i] = (const float*)d_in[i];
  p.out = (float*)d_out; p.ws = (char*)d_ws;
#if MULTI_LAUNCH
  for (int ph = 0; ph < NPHASE; ++ph) {
    p.ph_lo = ph; p.ph_hi = ph + 1;
    hipLaunchKernelGGL(fwd_kernel<false>, dim3(grid), dim3(NBLK), 0, stream, p);
  }
#else
  p.ph_lo = 0; p.ph_hi = NPHASE;
  (void)hipMemsetAsync((char*)d_ws + OFF_BAR, 0, 16384, stream);
  void* args[] = {&p};
  hipError_t e = hipLaunchCooperativeKernel((const void*)fwd_kernel<true>, dim3(grid), dim3(NBLK), args, 0, stream);
  if (e != hipSuccess) fprintf(stderr, "cooperative launch failed: %s (grid %d)\n", hipGetErrorString(e), grid);
#endif
}
```

```cpp
#include <hip/hip_runtime.h>
#include <hip/hip_cooperative_groups.h>
#include <cstdio>
#include <cstdint>
namespace cg = cooperative_groups;

#ifndef MULTI_LAUNCH
#define MULTI_LAUNCH 0
#endif

typedef unsigned short bf16_t;
typedef short bf16x8 __attribute__((ext_vector_type(8)));
typedef float f32x16 __attribute__((ext_vector_type(16)));
typedef float f32x4 __attribute__((ext_vector_type(4)));
typedef float f32x2 __attribute__((ext_vector_type(2)));
typedef unsigned u32x4 __attribute__((ext_vector_type(4)));
typedef unsigned u32x2 __attribute__((ext_vector_type(2)));
#define DEV __device__ __forceinline__
#define MFMA32(a, b, c) __builtin_amdgcn_mfma_f32_32x32x16_bf16((a), (b), (c), 0, 0, 0)

constexpr int T = 16896, NP = 16384, DM = 1024, E = 2048, NBLK = 256;
constexpr int NPHASE = 11;
constexpr size_t SLOT = 69206016;
constexpr size_t OFF_A = 0;
constexpr size_t OFF_B = SLOT;
constexpr size_t OFF_C = 2 * SLOT;
constexpr size_t OFF_D = 3 * SLOT;
constexpr size_t OFF_E = 4 * SLOT;
constexpr size_t OFF_F = 5 * SLOT;
constexpr size_t OFF_W1 = 6 * SLOT;
constexpr size_t OFF_W2 = OFF_W1 + 12582912;
constexpr size_t OFF_W3 = OFF_W2 + 4194304;
constexpr size_t OFF_W4 = OFF_W3 + 8388608;
constexpr size_t OFF_WM = OFF_W4 + 4194304;
constexpr size_t OFF_WMS = OFF_WM + 262144;
constexpr size_t OFF_SW = OFF_WMS + 262144;
constexpr size_t OFF_VST = OFF_SW + 69206016;
constexpr size_t OFF_RS0 = OFF_VST + 4325376;
constexpr size_t OFF_SS1 = OFF_RS0 + 67584;
constexpr size_t OFF_SS2 = OFF_SS1 + 1081344;
constexpr size_t OFF_GB = OFF_SS2 + 1081344;
constexpr size_t OFF_GU = OFF_GB + 270336;
constexpr size_t OFF_GA = OFF_GU + 270336;
constexpr size_t OFF_WINTER = OFF_GA + 270336;
constexpr size_t OFF_WUPD = OFF_WINTER + 270336;
constexpr size_t OFF_DENI = OFF_WUPD + 270336;
constexpr size_t OFF_ENEGM = OFF_DENI + 270336;
constexpr size_t OFF_DINV = OFF_ENEGM + 270336;
constexpr size_t OFF_CHS = OFF_DINV + 270336;
constexpr size_t OFF_DECAY = OFF_CHS + 8192;
constexpr size_t OFF_GP = OFF_DECAY + 8192;
constexpr size_t OFF_BAR = OFF_GP + 1081344;
constexpr size_t OFF_GT = OFF_BAR + 16384;
constexpr size_t WS_END = OFF_GT + 524288;
constexpr size_t O_Y = 0;
constexpr size_t O_SGUV = 17301504;
constexpr size_t O_CP = 18350080;
constexpr size_t O_NP = 20447232;
constexpr size_t O_MP = 20451328;
constexpr size_t O_CONVP = 20451336;
constexpr size_t O_CS = 20463624;
constexpr size_t O_NS = 54018056;
constexpr size_t O_MS = 54083592;
constexpr size_t O_CONVS = 54083720;

struct Params {
  const float* in[25];
  float* out;
  char* ws;
  int ph_lo, ph_hi;
};

typedef __bf16 bf16v2 __attribute__((ext_vector_type(2)));
DEV unsigned cvt_pk_bf16(float lo, float hi) { f32x2 v = {lo, hi}; bf16v2 b = __builtin_convertvector(v, bf16v2); return __builtin_bit_cast(unsigned, b); }
DEV float bf_lo(unsigned u) { return __uint_as_float(u << 16); }
DEV float bf_hi(unsigned u) { return __uint_as_float(u & 0xffff0000u); }
DEV float bf1(bf16_t b) { return __uint_as_float(((unsigned)b) << 16); }
DEV bf16_t f2bf(float x) { return (bf16_t)(cvt_pk_bf16(x, 0.f) & 0xffffu); }
DEV float sigmoidf_(float x) { return __builtin_amdgcn_rcpf(1.f + __builtin_amdgcn_exp2f(-1.4426950408889634f * x)); }
DEV float siluf_(float x) { return x * __builtin_amdgcn_rcpf(1.f + __builtin_amdgcn_exp2f(-1.4426950408889634f * x)); }
DEV float geluf_(float x) { const float x2 = x * x; const float t = x * (-2.302208198092545f - 0.10294324517f * x2); return x * __builtin_amdgcn_rcpf(1.f + __builtin_amdgcn_exp2f(t)); }
DEV int crow(int reg, int h) { return (reg & 3) + 8 * (reg >> 2) + 4 * h; }
DEV float wave_sum(float v) {
#pragma unroll
  for (int o = 1; o < 64; o <<= 1) v += __shfl_xor(v, o);
  return v;
}
DEV bf16x8 as_bf16x8(u32x4 v) { return __builtin_bit_cast(bf16x8, v); }

DEV void transpose_tile(const float* __restrict__ W, int K, int N, const float* __restrict__ gain, bf16_t* __restrict__ WT, int tile, float* scr) {
  const int tid = threadIdx.x;
  const int ntn = N / 64, kb = tile / ntn, nb = tile % ntn, k0 = kb * 64, n0 = nb * 64;
#pragma unroll
  for (int j = 0; j < 4; ++j) {
    const int c = tid + 256 * j, r = c >> 4, c4 = (c & 15) * 4;
    f32x4 v = *(const f32x4*)(W + (size_t)(k0 + r) * N + n0 + c4);
    const float g = gain ? gain[k0 + r] : 1.f;
    scr[r * 65 + c4 + 0] = v.x * g; scr[r * 65 + c4 + 1] = v.y * g; scr[r * 65 + c4 + 2] = v.z * g; scr[r * 65 + c4 + 3] = v.w * g;
  }
  __syncthreads();
  {
    const int n = tid >> 2, ks = (tid & 3) * 16;
    u32x4 o0, o1;
    const float* s = scr + ks * 65 + n;
    o0.x = cvt_pk_bf16(s[0 * 65], s[1 * 65]); o0.y = cvt_pk_bf16(s[2 * 65], s[3 * 65]); o0.z = cvt_pk_bf16(s[4 * 65], s[5 * 65]); o0.w = cvt_pk_bf16(s[6 * 65], s[7 * 65]);
    o1.x = cvt_pk_bf16(s[8 * 65], s[9 * 65]); o1.y = cvt_pk_bf16(s[10 * 65], s[11 * 65]); o1.z = cvt_pk_bf16(s[12 * 65], s[13 * 65]); o1.w = cvt_pk_bf16(s[14 * 65], s[15 * 65]);
    bf16_t* dst = WT + (size_t)(n0 + n) * K + k0 + ks;
    *(u32x4*)dst = o0; *(u32x4*)(dst + 8) = o1;
  }
  __syncthreads();
}

DEV void phase0(const Params& p, char* smem) {
  float* scr = (float*)smem;
  const int nb = gridDim.x, bid = blockIdx.x, tid = threadIdx.x;
  bf16_t* W1 = (bf16_t*)(p.ws + OFF_W1); bf16_t* W2 = (bf16_t*)(p.ws + OFF_W2); bf16_t* W3 = (bf16_t*)(p.ws + OFF_W3); bf16_t* W4 = (bf16_t*)(p.ws + OFF_W4);
  constexpr int T1 = 16 * 96, T2 = 32 * 16, T3 = 16 * 64, T4 = 32 * 16;
  for (int it = bid; it < T1 + T2 + T3 + T4; it += nb) {
    int r = it;
    if (r < T1) { transpose_tile(p.in[8], 1024, 6144, p.in[6], W1, r, scr); continue; } r -= T1;
    if (r < T2) { transpose_tile(p.in[13], 2048, 1024, nullptr, W2, r, scr); continue; } r -= T2;
    if (r < T3) { transpose_tile(p.in[14], 1024, 4096, p.in[6] + 1024, W3, r, scr); continue; } r -= T3;
    transpose_tile(p.in[24], 2048, 1024, nullptr, W4, r, scr);
  }
  {
    bf16_t* XB = (bf16_t*)(p.ws + OFF_E); float* RS0 = (float*)(p.ws + OFF_RS0);
    const int lane = tid & 63, wid = tid >> 6;
    for (int row = bid * 4 + wid; row < T; row += nb * 4) {
      const float* xr = row < NP ? p.in[0] + (size_t)row * DM : p.in[1] + (size_t)(row - NP) * DM;
      f32x4 v[4]; float ss = 0.f;
#pragma unroll
      for (int j = 0; j < 4; ++j) { v[j] = *(const f32x4*)(xr + j * 256 + lane * 4); ss += v[j].x * v[j].x + v[j].y * v[j].y + v[j].z * v[j].z + v[j].w * v[j].w; }
      ss = wave_sum(ss);
#pragma unroll
      for (int j = 0; j < 4; ++j) { u32x2 o; o.x = cvt_pk_bf16(v[j].x, v[j].y); o.y = cvt_pk_bf16(v[j].z, v[j].w); *(u32x2*)(XB + (size_t)row * DM + j * 256 + lane * 4) = o; }
      if (lane == 0) RS0[row] = rsqrtf(ss * (1.f / DM) + 1e-6f);
    }
  }
  {
    bf16_t* GT = (bf16_t*)(p.ws + OFF_GT);
    const float* wq = p.in[17]; const float* wk = p.in[18]; const float* wv = p.in[19]; const float* wgt = p.in[20];
    for (int idx = bid * 256 + tid; idx < 32 * 4096; idx += nb * 256) {
      const int j = idx >> 12, k = idx & 4095;
      bf16_t hi = 0, lo = 0;
      if (j < 8) {
        const int part = k >> 11, ch = k & 2047, nbk = ch >> 2, i = ch & 3, cb4 = ch & ~3;
        float g = 0.f;
#pragma unroll
        for (int o = 0; o < 4; ++o) {
          if (part == 0) g += wq[nbk * 16 + i * 4 + o] * wgt[(size_t)(cb4 + o) * 8 + j] + wk[nbk * 16 + i * 4 + o] * wgt[(size_t)(E + cb4 + o) * 8 + j];
          else g += wv[nbk * 16 + i * 4 + o] * wgt[(size_t)(2 * E + cb4 + o) * 8 + j];
        }
        hi = f2bf(g); lo = f2bf(g - bf1(hi));
      }
      GT[(size_t)j * 4096 + k] = hi; GT[(size_t)(32 + j) * 4096 + k] = lo;
    }
  }
  {
    bf16_t* WM = (bf16_t*)(p.ws + OFF_WM); bf16_t* WMS = (bf16_t*)(p.ws + OFF_WMS);
    const float* ws_ = p.in[11];
    for (int i = bid * 256 + tid; i < 8 * 128 * 128; i += nb * 256) {
      const int g = i >> 14, t = (i >> 7) & 127, s = i & 127;
      WM[i] = f2bf(s <= t ? ws_[i] : 0.f);
      const int tl = t & 15, sl = s & 15;
      WMS[i] = f2bf(((t >> 4) == (s >> 4) && sl <= tl) ? ws_[(g << 14) + tl * 128 + sl] : 0.f);
    }
  }
}

constexpr int LDS_ST = 72;
constexpr int TILE_E = 128 * LDS_ST;

constexpr int TILE_G = 128 * 64;

template <int MI, class Epi>
DEV void gemm_tile(const bf16_t* __restrict__ X, const bf16_t* __restrict__ W, const int K, const int row0, const int col0, const Epi& epi, bf16_t* sm) {
  int tid_ = threadIdx.x; asm volatile("" : "+v"(tid_));
  const int tid = tid_, lane = tid & 63, wid = tid >> 6, wr = wid >> 1, wc = wid & 1;
  const int l31 = lane & 31, hh = lane >> 5;
  bf16_t* sa = sm; bf16_t* sb = sm + 2 * TILE_G;
  f32x16 acc[MI][2];
#pragma unroll
  for (int a = 0; a < MI; ++a)
#pragma unroll
    for (int b = 0; b < 2; ++b)
#pragma unroll
      for (int i = 0; i < 16; ++i) acc[a][b][i] = 0.f;
  const int srow = wid * 8 + (lane >> 3);
  const int sc8 = ((lane & 7) ^ (((wid & 1) << 2) | (lane >> 4))) * 8;
  const bf16_t* xp = X + (size_t)(row0 + srow) * K + sc8;
  const bf16_t* wp = W + (size_t)(col0 + srow) * K + sc8;
  const int sdst = wid * 8 * 64 + lane * 8;
#define GEMM_STAGE(bufi, k0) do { _Pragma("unroll") for (int j = 0; j < 4; ++j) { \
      if (j < 2 * MI) __builtin_amdgcn_global_load_lds((const unsigned*)(xp + (size_t)(32 * j) * K + (k0)), (unsigned*)(sa + (bufi) * TILE_G + sdst + j * 2048), 16, 0, 0); \
      __builtin_amdgcn_global_load_lds((const unsigned*)(wp + (size_t)(32 * j) * K + (k0)), (unsigned*)(sb + (bufi) * TILE_G + sdst + j * 2048), 16, 0, 0); } } while (0)
  GEMM_STAGE(0, 0); GEMM_STAGE(1, 64);
  const int swz = (l31 >> 1) & 7;
  int koff[4];
#pragma unroll
  for (int kk = 0; kk < 4; ++kk) koff[kk] = ((2 * kk + hh) ^ swz) * 8;
  const int nk = K >> 6;
  for (int kt = 0; kt < nk; ++kt) {
    const int buf = kt & 1;
    if (kt + 1 < nk) { if (MI == 2) asm volatile("s_waitcnt vmcnt(8)" ::: "memory"); else asm volatile("s_waitcnt vmcnt(6)" ::: "memory"); }
    else asm volatile("s_waitcnt vmcnt(0)" ::: "memory");
    __builtin_amdgcn_s_barrier();
    const bf16_t* ca = sa + buf * TILE_G + (wr * 32 * MI + l31) * 64;
    const bf16_t* cb = sb + buf * TILE_G + (wc * 64 + l31) * 64;
    bf16x8 fa[4][MI], fb[4][2];
#pragma unroll
    for (int kk = 0; kk < 4; ++kk) {
#pragma unroll
      for (int mi = 0; mi < MI; ++mi) fa[kk][mi] = *(const bf16x8*)(ca + mi * 32 * 64 + koff[kk]);
      fb[kk][0] = *(const bf16x8*)(cb + koff[kk]); fb[kk][1] = *(const bf16x8*)(cb + 32 * 64 + koff[kk]);
    }
    asm volatile("s_waitcnt lgkmcnt(0)" ::: "memory");
    __builtin_amdgcn_s_barrier();
    if (kt + 2 < nk) GEMM_STAGE(buf, (kt + 2) * 64);
    __builtin_amdgcn_sched_barrier(0);
    __builtin_amdgcn_s_setprio(1);
#pragma unroll
    for (int kk = 0; kk < 4; ++kk)
#pragma unroll
      for (int mi = 0; mi < MI; ++mi) {
        acc[mi][0] = MFMA32(fb[kk][0], fa[kk][mi], acc[mi][0]); acc[mi][1] = MFMA32(fb[kk][1], fa[kk][mi], acc[mi][1]);
      }
    __builtin_amdgcn_s_setprio(0);
  }
#undef GEMM_STAGE
  epi.template run<MI>(acc, row0 + wr * 32 * MI, col0 + wc * 64, l31, hh);
}

template <class Epi>
DEV void gemm_phase(const bf16_t* X, const bf16_t* W, int N, int K, const Epi& epi, bf16_t* sm, bool half_tail = false) {
  const int ntn = N / 128, ntm = T / 128, nt = ntn * ntm;
  const int rem = nt % (int)gridDim.x;
  const int full_rows = (half_tail && rem > 0 && rem % ntn == 0) ? ntm - rem / ntn : ntm;
  const int G = gridDim.x;
  if (half_tail && ntn == 8 && (G & 7) == 0 && (full_rows & 1) == 0) {
    const int x = blockIdx.x & 7, cgrp = x & 3, rsub = x >> 2, nbx = G >> 3, nloc = (full_rows >> 1) * 2;
    for (int li = blockIdx.x >> 3; li < nloc; li += nbx) {
      const int tm = 2 * (li >> 1) + rsub, tn = 2 * cgrp + (li & 1);
      gemm_tile<2>(X, W, K, tm * 128, tn * 128, epi, sm);
    }
  } else {
    for (int t = blockIdx.x; t < full_rows * ntn; t += gridDim.x) {
      const int tm = t / ntn, tn = t % ntn;
      gemm_tile<2>(X, W, K, tm * 128, tn * 128, epi, sm);
    }
  }
  if (full_rows < ntm) {
    for (int t = blockIdx.x; t < (ntm - full_rows) * 2 * ntn; t += gridDim.x) {
      const int tmh = t / ntn, tn = t % ntn;
      gemm_tile<1>(X, W, K, full_rows * 128 + tmh * 64, tn * 128, epi, sm);
    }
  }
}

struct Epi1 {
  const float* rs0; bf16_t* U; bf16_t* VT; bf16_t* Z; float* VST;
  template <int MI> DEV void run(const f32x16 (&acc)[MI][2], int rbase, int cbase, int l31, int hh) const {
    const float rr[2] = {rs0[rbase + l31], rs0[rbase + 32 + l31]};
#pragma unroll
    for (int mi = 0; mi < MI; ++mi) {
      const int tok = rbase + mi * 32 + l31;
      const float r = rr[mi];
      if (cbase < 2048) {
#pragma unroll
        for (int ni = 0; ni < 2; ++ni)
#pragma unroll
          for (int g = 0; g < 4; ++g) {
            const int ch = cbase + ni * 32 + 8 * g + 4 * hh;
            u32x2 o; o.x = cvt_pk_bf16(geluf_(acc[mi][ni][4 * g] * r), geluf_(acc[mi][ni][4 * g + 1] * r));
            o.y = cvt_pk_bf16(geluf_(acc[mi][ni][4 * g + 2] * r), geluf_(acc[mi][ni][4 * g + 3] * r));
            *(u32x2*)(U + (size_t)tok * E + ch) = o;
          }
      } else if (cbase < 4096) {
        float s = 0.f, ss = 0.f;
#pragma unroll
        for (int ni = 0; ni < 2; ++ni)
#pragma unroll
          for (int i = 0; i < 16; ++i) {
            const int ch = cbase - 2048 + ni * 32 + crow(i, hh);
            const float v = geluf_(acc[mi][ni][i] * r);
            s += v; ss += v * v;
            VT[(size_t)ch * T + tok] = f2bf(v);
          }
        s += __shfl_xor(s, 32); ss += __shfl_xor(ss, 32);
        if (hh == 0) { f32x2 o; o.x = s; o.y = ss; *(f32x2*)(VST + ((size_t)tok * 32 + ((cbase - 2048) >> 6)) * 2) = o; }
      } else {
#pragma unroll
        for (int ni = 0; ni < 2; ++ni)
#pragma unroll
          for (int g = 0; g < 4; ++g) {
            const int ch = cbase - 4096 + ni * 32 + 8 * g + 4 * hh;
            u32x2 o; o.x = cvt_pk_bf16(acc[mi][ni][4 * g] * r, acc[mi][ni][4 * g + 1] * r);
            o.y = cvt_pk_bf16(acc[mi][ni][4 * g + 2] * r, acc[mi][ni][4 * g + 3] * r);
            *(u32x2*)(Z + (size_t)tok * E + ch) = o;
          }
      }
    }
  }
};

struct EpiRes {
  const float* res_p; const float* res_s;
  float* OUT; bf16_t* OUTB; float* SS;
  template <int MI> DEV void run(const f32x16 (&acc)[MI][2], int rbase, int cbase, int l31, int hh) const {
#pragma unroll
    for (int mi = 0; mi < MI; ++mi) {
      const int tok = rbase + mi * 32 + l31;
      const float* rp = tok < NP ? res_p + (size_t)tok * DM : res_s + (size_t)(tok - NP) * DM;
      f32x4 rva[2][4];
#pragma unroll
      for (int ni = 0; ni < 2; ++ni)
#pragma unroll
        for (int g = 0; g < 4; ++g) rva[ni][g] = *(const f32x4*)(rp + cbase + ni * 32 + 8 * g + 4 * hh);
      float ss = 0.f;
#pragma unroll
      for (int ni = 0; ni < 2; ++ni)
#pragma unroll
        for (int g = 0; g < 4; ++g) {
          const int ch = cbase + ni * 32 + 8 * g + 4 * hh;
          const f32x4 rv = rva[ni][g];
          f32x4 o; o.x = acc[mi][ni][4 * g] + rv.x; o.y = acc[mi][ni][4 * g + 1] + rv.y; o.z = acc[mi][ni][4 * g + 2] + rv.z; o.w = acc[mi][ni][4 * g + 3] + rv.w;
          ss += o.x * o.x + o.y * o.y + o.z * o.z + o.w * o.w;
          *(f32x4*)(OUT + (size_t)tok * DM + ch) = o;
          if (OUTB) { u32x2 b; b.x = cvt_pk_bf16(o.x, o.y); b.y = cvt_pk_bf16(o.z, o.w); *(u32x2*)(OUTB + (size_t)tok * DM + ch) = b; }
        }
      ss += __shfl_xor(ss, 32);
      if (hh == 0) SS[(size_t)tok * 16 + (cbase >> 6)] = ss;
    }
  }
};

struct Epi3 {
  const float* SS1; bf16_t* XM; bf16_t* Z2;
  template <int MI> DEV void run(const f32x16 (&acc)[MI][2], int rbase, int cbase, int l31, int hh) const {
    float sums[2];
#pragma unroll
    for (int mi = 0; mi < MI; ++mi) {
      float s = 0.f;
#pragma unroll
      for (int j = 0; j < 4; ++j) { const f32x4 v = *(const f32x4*)(SS1 + (size_t)(rbase + mi * 32 + l31) * 16 + 4 * j); s += v.x + v.y + v.z + v.w; }
      sums[mi] = s;
    }
#pragma unroll
    for (int mi = 0; mi < MI; ++mi) {
      const int tok = rbase + mi * 32 + l31;
      const float r = rsqrtf(sums[mi] * (1.f / DM) + 1e-6f);
      bf16_t* dst = cbase < 2048 ? XM + (size_t)tok * E + cbase : Z2 + (size_t)tok * E + cbase - 2048;
#pragma unroll
      for (int ni = 0; ni < 2; ++ni)
#pragma unroll
        for (int g = 0; g < 4; ++g) {
          u32x2 o; o.x = cvt_pk_bf16(acc[mi][ni][4 * g] * r, acc[mi][ni][4 * g + 1] * r);
          o.y = cvt_pk_bf16(acc[mi][ni][4 * g + 2] * r, acc[mi][ni][4 * g + 3] * r);
          *(u32x2*)(dst + ni * 32 + 8 * g + 4 * hh) = o;
        }
    }
  }
};

DEV void sgu_phase(const Params& p, char* smem) {
  const int tid = threadIdx.x, lane = tid & 63, wid = tid >> 6, l31 = lane & 31, hh = lane >> 5;
  float* smu = (float*)smem; float* srs = smu + 128;
  const bf16_t* U = (const bf16_t*)(p.ws + OFF_A); const bf16_t* VT = (const bf16_t*)(p.ws + OFF_B); const bf16_t* Z = (const bf16_t*)(p.ws + OFF_C);
  bf16_t* G = (bf16_t*)(p.ws + OFF_D);
  const float* VST = (const float*)(p.ws + OFF_VST);
  const float* lng = p.in[9]; const float* lnb = p.in[10]; const float* bs = p.in[12];
  for (int unit = blockIdx.x; unit < 132 * 8; unit += gridDim.x) {
    const int ci = unit >> 3, g = unit & 7, tok0 = ci * 128;
    const bool samp = ci >= 128;
    const bf16_t* WMg = (const bf16_t*)(p.ws + (samp ? OFF_WMS : OFF_WM)) + g * 16384;
    __syncthreads();
    if (tid < 128) {
      float s = 0.f, ss = 0.f;
      const f32x4* q = (const f32x4*)(VST + (size_t)(tok0 + tid) * 64);
#pragma unroll
      for (int j = 0; j < 16; ++j) { const f32x4 v = q[j]; s += v.x + v.z; ss += v.y + v.w; }
      const float mean = s * (1.f / E); const float var = ss * (1.f / E) - mean * mean;
      smu[tid] = mean; srs[tid] = rsqrtf(var + 1e-5f);
    }
    __syncthreads();
    const int cbase = g * 256 + wid * 64;
    bf16x8 af[2][8];
#pragma unroll
    for (int mi = 0; mi < 2; ++mi) {
      const int c = cbase + mi * 32 + l31;
      const float gg = lng[c], bb = lnb[c];
      u32x4 raws[8];
#pragma unroll
      for (int kk = 0; kk < 8; ++kk) raws[kk] = *(const u32x4*)(VT + (size_t)c * T + tok0 + kk * 16 + 8 * hh);
      __builtin_amdgcn_sched_barrier(0);
#pragma unroll
      for (int kk = 0; kk < 8; ++kk) {
        const int s0 = kk * 16 + 8 * hh;
        const u32x4 raw = raws[kk];
        const f32x4 m0 = *(const f32x4*)(smu + s0), m1 = *(const f32x4*)(smu + s0 + 4);
        const f32x4 r0 = *(const f32x4*)(srs + s0), r1 = *(const f32x4*)(srs + s0 + 4);
        float v[8];
        v[0] = (bf_lo(raw.x) - m0.x) * r0.x * gg + bb; v[1] = (bf_hi(raw.x) - m0.y) * r0.y * gg + bb;
        v[2] = (bf_lo(raw.y) - m0.z) * r0.z * gg + bb; v[3] = (bf_hi(raw.y) - m0.w) * r0.w * gg + bb;
        v[4] = (bf_lo(raw.z) - m1.x) * r1.x * gg + bb; v[5] = (bf_hi(raw.z) - m1.y) * r1.y * gg + bb;
        v[6] = (bf_lo(raw.w) - m1.z) * r1.z * gg + bb; v[7] = (bf_hi(raw.w) - m1.w) * r1.w * gg + bb;
        u32x4 pk; pk.x = cvt_pk_bf16(v[0], v[1]); pk.y = cvt_pk_bf16(v[2], v[3]); pk.z = cvt_pk_bf16(v[4], v[5]); pk.w = cvt_pk_bf16(v[6], v[7]);
        af[mi][kk] = as_bf16x8(pk);
        if (samp) {
          float* sv = p.out + O_SGUV + (size_t)(tok0 - NP + s0) * E + c;
#pragma unroll
          for (int j = 0; j < 8; ++j) sv[(size_t)j * E] = v[j];
        }
      }
    }
#pragma unroll
    for (int nt = 0; nt < 4; ++nt) {
      f32x16 acc[2];
#pragma unroll
      for (int i = 0; i < 16; ++i) { acc[0][i] = 0.f; acc[1][i] = 0.f; }
      const int tl = nt * 32 + l31;
      u32x4 bfrs[8];
#pragma unroll
      for (int kk = 0; kk < 8; ++kk) if (kk <= 2 * nt + 1) bfrs[kk] = *(const u32x4*)(WMg + tl * 128 + kk * 16 + 8 * hh);
      __builtin_amdgcn_sched_barrier(0);
#pragma unroll
      for (int kk = 0; kk < 8; ++kk) {
        if (kk <= 2 * nt + 1) {
          acc[0] = MFMA32(af[0][kk], as_bf16x8(bfrs[kk]), acc[0]);
          acc[1] = MFMA32(af[1][kk], as_bf16x8(bfrs[kk]), acc[1]);
        }
      }
      const int tok = tok0 + tl;
      const float bias = bs[g * 128 + (samp ? (tl & 15) : tl)];
      u32x2 uus[2][4], zzs[2][4];
#pragma unroll
      for (int mi = 0; mi < 2; ++mi)
#pragma unroll
        for (int q = 0; q < 4; ++q) {
          const int c = cbase + mi * 32 + 8 * q + 4 * hh;
          uus[mi][q] = *(const u32x2*)(U + (size_t)tok * E + c);
          zzs[mi][q] = *(const u32x2*)(Z + (size_t)tok * E + c);
        }
#pragma unroll
      for (int mi = 0; mi < 2; ++mi)
#pragma unroll
        for (int q = 0; q < 4; ++q) {
          const int c = cbase + mi * 32 + 8 * q + 4 * hh;
          const u32x2 uu = uus[mi][q];
          const u32x2 zz = zzs[mi][q];
          const float o0 = bf_lo(uu.x) * (acc[mi][4 * q] + bias) * siluf_(bf_lo(zz.x));
          const float o1 = bf_hi(uu.x) * (acc[mi][4 * q + 1] + bias) * siluf_(bf_hi(zz.x));
          const float o2 = bf_lo(uu.y) * (acc[mi][4 * q + 2] + bias) * siluf_(bf_lo(zz.y));
          const float o3 = bf_hi(uu.y) * (acc[mi][4 * q + 3] + bias) * siluf_(bf_hi(zz.y));
          u32x2 o; o.x = cvt_pk_bf16(o0, o1); o.y = cvt_pk_bf16(o2, o3);
          *(u32x2*)(G + (size_t)tok * E + c) = o;
        }
    }
  }
}

DEV int perm4(int g) { return ((g & 1) << 1) | (g >> 1); }

struct ConvHist { float x1[4], x2[4], x3[4]; };
DEV void conv_hist_init(ConvHist& H, const bf16_t* XM, const float* conv0, int t, int tt, int pos, bool samp, int ch) {
  if (pos == 0) {
    if (samp) {
      const float* c0 = conv0 + (size_t)((t - NP) >> 4) * 3 * E + ch;
      const f32x4 a = *(const f32x4*)(c0), b = *(const f32x4*)(c0 + E), c = *(const f32x4*)(c0 + 2 * E);
      H.x3[0] = a.x; H.x3[1] = a.y; H.x3[2] = a.z; H.x3[3] = a.w; H.x2[0] = b.x; H.x2[1] = b.y; H.x2[2] = b.z; H.x2[3] = b.w; H.x1[0] = c.x; H.x1[1] = c.y; H.x1[2] = c.z; H.x1[3] = c.w;
    } else {
#pragma unroll
      for (int i = 0; i < 4; ++i) { H.x1[i] = 0.f; H.x2[i] = 0.f; H.x3[i] = 0.f; }
    }
  } else if (tt == 0) {
    const u32x2 a = *(const u32x2*)(XM + (size_t)(t - 1) * E + ch), b = *(const u32x2*)(XM + (size_t)(t - 2) * E + ch), c = *(const u32x2*)(XM + (size_t)(t - 3) * E + ch);
    H.x1[0] = bf_lo(a.x); H.x1[1] = bf_hi(a.x); H.x1[2] = bf_lo(a.y); H.x1[3] = bf_hi(a.y);
    H.x2[0] = bf_lo(b.x); H.x2[1] = bf_hi(b.x); H.x2[2] = bf_lo(b.y); H.x2[3] = bf_hi(b.y);
    H.x3[0] = bf_lo(c.x); H.x3[1] = bf_hi(c.x); H.x3[2] = bf_lo(c.y); H.x3[3] = bf_hi(c.y);
  }
}

DEV float reduce16(float (&r16)[16], int lane) {
#pragma unroll
  for (int i = 0; i < 8; ++i) { const bool up = lane & 8; const float send = up ? r16[i] : r16[i + 8]; const float keep = up ? r16[i + 8] : r16[i]; r16[i] = keep + __shfl_xor(send, 8); }
#pragma unroll
  for (int i = 0; i < 4; ++i) { const bool up = lane & 4; const float send = up ? r16[i] : r16[i + 4]; const float keep = up ? r16[i + 4] : r16[i]; r16[i] = keep + __shfl_xor(send, 4); }
#pragma unroll
  for (int i = 0; i < 2; ++i) { const bool up = lane & 2; const float send = up ? r16[i] : r16[i + 2]; const float keep = up ? r16[i + 2] : r16[i]; r16[i] = keep + __shfl_xor(send, 2); }
  { const bool up = lane & 1; const float send = up ? r16[0] : r16[1]; const float keep = up ? r16[1] : r16[0]; r16[0] = keep + __shfl_xor(send, 1); }
  float tot = r16[0];
  tot += __shfl_xor(tot, 16); tot += __shfl_xor(tot, 32);
  return tot;
}

DEV void conv_phase(const Params& p, char* smem) {
  const int tid = threadIdx.x;
  const bf16_t* XM = (const bf16_t*)(p.ws + OFF_B);
  bf16_t* XC = (bf16_t*)(p.ws + OFF_D); bf16_t* QF = (bf16_t*)(p.ws + OFF_E); bf16_t* VF = (bf16_t*)(p.ws + OFF_F);
  bf16_t* KF = (bf16_t*)(p.out + O_CS); bf16_t* KTF = (bf16_t*)(p.out + O_Y);
  const float* conv0 = p.in[5]; const float* convw = p.in[15]; const float* convb = p.in[16];
  const float* wq = p.in[17]; const float* wk = p.in[18]; const float* wv = p.in[19];
  const float kscale = 0.04419417382415922f;
  bf16_t* QS = (bf16_t*)(smem + 4096); bf16_t* KS = QS + 128 * 136;
  for (int unit = blockIdx.x; unit < (T / 16) * 2; unit += gridDim.x) {
    const int hf = unit & 1, tok0 = (unit >> 1) * 16, cg = tok0 >> 6, tt0 = tok0 & 63;
    const bool samp = tok0 >= NP;
    const int nb = hf * 256 + tid, ch = nb * 4, h = nb >> 7, nl = nb & 127;
    const int pd = (nl & ~3) * 4 + perm4(nl & 3) * 4, kstep = pd >> 4, hhq = (pd >> 3) & 1, j0 = pd & 7;
    float cw[4][4], cb[4], q_w[4][4], k_w[4][4], v_w[4][4];
#pragma unroll
    for (int j = 0; j < 4; ++j) { const f32x4 v = *(const f32x4*)(convw + j * E + ch); cw[j][0] = v.x; cw[j][1] = v.y; cw[j][2] = v.z; cw[j][3] = v.w; }
    { const f32x4 v = *(const f32x4*)(convb + ch); cb[0] = v.x; cb[1] = v.y; cb[2] = v.z; cb[3] = v.w; }
#pragma unroll
    for (int i = 0; i < 4; ++i) {
      const f32x4 a = *(const f32x4*)(wq + nb * 16 + i * 4), b = *(const f32x4*)(wk + nb * 16 + i * 4), c = *(const f32x4*)(wv + nb * 16 + i * 4);
      q_w[i][0] = a.x; q_w[i][1] = a.y; q_w[i][2] = a.z; q_w[i][3] = a.w;
      k_w[i][0] = b.x * kscale; k_w[i][1] = b.y * kscale; k_w[i][2] = b.z * kscale; k_w[i][3] = b.w * kscale;
      v_w[i][0] = c.x; v_w[i][1] = c.y; v_w[i][2] = c.z; v_w[i][3] = c.w;
    }
    u32x2 xrow[16];
#pragma unroll
    for (int i = 0; i < 16; ++i) xrow[i] = *(const u32x2*)(XM + (size_t)(tok0 + i) * E + ch);
    __syncthreads();
    ConvHist H;
    const int srun = (((tid >> 7) * 32 + kstep) * 2 + hhq) * 136 + j0;
#pragma unroll
    for (int tb8 = 0; tb8 < 2; ++tb8) {
      unsigned kacc[4][4], vacc[4][4];
#pragma unroll
      for (int pr = 0; pr < 4; ++pr) {
        float kq[2][4], vq[2][4];
#pragma unroll
        for (int u = 0; u < 2; ++u) {
          const int ttl = tb8 * 8 + pr * 2 + u, t = tok0 + ttl;
          const int pos = samp ? ttl : (t & 8191);
          conv_hist_init(H, XM, conv0, t, ttl, pos, samp, ch);
          const u32x2 xr = xrow[ttl];
          float x0[4] = {bf_lo(xr.x), bf_hi(xr.x), bf_lo(xr.y), bf_hi(xr.y)};
          float xc[4];
#pragma unroll
          for (int i = 0; i < 4; ++i) xc[i] = siluf_(cb[i] + cw[0][i] * H.x3[i] + cw[1][i] * H.x2[i] + cw[2][i] * H.x1[i] + cw[3][i] * x0[i]);
          float qv[4];
#pragma unroll
          for (int o = 0; o < 4; ++o) {
            qv[o] = xc[0] * q_w[0][o] + xc[1] * q_w[1][o] + xc[2] * q_w[2][o] + xc[3] * q_w[3][o];
            kq[u][o] = xc[0] * k_w[0][o] + xc[1] * k_w[1][o] + xc[2] * k_w[2][o] + xc[3] * k_w[3][o];
            vq[u][o] = x0[0] * v_w[0][o] + x0[1] * v_w[1][o] + x0[2] * v_w[2][o] + x0[3] * v_w[3][o];
          }
          { u32x2 o; o.x = cvt_pk_bf16(xc[0], xc[1]); o.y = cvt_pk_bf16(xc[2], xc[3]); *(u32x2*)(XC + (size_t)t * E + ch) = o; }
          { u32x2 o; o.x = cvt_pk_bf16(qv[0], qv[1]); o.y = cvt_pk_bf16(qv[2], qv[3]); *(u32x2*)(QS + srun + ttl * 8) = o; }
          { u32x2 o; o.x = cvt_pk_bf16(kq[u][0], kq[u][1]); o.y = cvt_pk_bf16(kq[u][2], kq[u][3]); *(u32x2*)(KS + srun + ttl * 8) = o; }
          if (samp) { if (pos >= 13) { f32x4 o; o.x = x0[0]; o.y = x0[1]; o.z = x0[2]; o.w = x0[3]; *(f32x4*)(p.out + O_CONVS + ((size_t)((t - NP) >> 4) * 3 + (pos - 13)) * E + ch) = o; } }
          else if (pos >= 8189) { f32x4 o; o.x = x0[0]; o.y = x0[1]; o.z = x0[2]; o.w = x0[3]; *(f32x4*)(p.out + O_CONVP + ((size_t)(t >> 13) * 3 + (pos - 8189)) * E + ch) = o; }
#pragma unroll
          for (int i = 0; i < 4; ++i) { H.x3[i] = H.x2[i]; H.x2[i] = H.x1[i]; H.x1[i] = x0[i]; }
        }
#pragma unroll
        for (int o = 0; o < 4; ++o) { kacc[o][pr] = cvt_pk_bf16(kq[0][o], kq[1][o]); vacc[o][pr] = cvt_pk_bf16(vq[0][o], vq[1][o]); }
      }
      const int tg = tt0 + tb8 * 8, ks = tg >> 4, hht = (tg >> 3) & 1;
#pragma unroll
      for (int o = 0; o < 4; ++o) {
        const int d = nl * 4 + o;
        const size_t fo = ((((size_t)(cg * 4 + h) * 16 + (d >> 5)) * 4 + ks) * 64 + (d & 31) + 32 * hht) * 8;
        u32x4 kk_; kk_.x = kacc[o][0]; kk_.y = kacc[o][1]; kk_.z = kacc[o][2]; kk_.w = kacc[o][3];
        u32x4 vv_; vv_.x = vacc[o][0]; vv_.y = vacc[o][1]; vv_.z = vacc[o][2]; vv_.w = vacc[o][3];
        *(u32x4*)(KTF + fo) = kk_;
        *(u32x4*)(VF + fo) = vv_;
      }
    }
    __syncthreads();
#pragma unroll 2
    for (int i = 0; i < 8; ++i) {
      const int pc = i * 256 + tid, run = pc >> 4, l16 = pc & 15;
      const int hl = run >> 6, ks_ = (run >> 1) & 31, hq_ = run & 1;
      const size_t dst = ((size_t)((cg * 4 + 2 * hf + hl) * 64 + (tt0 >> 5) * 32 + ks_)) * 512 + ((tt0 & 31) + l16 + 32 * hq_) * 8;
      *(u32x4*)(QF + dst) = *(const u32x4*)(QS + run * 136 + l16 * 8);
      *(u32x4*)(KF + dst) = *(const u32x4*)(KS + run * 136 + l16 * 8);
    }
  }
}

DEV void gate_phase(const Params& p, char* smem) {
  const int tid = threadIdx.x, lane = tid & 63, wid = tid >> 6, l31 = lane & 31, hh = lane >> 5;
  float* sig = (float*)smem; float* slf = sig + 256;
  float* red = (float*)(smem + 2048);
  const bf16_t* XMb = (const bf16_t*)(p.ws + OFF_B); const bf16_t* XCb = (const bf16_t*)(p.ws + OFF_D);
  const bf16_t* GT = (const bf16_t*)(p.ws + OFF_GT);
  const float* bgt = p.in[21];
  float* GB = (float*)(p.ws + OFF_GB); float* GU = (float*)(p.ws + OFF_GU); float* GA = (float*)(p.ws + OFF_GA); float* CHS = (float*)(p.ws + OFF_CHS);
  for (int unit = blockIdx.x; unit < T / 64; unit += gridDim.x) {
    const int tok0 = unit * 64;
    const bool samp = tok0 >= NP;
    __syncthreads();
    {
      bf16_t* slab = (bf16_t*)smem;
      f32x16 a0, a1;
#pragma unroll
      for (int i = 0; i < 16; ++i) { a0[i] = 0.f; a1[i] = 0.f; }
      const int lrow = tid >> 5, lc8 = (tid & 31) * 8;
      const bf16_t* gxc = XCb + (size_t)(tok0 + lrow) * E + lc8;
      const bf16_t* gxm = XMb + (size_t)(tok0 + lrow) * E + lc8;
      const bf16_t* gtp = GT + (size_t)(l31 < 8 ? l31 : 8) * 4096 + wid * 64 + 8 * hh;
      u32x4 ar[8], bcur[8], bnxt[8];
#pragma unroll
      for (int i = 0; i < 8; ++i) ar[i] = *(const u32x4*)(gxc + (size_t)(8 * i) * E);
#pragma unroll
      for (int i = 0; i < 4; ++i) { bcur[i] = *(const u32x4*)(gtp + i * 16); bcur[4 + i] = *(const u32x4*)(gtp + (size_t)32 * 4096 + i * 16); }
#pragma unroll
      for (int i = 0; i < 8; ++i) *(u32x4*)(slab + (lrow + 8 * i) * 264 + lc8) = ar[i];
      __syncthreads();
#pragma unroll 1
      for (int s = 0; s < 16; ++s) {
        const int buf = s & 1;
        if (s + 1 < 16) {
          const bf16_t* g = ((s + 1) < 8 ? gxc : gxm) + ((s + 1) & 7) * 256;
#pragma unroll
          for (int i = 0; i < 8; ++i) ar[i] = *(const u32x4*)(g + (size_t)(8 * i) * E);
#pragma unroll
          for (int i = 0; i < 4; ++i) { bnxt[i] = *(const u32x4*)(gtp + (s + 1) * 256 + i * 16); bnxt[4 + i] = *(const u32x4*)(gtp + (size_t)32 * 4096 + (s + 1) * 256 + i * 16); }
        }
        const bf16_t* sb0 = slab + buf * (64 * 264) + l31 * 264 + wid * 64 + 8 * hh;
#pragma unroll
        for (int i = 0; i < 4; ++i) {
          const bf16x8 x0 = *(const bf16x8*)(sb0 + i * 16), x1 = *(const bf16x8*)(sb0 + 32 * 264 + i * 16);
          a0 = MFMA32(x0, as_bf16x8(bcur[i]), a0); a1 = MFMA32(x1, as_bf16x8(bcur[i]), a1);
          a0 = MFMA32(x0, as_bf16x8(bcur[4 + i]), a0); a1 = MFMA32(x1, as_bf16x8(bcur[4 + i]), a1);
        }
        if (s + 1 < 16) {
#pragma unroll
          for (int i = 0; i < 8; ++i) *(u32x4*)(slab + (buf ^ 1) * (64 * 264) + (lrow + 8 * i) * 264 + lc8) = ar[i];
#pragma unroll
          for (int i = 0; i < 8; ++i) bcur[i] = bnxt[i];
        }
        __syncthreads();
      }
      if (l31 < 8) {
        float* rb = red + (wid * 64 + 4 * hh) * 8 + l31;
#pragma unroll
        for (int i = 0; i < 16; ++i) {
          const int t0 = (i & 3) + 8 * (i >> 2);
          rb[t0 * 8] = a0[i]; rb[(32 + t0) * 8] = a1[i];
        }
      }
    }
    __syncthreads();
    {
      const int tt = tid >> 2, h = tid & 3;
      float gi = bgt[h], gf = bgt[4 + h];
#pragma unroll
      for (int w = 0; w < 4; ++w) { gi += red[(w * 64 + tt) * 8 + h]; gf += red[(w * 64 + tt) * 8 + 4 + h]; }
      sig[h * 64 + tt] = gi;
      slf[h * 64 + tt] = fminf(gf, 0.f) - log1pf(__expf(-fabsf(gf)));
    }
    __syncthreads();
    {
      const int seglen = samp ? 16 : 64, nseg = 64 / seglen;
      if (tid < 4 * nseg) {
        const int h = tid & 3, sg = tid >> 2;
        float b = 0.f, a = -INFINITY;
        for (int j = 0; j < seglen; ++j) {
          const int tt = sg * seglen + j;
          b += slf[h * 64 + tt];
          const float u = sig[h * 64 + tt] - b;
          a = fmaxf(a, u);
          const size_t o = (size_t)(tok0 + tt) * 4 + h;
          GB[o] = b; GU[o] = u; GA[o] = a;
        }
        if (!samp) { CHS[(unit * 4 + h) * 2] = b; CHS[(unit * 4 + h) * 2 + 1] = a; }
      }
    }
  }
}

DEV size_t numidx(int row, int h, int e) { return ((((size_t)(row >> 1) * 4 + h) * 16 + (e >> 5)) * 2 + (row & 1)) * 32 + (e & 31); }

DEV u32x4 coherent_load16(const bf16_t* ptr) {
  unsigned* q = (unsigned*)ptr; u32x4 r;
  r.x = __hip_atomic_load(q, __ATOMIC_RELAXED, __HIP_MEMORY_SCOPE_AGENT); r.y = __hip_atomic_load(q + 1, __ATOMIC_RELAXED, __HIP_MEMORY_SCOPE_AGENT);
  r.z = __hip_atomic_load(q + 2, __ATOMIC_RELAXED, __HIP_MEMORY_SCOPE_AGENT); r.w = __hip_atomic_load(q + 3, __ATOMIC_RELAXED, __HIP_MEMORY_SCOPE_AGENT);
  return r;
}

constexpr int NSUB = 4;

DEV float mscan_prefix(const float* CHS, int pb, int h, int c, int lane) {
  float P[2], Q[2];
#pragma unroll
  for (int j = 0; j < 2; ++j) {
    const int i = 2 * lane + j;
    if (i < c) { const float bl = CHS[((pb * 128 + i) * 4 + h) * 2], al = CHS[((pb * 128 + i) * 4 + h) * 2 + 1]; P[j] = bl; Q[j] = al + bl; }
    else { P[j] = 0.f; Q[j] = -INFINITY; }
  }
  float Pc = P[0] + P[1], Qc = fmaxf(Q[0] + P[1], Q[1]);
#pragma unroll
  for (int off = 1; off < 64; off <<= 1) {
    const float Po = __shfl_xor(Pc, off), Qo = __shfl_xor(Qc, off);
    if (lane & off) { Qc = fmaxf(Qo + Pc, Qc); Pc = Po + Pc; }
    else { Qc = fmaxf(Qc + Po, Qo); Pc = Pc + Po; }
  }
  return fmaxf(Pc, Qc);
}

DEV void intra_phase(const Params& p, char* smem) {
  const int tid = threadIdx.x, lane = tid & 63, wid = tid >> 6, l31 = lane & 31, hh = lane >> 5;
  float* su = (float*)smem;
  float* sM = su + NSUB * 64;
  float* sden = sM + 64;
  bf16_t* SWL = (bf16_t*)(smem + 2048);
  const bf16_t* QF = (const bf16_t*)(p.ws + OFF_E); const bf16_t* KF = (const bf16_t*)(p.out + O_CS); const bf16_t* VF = (const bf16_t*)(p.ws + OFF_F);
  bf16_t* NUMI = (bf16_t*)(p.ws + OFF_SW);
  const float* GB = (const float*)(p.ws + OFF_GB); const float* GU = (const float*)(p.ws + OFF_GU); const float* GA = (const float*)(p.ws + OFF_GA);
  const float* CHS = (const float*)(p.ws + OFF_CHS);
  float* WINTER = (float*)(p.ws + OFF_WINTER); float* WUPD = (float*)(p.ws + OFF_WUPD); float* DENI = (float*)(p.ws + OFF_DENI); float* ENEGM = (float*)(p.ws + OFF_ENEGM);
  float* DECAY = (float*)(p.ws + OFF_DECAY);
  const int si = wid >> 1, ti = wid & 1;
  for (int u0 = blockIdx.x; u0 < 1152; u0 += gridDim.x) {
    const int uid = (u0 >= 512 && u0 < 1024) ? (u0 ^ 12) : u0;
    const bool samp = uid >= 1024;
    const int h = uid & 3;
    __syncthreads();
    if (!samp) {
      const int cg = uid >> 2, pb = cg >> 7, cseq = cg & 127, tb = cseq & (NSUB - 1), cg0 = cg - tb, row0 = cg * 64;
      if (wid == 0) {
        const float mprev = mscan_prefix(CHS, pb, h, cseq - tb, lane);
        float B[NSUB + 1]; B[0] = 0.f; float Apre = -INFINITY, Aall = -INFINITY;
#pragma unroll
        for (int i = 0; i < NSUB; ++i) {
          const float bl = CHS[((cg0 + i) * 4 + h) * 2], al = CHS[((cg0 + i) * 4 + h) * 2 + 1];
          if (i < tb) Apre = fmaxf(Apre, al - B[i]);
          Aall = fmaxf(Aall, al - B[i]);
          B[i + 1] = B[i] + bl;
        }
        float Btb = 0.f;
#pragma unroll
        for (int i = 0; i < NSUB; ++i) if (i == tb) Btb = B[i];
        const float Mlast = fmaxf(mprev, Aall);
        const size_t o = (size_t)(row0 + lane) * 4 + h;
        const float bt = GB[o] + Btb, ut = GU[o] - Btb, at = fmaxf(Apre, GA[o] - Btb);
        const float Mt = fmaxf(mprev, at);
        sM[lane] = Mt;
        WINTER[o] = __expf(mprev - Mt);
        ENEGM[o] = __expf(-(bt + Mt));
        WUPD[o] = __expf(ut - Mlast);
#pragma unroll
        for (int i = 0; i < NSUB; ++i) if (i <= tb) su[i * 64 + lane] = GU[(size_t)((cg0 + i) * 64 + lane) * 4 + h] - B[i];
        if (lane == 0) {
          if (tb == 0) DECAY[uid] = __expf(mprev - Mlast);
          if (cseq == 127) p.out[O_MP + pb * 4 + h] = B[NSUB] + Mlast;
        }
      }
      __syncthreads();
      float dpart = 0.f;
      const int t = 32 * ti + l31;
      const float Mt = sM[t];
      for (int jj = 0; jj <= tb; ++jj) {
        bf16_t* swb = SWL + (size_t)((jj * 2 + ti) * 4) * 512;
        if (jj < tb || si <= ti) {
          f32x16 acc;
#pragma unroll
          for (int i = 0; i < 16; ++i) acc[i] = 0.f;
          const bf16_t* ka = KF + ((size_t)((cg0 + jj) * 4 + h) * 2 + si) * 32 * 512 + lane * 8;
          const bf16_t* qb = QF + ((size_t)(cg * 4 + h) * 2 + ti) * 32 * 512 + lane * 8;
#pragma unroll 1
          for (int kb = 0; kb < 2; ++kb) {
            u32x4 fa[16], fb[16];
#pragma unroll
            for (int i = 0; i < 16; ++i) { fa[i] = *(const u32x4*)(ka + (kb * 16 + i) * 512); fb[i] = *(const u32x4*)(qb + (kb * 16 + i) * 512); }
            __builtin_amdgcn_sched_barrier(0);
#pragma unroll
            for (int i = 0; i < 16; ++i) acc = MFMA32(as_bf16x8(fa[i]), as_bf16x8(fb[i]), acc);
            __builtin_amdgcn_sched_barrier(0);
          }
#pragma unroll
          for (int g = 0; g < 4; ++g) {
            float w4[4];
#pragma unroll
            for (int x = 0; x < 4; ++x) {
              const int s = 32 * si + 8 * g + 4 * hh + x;
              const float v = (jj < tb || s <= t) ? acc[4 * g + x] * __expf(su[jj * 64 + s] - Mt) : 0.f;
              w4[x] = v; dpart += v;
            }
            u32x2 o; o.x = cvt_pk_bf16(w4[0], w4[1]); o.y = cvt_pk_bf16(w4[2], w4[3]);
            *(u32x2*)(swb + (2 * si + (g >> 1)) * 512 + (l31 + 32 * (g & 1)) * 8 + 4 * hh) = o;
          }
        } else {
          u32x2 z; z.x = 0u; z.y = 0u;
#pragma unroll
          for (int g = 0; g < 4; ++g) *(u32x2*)(swb + (2 * si + (g >> 1)) * 512 + (l31 + 32 * (g & 1)) * 8 + 4 * hh) = z;
        }
      }
      dpart += __shfl_xor(dpart, 32);
      if (hh == 0) sden[si * 64 + t] = dpart;
      __syncthreads();
      if (tid < 64) DENI[(size_t)(row0 + tid) * 4 + h] = sden[tid] + sden[64 + tid];
#pragma unroll 1
      for (int eti = 0; eti < 4; ++eti) {
        const int et = wid + 4 * eti;
        f32x16 a0, a1;
#pragma unroll
        for (int i = 0; i < 16; ++i) { a0[i] = 0.f; a1[i] = 0.f; }
        u32x4 vfr[NSUB][4];
#pragma unroll
        for (int jj = 0; jj < NSUB; ++jj) {
          if (jj <= tb) {
            const bf16_t* vf = VF + ((((size_t)((cg0 + jj) * 4 + h) * 16 + et) * 4) * 64 + lane) * 8;
#pragma unroll
            for (int ks = 0; ks < 4; ++ks) vfr[jj][ks] = *(const u32x4*)(vf + ks * 512);
          }
        }
        __builtin_amdgcn_sched_barrier(0);
#pragma unroll
        for (int jj = 0; jj < NSUB; ++jj) {
          if (jj <= tb) {
            const bf16_t* sw = SWL + (size_t)(jj * 8) * 512 + lane * 8;
#pragma unroll
            for (int ks = 0; ks < 4; ++ks) {
              const bf16x8 v = as_bf16x8(vfr[jj][ks]);
              a0 = MFMA32(v, *(const bf16x8*)(sw + ks * 512), a0);
              a1 = MFMA32(v, *(const bf16x8*)(sw + (4 + ks) * 512), a1);
            }
          }
        }
        bf16_t* dst0 = NUMI + numidx(row0 + l31, h, et * 32) + 4 * hh;
        bf16_t* dst1 = NUMI + numidx(row0 + 32 + l31, h, et * 32) + 4 * hh;
#pragma unroll
        for (int g = 0; g < 4; ++g) {
          u32x2 o0; o0.x = cvt_pk_bf16(a0[4 * g], a0[4 * g + 1]); o0.y = cvt_pk_bf16(a0[4 * g + 2], a0[4 * g + 3]);
          u32x2 o1; o1.x = cvt_pk_bf16(a1[4 * g], a1[4 * g + 1]); o1.y = cvt_pk_bf16(a1[4 * g + 2], a1[4 * g + 3]);
          *(u32x2*)(dst0 + 8 * g) = o0;
          *(u32x2*)(dst1 + 8 * g) = o1;
        }
      }
    } else {
      const int sb = (uid - 1024) >> 2, row0 = NP + sb * 16, cg = row0 >> 6, r0 = (sb & 3) * 16, mts = r0 >> 5, r0t = r0 & 31, ksq = sb & 3;
      if (wid == 0) {
        const float mprev = p.in[4][uid - 1024];
        const bool valid = lane < 16;
        const size_t o = (size_t)(row0 + (valid ? lane : 0)) * 4 + h;
        const float bt = GB[o], ut = GU[o], at = GA[o];
        const float Mt = fmaxf(mprev, at);
        const float alast = __shfl(at, 15), blast = __shfl(bt, 15);
        const float Mlast = fmaxf(mprev, alast);
        sM[lane] = Mt; su[lane] = ut;
        if (valid) { WINTER[o] = __expf(mprev - Mt); ENEGM[o] = __expf(-(bt + Mt)); WUPD[o] = __expf(ut - Mlast); }
        if (lane == 0) { DECAY[uid] = __expf(mprev - Mlast); p.out[O_MS + (uid - 1024)] = blast + Mlast; }
      }
      __syncthreads();
      if (wid == 0) {
        f32x16 acc;
#pragma unroll
        for (int i = 0; i < 16; ++i) acc[i] = 0.f;
        const bf16_t* ka = KF + ((size_t)(cg * 4 + h) * 2 + mts) * 32 * 512 + lane * 8;
        const bf16_t* qb = QF + ((size_t)(cg * 4 + h) * 2 + mts) * 32 * 512 + lane * 8;
#pragma unroll 1
        for (int kb = 0; kb < 2; ++kb) {
          u32x4 fa[16], fb[16];
#pragma unroll
          for (int i = 0; i < 16; ++i) { fa[i] = *(const u32x4*)(ka + (kb * 16 + i) * 512); fb[i] = *(const u32x4*)(qb + (kb * 16 + i) * 512); }
          __builtin_amdgcn_sched_barrier(0);
#pragma unroll
          for (int i = 0; i < 16; ++i) acc = MFMA32(as_bf16x8(fa[i]), as_bf16x8(fb[i]), acc);
          __builtin_amdgcn_sched_barrier(0);
        }
        const int tl = l31 - r0t;
        const bool tv = tl >= 0 && tl < 16;
        const float Mt = sM[tv ? tl : 0];
        float dpart = 0.f;
#pragma unroll
        for (int g = 0; g < 4; ++g) {
          float w4[4];
#pragma unroll
          for (int x = 0; x < 4; ++x) {
            const int s = 8 * g + 4 * hh + x, sl = s - r0t;
            const bool ok = tv && sl >= 0 && s <= l31;
            const float v = ok ? acc[4 * g + x] * __expf(su[ok ? sl : 0] - Mt) : 0.f;
            w4[x] = v; dpart += v;
          }
          u32x2 o; o.x = cvt_pk_bf16(w4[0], w4[1]); o.y = cvt_pk_bf16(w4[2], w4[3]);
          *(u32x2*)(SWL + (g >> 1) * 512 + (l31 + 32 * (g & 1)) * 8 + 4 * hh) = o;
        }
        dpart += __shfl_xor(dpart, 32);
        if (hh == 0 && tv) DENI[(size_t)(row0 + tl) * 4 + h] = dpart;
      }
      __syncthreads();
      {
        const int tl = l31 - r0t;
        const bool tv = tl >= 0 && tl < 16;
        const bf16x8 swf = *(const bf16x8*)(SWL + (r0t >> 4) * 512 + lane * 8);
#pragma unroll 1
        for (int eti = 0; eti < 4; ++eti) {
          const int et = wid + 4 * eti;
          f32x16 a0;
#pragma unroll
          for (int i = 0; i < 16; ++i) a0[i] = 0.f;
          const bf16x8 v = as_bf16x8(*(const u32x4*)(VF + ((((size_t)(cg * 4 + h) * 16 + et) * 4 + ksq) * 64 + lane) * 8));
          a0 = MFMA32(v, swf, a0);
          if (tv) {
            bf16_t* dst = NUMI + numidx(row0 + tl, h, et * 32) + 4 * hh;
#pragma unroll
            for (int g = 0; g < 4; ++g) { u32x2 o0; o0.x = cvt_pk_bf16(a0[4 * g], a0[4 * g + 1]); o0.y = cvt_pk_bf16(a0[4 * g + 2], a0[4 * g + 3]); *(u32x2*)(dst + 8 * g) = o0; }
          }
        }
      }
    }
  }
}

DEV bf16x8 pack_acc(const f32x16& x, int s) {
  u32x4 pk;
  if (s == 0) { pk.x = cvt_pk_bf16(x[0], x[1]); pk.y = cvt_pk_bf16(x[2], x[3]); pk.z = cvt_pk_bf16(x[4], x[5]); pk.w = cvt_pk_bf16(x[6], x[7]); }
  else { pk.x = cvt_pk_bf16(x[8], x[9]); pk.y = cvt_pk_bf16(x[10], x[11]); pk.z = cvt_pk_bf16(x[12], x[13]); pk.w = cvt_pk_bf16(x[14], x[15]); }
  return as_bf16x8(pk);
}
DEV bf16x8 scale_frag(u32x4 raw, const float* w) {
  const f32x4 w0 = *(const f32x4*)(w), w1 = *(const f32x4*)(w + 4);
  u32x4 pk;
  pk.x = cvt_pk_bf16(bf_lo(raw.x) * w0.x, bf_hi(raw.x) * w0.y); pk.y = cvt_pk_bf16(bf_lo(raw.y) * w0.z, bf_hi(raw.y) * w0.w);
  pk.z = cvt_pk_bf16(bf_lo(raw.z) * w1.x, bf_hi(raw.z) * w1.y); pk.w = cvt_pk_bf16(bf_lo(raw.w) * w1.z, bf_hi(raw.w) * w1.w);
  return as_bf16x8(pk);
}

DEV void store_ctile(float* base, const f32x16 (&C)[4]) {
  float* cptr = base;
#pragma unroll
  for (int dt = 0; dt < 4; ++dt)
#pragma unroll
    for (int q = 0; q < 4; ++q) {
      cptr[0] = C[dt][4 * q]; cptr[512] = C[dt][4 * q + 1]; cptr[1024] = C[dt][4 * q + 2]; cptr[1536] = C[dt][4 * q + 3];
      cptr += 8 * 512; asm volatile("" : "+v"(cptr));
    }
}
DEV void load_ctile(const float* base, f32x16 (&C)[4]) {
  const float* cptr = base;
#pragma unroll
  for (int dt = 0; dt < 4; ++dt)
#pragma unroll
    for (int q = 0; q < 4; ++q) {
      C[dt][4 * q] = cptr[0]; C[dt][4 * q + 1] = cptr[512]; C[dt][4 * q + 2] = cptr[1024]; C[dt][4 * q + 3] = cptr[1536];
      cptr += 8 * 512; asm volatile("" : "+v"(cptr));
    }
}

constexpr unsigned BF_ONES = 0x3F803F80u;

DEV void lds_barrier() { asm volatile("s_waitcnt lgkmcnt(0)\n\ts_barrier" ::: "memory"); }

DEV void scan_prompt(const Params& p, char* smem, int pb, int h, int sl, unsigned* prog) {
  int tid_ = threadIdx.x; asm volatile("" : "+v"(tid_));
  const int tid = tid_, lane = tid & 63, wid = tid >> 6, l31 = lane & 31, hh = lane >> 5;
  float* red = (float*)smem;
  float* swi = red + 2 * 4 * 64 * 32;
  float* swu = swi + 256;
  const bf16_t* QF = (const bf16_t*)(p.ws + OFF_E); const bf16_t* VF = (const bf16_t*)(p.ws + OFF_F); const bf16_t* KTF = (const bf16_t*)(p.out + O_Y);
  bf16_t* NUM = (bf16_t*)(p.ws + OFF_B);
  const float* WINTER = (const float*)(p.ws + OFF_WINTER); const float* WUPD = (const float*)(p.ws + OFF_WUPD); const float* DECAY = (const float*)(p.ws + OFF_DECAY);
  const float* DENI = (const float*)(p.ws + OFF_DENI); const float* ENEGM = (const float*)(p.ws + OFF_ENEGM); float* DINV = (float*)(p.ws + OFF_DINV);
  const bool ns = sl == 16;
  const int slv = ns ? 0 : sl;
  f32x16 C[4];
#pragma unroll
  for (int dt = 0; dt < 4; ++dt)
#pragma unroll
    for (int i = 0; i < 16; ++i) C[dt][i] = 0.f;
  const int e0 = slv * 32;
  const u32x4 ones = {BF_ONES, BF_ONES, BF_ONES, BF_ONES};
  constexpr int RQ = 16;
  const int rt = tid >> 2, re8 = (tid & 3) * 8;
  float nwi, nwu, ndecay;
  { const size_t o = (size_t)(pb * 8192 + tid) * 4 + h; nwi = WINTER[o]; nwu = WUPD[o]; ndecay = DECAY[(pb * 128) * 4 + h]; }
  for (int sc = 0; sc < 128 / NSUB; ++sc) {
    const int cg0 = pb * 128 + sc * NSUB, rows = cg0 * 64;
    if (sl == 0 && tid == 0) __hip_atomic_store(prog + pb * 4 + h, (unsigned)sc, __ATOMIC_RELAXED, __HIP_MEMORY_SCOPE_AGENT);
    const bf16_t* qbase = QF + ((size_t)(cg0 * 4 + h) * 64 + 8 * wid) * 512 + lane * 8;
    u32x4 qf[RQ];
#pragma unroll
    for (int q = 0; q < RQ; ++q) qf[q] = *(const u32x4*)(qbase + (size_t)(q >> 4) * (4 * 64 * 512) + (size_t)(((q >> 3) & 1) * 32 + (q & 7)) * 512);
    lds_barrier();
    swi[tid] = nwi; swu[tid] = nwu;
    const float decay = ndecay;
    if (sc + 1 < 128 / NSUB) {
      const size_t o = (size_t)(rows + NSUB * 64 + tid) * 4 + h;
      nwi = WINTER[o]; nwu = WUPD[o]; ndecay = DECAY[(cg0 + NSUB) * 4 + h];
    }
    lds_barrier();
#pragma unroll
    for (int it = 0; it < 2 * NSUB; ++it) {
      const int j = it >> 1, mt = it & 1;
      const int cgj = cg0 + j;
      bf16_t* nump = NUM + numidx(cgj * 64 + rt, h, e0 + re8);
#pragma unroll
      for (int dt = 0; dt < 4; ++dt) asm volatile("" : "+v"(C[dt]));
      f32x16 ai;
#pragma unroll
      for (int i = 0; i < 16; ++i) ai[i] = 0.f;
#pragma unroll
      for (int kk = 0; kk < 8; ++kk) {
        const int q = it * 8 + kk;
        ai = MFMA32(as_bf16x8(qf[q % RQ]), pack_acc(C[kk >> 1], kk & 1), ai);
        if (q + RQ < 16 * NSUB) {
          const int qn = q + RQ;
          qf[q % RQ] = *(const u32x4*)(qbase + (size_t)(qn >> 4) * (4 * 64 * 512) + (size_t)(((qn >> 3) & 1) * 32 + (qn & 7)) * 512);
        }
      }
      float* rb = red + (j & 1) * (4 * 64 * 32);
      {
        float* rbt = rb + (wid * 64 + 4 * hh) * 32 + l31;
        const float* swij = swi + j * 64 + 4 * hh + 32 * mt;
        f32x4 w4[4];
#pragma unroll
        for (int q = 0; q < 4; ++q) w4[q] = *(const f32x4*)(swij + 8 * q);
#pragma unroll
        for (int i = 0; i < 16; ++i) {
          const int t0 = 32 * mt + (i & 3) + 8 * (i >> 2);
          rbt[t0 * 32] = w4[i >> 2][i & 3] * ai[i];
        }
      }
      if (mt == 1) {
        lds_barrier();
        f32x4 s0 = *(const f32x4*)(rb + rt * 32 + re8), s1 = *(const f32x4*)(rb + rt * 32 + re8 + 4);
#pragma unroll
        for (int w = 1; w < 4; ++w) { s0 += *(const f32x4*)(rb + (w * 64 + rt) * 32 + re8); s1 += *(const f32x4*)(rb + (w * 64 + rt) * 32 + re8 + 4); }
        if (!ns) {
          u32x4 o;
          o.x = cvt_pk_bf16(s0.x, s0.y); o.y = cvt_pk_bf16(s0.z, s0.w); o.z = cvt_pk_bf16(s1.x, s1.y); o.w = cvt_pk_bf16(s1.z, s1.w);
          *(u32x4*)nump = o;
        } else if (re8 == 0) {
          const size_t o = (size_t)(cgj * 64 + rt) * 4 + h;
          DINV[o] = s0.x;
        }
      }
    }
#pragma unroll
    for (int dt = 0; dt < 4; ++dt)
#pragma unroll
      for (int i = 0; i < 16; ++i) C[dt][i] *= decay;
    constexpr int PF = 4;
    u32x4 vb[PF], kb[PF][4];
    const bf16_t* vbase = VF + ((((size_t)(cg0 * 4 + h) * 16 + slv) * 4) * 64 + lane) * 8;
    const bf16_t* kbase = KTF + ((((size_t)(cg0 * 4 + h) * 16 + 4 * wid) * 4) * 64 + lane) * 8;
#pragma unroll
    for (int k16 = 0; k16 < PF; ++k16) {
      const size_t off = (size_t)(k16 >> 2) * (4 * 16 * 4 * 512) + (size_t)(k16 & 3) * 512;
      vb[k16] = ns ? ones : *(const u32x4*)(vbase + off);
#pragma unroll
      for (int dt = 0; dt < 4; ++dt) kb[k16][dt] = *(const u32x4*)(kbase + off + (size_t)dt * 4 * 512);
    }
#pragma unroll
    for (int k16 = 0; k16 < NSUB * 4; ++k16) {
      const bf16x8 b = scale_frag(vb[k16 % PF], swu + k16 * 16 + 8 * hh);
#pragma unroll
      for (int dt = 0; dt < 4; ++dt) C[dt] = MFMA32(as_bf16x8(kb[k16 % PF][dt]), b, C[dt]);
      if (k16 + PF < NSUB * 4) {
        const int kn = k16 + PF;
        const size_t off = (size_t)(kn >> 2) * (4 * 16 * 4 * 512) + (size_t)(kn & 3) * 512;
        vb[k16 % PF] = ns ? ones : *(const u32x4*)(vbase + off);
#pragma unroll
        for (int dt = 0; dt < 4; ++dt) kb[k16 % PF][dt] = *(const u32x4*)(kbase + off + (size_t)dt * 4 * 512);
      }
    }
  }
  if (!ns) store_ctile(p.out + O_CP + (size_t)(pb * 4 + h) * 262144 + (size_t)(128 * wid + 4 * hh) * 512 + e0 + l31, C);
  else if (l31 == 0) {
    float* nout = p.out + O_NP + (size_t)(pb * 4 + h) * 512 + 128 * wid + 4 * hh;
#pragma unroll
    for (int dt = 0; dt < 4; ++dt)
#pragma unroll
      for (int i = 0; i < 16; ++i) nout[32 * dt + (i & 3) + 8 * (i >> 2)] = C[dt][i];
  }
}

DEV void scan_sample(const Params& p_, char* smem, int sbh, int sl) {
  Params p = p_;
  asm volatile("" : "+s"(p.ws), "+s"(p.out), "+s"(p.in[2]), "+s"(p.in[3]));
  const int tid = threadIdx.x, lane = tid & 63, wid = tid >> 6, l31 = lane & 31, hh = lane >> 5;
  float* red = (float*)smem;
  float* swi = red + 2 * 4 * 64 * 32;
  float* swu = swi + 256;
  const bf16_t* QF = (const bf16_t*)(p.ws + OFF_E); const bf16_t* VF = (const bf16_t*)(p.ws + OFF_F); const bf16_t* KTF = (const bf16_t*)(p.out + O_Y);
  const bf16_t* SWF = (const bf16_t*)(p.ws + OFF_SW);
  bf16_t* NUM = (bf16_t*)(p.ws + OFF_B);
  const float* WINTER = (const float*)(p.ws + OFF_WINTER); const float* WUPD = (const float*)(p.ws + OFF_WUPD); const float* DECAY = (const float*)(p.ws + OFF_DECAY);
  const float* DENI = (const float*)(p.ws + OFF_DENI); const float* ENEGM = (const float*)(p.ws + OFF_ENEGM); float* DINV = (float*)(p.ws + OFF_DINV);
  const int sb = sbh >> 2, h = sbh & 3, row0 = NP + sb * 16, cg = row0 >> 6, r0 = (sb & 3) * 16, mts = r0 >> 5, r0t = r0 & 31, ksq = sb & 3;
  const bool ns = sl == 16;
  const int slv = ns ? 0 : sl;
  const int uid = 1024 + sbh, e0 = slv * 32;
  f32x16 C[4];
  if (!ns) load_ctile(p.in[2] + (size_t)sbh * 262144 + (size_t)(128 * wid + 4 * hh) * 512 + e0 + l31, C);
  else {
    const float* n0 = p.in[3] + (size_t)sbh * 512 + 128 * wid + 4 * hh;
#pragma unroll
    for (int dt = 0; dt < 4; ++dt)
#pragma unroll
      for (int i = 0; i < 16; ++i) C[dt][i] = n0[32 * dt + (i & 3) + 8 * (i >> 2)];
  }
  __syncthreads();
  if (tid < 32) { const int tl = tid - r0t; swi[tid] = (tl >= 0 && tl < 16) ? WINTER[(size_t)(row0 + tl) * 4 + h] : 0.f; }
  if (tid >= 64 && tid < 80) swu[tid - 64] = WUPD[(size_t)(row0 + tid - 64) * 4 + h];
  const float decay = DECAY[uid];
  f32x16 ai, aa;
#pragma unroll
  for (int i = 0; i < 16; ++i) { ai[i] = 0.f; aa[i] = 0.f; }
  const bf16_t* qa = QF + ((size_t)((cg * 4 + h) * 2 + mts) * 32 + 8 * wid) * 512 + lane * 8;
#pragma unroll
  for (int kk = 0; kk < 8; ++kk) {
    const bf16x8 a = as_bf16x8(*(const u32x4*)(qa + (size_t)kk * 512));
    ai = MFMA32(a, pack_acc(C[kk >> 1], kk & 1), ai);
  }
  u32x4 vraw = {BF_ONES, BF_ONES, BF_ONES, BF_ONES};
  if (!ns) vraw = *(const u32x4*)(VF + ((((size_t)(cg * 4 + h) * 16 + slv) * 4 + ksq) * 64 + lane) * 8);
  __syncthreads();
  {
    float* rbt = red + (wid * 32 + 4 * hh) * 32 + l31;
    const float* swij = swi + 4 * hh;
    f32x4 w4[4];
#pragma unroll
    for (int q = 0; q < 4; ++q) w4[q] = *(const f32x4*)(swij + 8 * q);
#pragma unroll
    for (int i = 0; i < 16; ++i) {
      const int t0 = (i & 3) + 8 * (i >> 2);
      rbt[t0 * 32] = aa[i] + w4[i >> 2][i & 3] * ai[i];
    }
  }
#pragma unroll
  for (int dt = 0; dt < 4; ++dt)
#pragma unroll
    for (int i = 0; i < 16; ++i) C[dt][i] *= decay;
  {
    const bf16x8 b = scale_frag(vraw, swu + 8 * hh);
    const bf16_t* ka = KTF + ((((size_t)(cg * 4 + h) * 16 + 4 * wid) * 4 + ksq) * 64 + lane) * 8;
#pragma unroll
    for (int dt = 0; dt < 4; ++dt) C[dt] = MFMA32(as_bf16x8(*(const u32x4*)(ka + (size_t)dt * 4 * 512)), b, C[dt]);
  }
  __syncthreads();
  if (tid < 64) {
    const int t = tid >> 2, e8 = (tid & 3) * 8, tr = r0t + t;
    f32x4 s0 = *(const f32x4*)(red + tr * 32 + e8), s1 = *(const f32x4*)(red + tr * 32 + e8 + 4);
#pragma unroll
    for (int w = 1; w < 4; ++w) { s0 += *(const f32x4*)(red + (w * 32 + tr) * 32 + e8); s1 += *(const f32x4*)(red + (w * 32 + tr) * 32 + e8 + 4); }
    if (!ns) {
      bf16_t* nump = NUM + numidx(row0 + t, h, e0 + e8);
      u32x4 o;
      o.x = cvt_pk_bf16(s0.x, s0.y); o.y = cvt_pk_bf16(s0.z, s0.w); o.z = cvt_pk_bf16(s1.x, s1.y); o.w = cvt_pk_bf16(s1.z, s1.w);
      *(u32x4*)nump = o;
    } else if (e8 == 0) {
      const size_t o = (size_t)(row0 + t) * 4 + h;
      DINV[o] = s0.x;
    }
  }
  if (!ns) store_ctile(p.out + O_CS + (size_t)sbh * 262144 + (size_t)(128 * wid + 4 * hh) * 512 + e0 + l31, C);
  else if (l31 == 0) {
    float* nout = p.out + O_NS + (size_t)sbh * 512 + 128 * wid + 4 * hh;
#pragma unroll
    for (int dt = 0; dt < 4; ++dt)
#pragma unroll
      for (int i = 0; i < 16; ++i) nout[32 * dt + (i & 3) + 8 * (i >> 2)] = C[dt][i];
  }
}

DEV unsigned hw_xcc_id() { return (unsigned)__builtin_amdgcn_s_getreg((3 << 11) | 20) & 0xFu; }

constexpr int NPF = 6;
constexpr int PF_AHEAD = 2;
DEV void scan_prefetch(const Params& p, int bh, int part, unsigned* prog, volatile int* flag) {
  const int tid = threadIdx.x, pb = bh >> 2, h = bh & 3;
  const bf16_t* QF = (const bf16_t*)(p.ws + OFF_E); const bf16_t* VF = (const bf16_t*)(p.ws + OFF_F); const bf16_t* KTF = (const bf16_t*)(p.out + O_Y);
  unsigned sink = 0u;
  for (int sc = 0; sc < 128 / NSUB; ++sc) {
    if (tid == 0) {
      unsigned spins = 0; int dead = 0;
      while ((int)__hip_atomic_load(prog + bh, __ATOMIC_RELAXED, __HIP_MEMORY_SCOPE_AGENT) + PF_AHEAD < sc) { __builtin_amdgcn_s_sleep(8); if (++spins > (1u << 15)) { dead = 1; break; } }
      flag[0] = dead;
    }
    __syncthreads();
    if (flag[0]) break;
    __syncthreads();
    const int cg0 = pb * 128 + sc * NSUB;
    for (int r = part; r < 3 * NSUB; r += NPF) {
      const int which = r / NSUB, j = r % NSUB;
      const bf16_t* base = (which == 0 ? QF : (which == 1 ? KTF : VF)) + (size_t)((cg0 + j) * 4 + h) * 32768;
      u32x4 v[16];
#pragma unroll
      for (int i = 0; i < 16; ++i) v[i] = *(const u32x4*)(base + (size_t)(i * 256 + tid) * 8);
#pragma unroll
      for (int i = 0; i < 16; ++i) sink ^= v[i].x ^ v[i].w;
    }
  }
  asm volatile("" :: "v"(sink));
}


DEV void scan_phase(const Params& p, char* smem) {
  const int tid = threadIdx.x, bid = blockIdx.x;
  unsigned* cnt = (unsigned*)(p.ws + OFF_BAR + 14336);
  volatile int* sunit = (volatile int*)(smem + 73728 - 16);
  constexpr int NSS = 128 * 17;
  int stage = 0, bh_try = 0;
  for (;;) {
    __syncthreads();
    if (tid == 0) {
      int kind = -1, a = 0, b = 0;
      for (;;) {
        if (stage == 0) {
          stage = 1;
          const unsigned x = hw_xcc_id() & 7u;
          if (bid < 256) { const unsigned t = atomicAdd(&cnt[x], 1u); if (t < 17u) { kind = 0; a = (int)x; b = (int)t; break; } }
          else { const unsigned t = atomicAdd(&cnt[8 + x], 1u); if (t < (unsigned)NPF) { kind = 2; a = (int)x; b = (int)t; break; } }
        } else if (stage == 1) {
          const unsigned u = atomicAdd(&cnt[16], 1u);
          if (u < (unsigned)NSS) { kind = 1; a = (int)u; break; }
          stage = 2;
        } else {
          if (bh_try >= 8) break;
          const unsigned t = atomicAdd(&cnt[bh_try], 1u);
          if (t < 17u) { kind = 0; a = bh_try; b = (int)t; break; }
          ++bh_try;
        }
      }
      sunit[0] = kind; sunit[1] = a; sunit[2] = b;
    }
    __syncthreads();
    const int kind = sunit[0], a = sunit[1], b = sunit[2];
    if (kind < 0) break;
    if (kind == 0) scan_prompt(p, smem, a >> 2, a & 3, b, cnt + 32);
    else if (kind == 1) scan_sample(p, smem, a / 17, a % 17);
    else scan_prefetch(p, a, b, cnt + 32, sunit + 3);
  }
}

DEV void hnorm_phase(const Params& p) {
  const int tid = threadIdx.x, lane = tid & 63, h = tid >> 6;
  const bf16_t* NUM = (const bf16_t*)(p.ws + OFF_B); const bf16_t* XC = (const bf16_t*)(p.ws + OFF_D); const bf16_t* Z2 = (const bf16_t*)(p.ws + OFF_C);
  const float* DINV = (const float*)(p.ws + OFF_DINV); const float* DENI = (const float*)(p.ws + OFF_DENI); const float* ENEGM = (const float*)(p.ws + OFF_ENEGM);
  bf16_t* A4 = (bf16_t*)(p.ws + OFF_F);
  const int ch = h * 512 + lane * 8;
  float hg[8], sk[8];
  { const f32x4 a = *(const f32x4*)(p.in[22] + ch), b = *(const f32x4*)(p.in[22] + ch + 4); hg[0] = a.x; hg[1] = a.y; hg[2] = a.z; hg[3] = a.w; hg[4] = b.x; hg[5] = b.y; hg[6] = b.z; hg[7] = b.w; }
  { const f32x4 a = *(const f32x4*)(p.in[23] + ch), b = *(const f32x4*)(p.in[23] + ch + 4); sk[0] = a.x; sk[1] = a.y; sk[2] = a.z; sk[3] = a.w; sk[4] = b.x; sk[5] = b.y; sk[6] = b.z; sk[7] = b.w; }
  const bf16_t* NUMI = (const bf16_t*)(p.ws + OFF_SW);
  int tok = blockIdx.x;
  float dinv_n = 0.f; u32x4 nr_n = {0u, 0u, 0u, 0u}, ni_n = nr_n, xr_n = nr_n, zr_n = nr_n;
  if (tok < T) {
    dinv_n = 1.f / fmaxf(fabsf(DENI[(size_t)tok * 4 + h] + DINV[(size_t)tok * 4 + h]), ENEGM[(size_t)tok * 4 + h]);
    nr_n = *(const u32x4*)(NUM + numidx(tok, h, lane * 8)); ni_n = *(const u32x4*)(NUMI + numidx(tok, h, lane * 8));
    xr_n = *(const u32x4*)(XC + (size_t)tok * E + ch); zr_n = *(const u32x4*)(Z2 + (size_t)tok * E + ch);
  }
  for (; tok < T; tok += gridDim.x) {
    const float dinv = dinv_n; const u32x4 nr = nr_n, ni = ni_n, xr = xr_n, zr = zr_n;
    const int tn = tok + gridDim.x;
    if (tn < T) {
      dinv_n = 1.f / fmaxf(fabsf(DENI[(size_t)tn * 4 + h] + DINV[(size_t)tn * 4 + h]), ENEGM[(size_t)tn * 4 + h]);
      nr_n = *(const u32x4*)(NUM + numidx(tn, h, lane * 8)); ni_n = *(const u32x4*)(NUMI + numidx(tn, h, lane * 8));
      xr_n = *(const u32x4*)(XC + (size_t)tn * E + ch); zr_n = *(const u32x4*)(Z2 + (size_t)tn * E + ch);
    }
    float v[8] = {(bf_lo(nr.x) + bf_lo(ni.x)) * dinv, (bf_hi(nr.x) + bf_hi(ni.x)) * dinv, (bf_lo(nr.y) + bf_lo(ni.y)) * dinv, (bf_hi(nr.y) + bf_hi(ni.y)) * dinv, (bf_lo(nr.z) + bf_lo(ni.z)) * dinv, (bf_hi(nr.z) + bf_hi(ni.z)) * dinv, (bf_lo(nr.w) + bf_lo(ni.w)) * dinv, (bf_hi(nr.w) + bf_hi(ni.w)) * dinv};
    const float xc[8] = {bf_lo(xr.x), bf_hi(xr.x), bf_lo(xr.y), bf_hi(xr.y), bf_lo(xr.z), bf_hi(xr.z), bf_lo(xr.w), bf_hi(xr.w)};
    const float z[8] = {bf_lo(zr.x), bf_hi(zr.x), bf_lo(zr.y), bf_hi(zr.y), bf_lo(zr.z), bf_hi(zr.z), bf_lo(zr.w), bf_hi(zr.w)};
    float s = 0.f;
#pragma unroll
    for (int j = 0; j < 8; ++j) s += v[j];
    const float mean = wave_sum(s) * (1.f / 512.f);
    float s2 = 0.f;
#pragma unroll
    for (int j = 0; j < 8; ++j) { v[j] -= mean; s2 += v[j] * v[j]; }
    const float rstd = rsqrtf(wave_sum(s2) * (1.f / 512.f) + 1e-5f);
    float o[8];
#pragma unroll
    for (int j = 0; j < 8; ++j) o[j] = (v[j] * rstd * hg[j] + sk[j] * xc[j]) * siluf_(z[j]);
    u32x4 ov; ov.x = cvt_pk_bf16(o[0], o[1]); ov.y = cvt_pk_bf16(o[2], o[3]); ov.z = cvt_pk_bf16(o[4], o[5]); ov.w = cvt_pk_bf16(o[6], o[7]);
    *(u32x4*)(A4 + (size_t)tok * E + ch) = ov;
  }
}

DEV void final_phase(const Params& p) {
  const int tid = threadIdx.x, lane = tid & 63, wid = tid >> 6;
  const float* SS2 = (const float*)(p.ws + OFF_SS2);
  const float* g = p.in[7];
  f32x4 gv[4];
#pragma unroll
  for (int j = 0; j < 4; ++j) gv[j] = *(const f32x4*)(g + j * 256 + lane * 4);
  for (int row = blockIdx.x * 4 + wid; row < T; row += gridDim.x * 4) {
    float s = 0.f;
#pragma unroll
    for (int j = 0; j < 4; ++j) { const f32x4 v = *(const f32x4*)(SS2 + (size_t)row * 16 + 4 * j); s += v.x + v.y + v.z + v.w; }
    const float r = rsqrtf(s * (1.f / DM) + 1e-6f);
    float* y = p.out + O_Y + (size_t)row * DM;
#pragma unroll
    for (int j = 0; j < 4; ++j) { f32x4 v = *(const f32x4*)(y + j * 256 + lane * 4); v.x *= r * gv[j].x; v.y *= r * gv[j].y; v.z *= r * gv[j].z; v.w *= r * gv[j].w; *(f32x4*)(y + j * 256 + lane * 4) = v; }
  }
}

#define XB_TMO      128
#define XB_XCNT(j)  (256  + 64 * (j))
#define XB_XSUB(j)  (1280 + 64 * (j))
#define XB_XGEN(j)  (2304 + 64 * (j))
#define XB_TOP      3328
#define XB_TOPGEN   3392
#define XCD_BAR_WORDS 3456
#define XB_SPIN_CAP (1u << 18)
#define LAS __attribute__((address_space(3)))
DEV unsigned xb_ld(unsigned* p)              { return __hip_atomic_load(p, __ATOMIC_RELAXED, __HIP_MEMORY_SCOPE_AGENT); }
DEV unsigned xb_add(unsigned* p, unsigned v) { return __hip_atomic_fetch_add(p, v, __ATOMIC_RELAXED, __HIP_MEMORY_SCOPE_AGENT); }
DEV unsigned xb_xcc_id() { return (unsigned)__builtin_amdgcn_s_getreg((3 << 11) | 20) & 0xFu; }
#define XB_SPIN(cond, bar) do { unsigned _sp = 0; while (cond) { __builtin_amdgcn_s_sleep(1); \
    if ((++_sp & 255u) == 0u) { if (xb_ld(&(bar)[XB_TMO])) break; if (_sp > XB_SPIN_CAP) { atomicAdd(&(bar)[XB_TMO], 1u); break; } } } } while (0)
struct XcdBarrier { unsigned* bar; unsigned x; volatile LAS unsigned* st; };
DEV XcdBarrier xcd_barrier_post(unsigned* bar, volatile LAS unsigned* st) {
  XcdBarrier b; b.bar = bar; b.x = xb_xcc_id(); b.st = st;
  if (threadIdx.x == 0) (void)xb_add(&bar[XB_XCNT(b.x)], 1u);
  return b;
}
DEV void xcd_barrier_complete(unsigned* bar, unsigned x, unsigned& nloc, unsigned& nx) {
  const unsigned G = gridDim.x * gridDim.y * gridDim.z;
  unsigned sum, cnt, mine, sp = 0u;
  for (;;) {
    sum = 0u; cnt = 0u; mine = 0u;
#pragma unroll
    for (unsigned j = 0; j < 16; ++j) { const unsigned c = xb_ld(&bar[XB_XCNT(j)]); sum += c; cnt += (c > 0u) ? 1u : 0u; mine = (j == x) ? c : mine; }
    if (sum == G) break;
    __builtin_amdgcn_s_sleep(1);
    if ((++sp & 255u) == 0u) { if (xb_ld(&bar[XB_TMO])) break; if (sp > XB_SPIN_CAP) { atomicAdd(&bar[XB_TMO], 1u); break; } }
  }
  nloc = mine > 0u ? mine : 1u; nx = cnt > 0u ? cnt : 1u;
}
DEV void xcd_barrier(const XcdBarrier& b) {
  asm volatile("s_waitcnt vmcnt(0)" ::: "memory");
  __syncthreads();
  if (threadIdx.x == 0) {
    unsigned* bar = b.bar;
    __builtin_amdgcn_s_waitcnt(0);
    unsigned nloc = b.st[0], nx = b.st[1];
    if (nloc == 0u) { xcd_barrier_complete(bar, b.x, nloc, nx); b.st[0] = nloc; b.st[1] = nx; }
    const unsigned old = xb_add(&bar[XB_XSUB(b.x)], 1u);
    const unsigned gen = old / nloc;
    if (old + 1u == (gen + 1u) * nloc) {
      __builtin_amdgcn_fence(__ATOMIC_RELEASE, "agent");
      asm volatile("s_waitcnt vmcnt(0)" ::: "memory");
      const unsigned og = xb_add(&bar[XB_TOP], 1u);
      const unsigned tg = og / nx;
      if (og + 1u == (tg + 1u) * nx) xb_add(&bar[XB_TOPGEN], 1u);
      else XB_SPIN(xb_ld(&bar[XB_TOPGEN]) == tg, bar);
      __builtin_amdgcn_fence(__ATOMIC_ACQUIRE, "agent");
      xb_add(&bar[XB_XGEN(b.x)], 1u);
      asm volatile("s_waitcnt vmcnt(0)" ::: "memory");
    } else {
      XB_SPIN(xb_ld(&bar[XB_XGEN(b.x)]) == gen, bar);
      __builtin_amdgcn_fence(__ATOMIC_ACQUIRE, "agent");
      asm volatile("s_waitcnt vmcnt(0)" ::: "memory");
    }
  }
  __syncthreads();
}

template <bool COOP>
__global__ void __launch_bounds__(NBLK, 2) fwd_kernel(Params p) {
  __shared__ __attribute__((aligned(16))) char smem[73728 + 16];
  XcdBarrier xb;
  if (COOP) {
    if (threadIdx.x == 0) *(uint4*)(smem + 73728) = make_uint4(0u, 0u, 0u, 0u);
    __syncthreads();
    xb = xcd_barrier_post((unsigned*)(p.ws + OFF_BAR), (volatile LAS unsigned*)(smem + 73728));
    if (p.ph_hi > 1000) cg::this_grid().sync();
  }
#ifndef REPMASK
#define REPMASK 0
#endif
#define PH_BEGIN(k) if (p.ph_lo <= (k) && (k) < p.ph_hi) for (int rep_ = 0; rep_ < (((REPMASK >> (k)) & 1) ? 2 : 1); ++rep_) { if (rep_) __syncthreads();
#define PH_END(k) } if (COOP) { if (p.ph_lo <= (k) && (k) + 1 < p.ph_hi) xcd_barrier(xb); }
  PH_BEGIN(0) phase0(p, smem); PH_END(0)
  PH_BEGIN(1) { Epi1 e{(const float*)(p.ws + OFF_RS0), (bf16_t*)(p.ws + OFF_A), (bf16_t*)(p.ws + OFF_B), (bf16_t*)(p.ws + OFF_C), (float*)(p.ws + OFF_VST)};
                gemm_phase((const bf16_t*)(p.ws + OFF_E), (const bf16_t*)(p.ws + OFF_W1), 6144, 1024, e, (bf16_t*)smem); } PH_END(1)
  PH_BEGIN(2) sgu_phase(p, smem); PH_END(2)
  PH_BEGIN(3) { EpiRes e{p.in[0], p.in[1], (float*)(p.ws + OFF_A), (bf16_t*)(p.ws + OFF_E + 34603008), (float*)(p.ws + OFF_SS1)};
                gemm_phase((const bf16_t*)(p.ws + OFF_D), (const bf16_t*)(p.ws + OFF_W2), 1024, 2048, e, (bf16_t*)smem, true); } PH_END(3)
  PH_BEGIN(4) { Epi3 e{(const float*)(p.ws + OFF_SS1), (bf16_t*)(p.ws + OFF_B), (bf16_t*)(p.ws + OFF_C)};
                gemm_phase((const bf16_t*)(p.ws + OFF_E + 34603008), (const bf16_t*)(p.ws + OFF_W3), 4096, 1024, e, (bf16_t*)smem); } PH_END(4)
  PH_BEGIN(5) conv_phase(p, smem); } if (COOP) xcd_barrier(xb); if (p.ph_lo <= 5 && 5 < p.ph_hi) { gate_phase(p, smem); PH_END(5)
  PH_BEGIN(6) intra_phase(p, smem); PH_END(6)
  PH_BEGIN(7) scan_phase(p, smem); PH_END(7)
  PH_BEGIN(8) hnorm_phase(p); PH_END(8)
  PH_BEGIN(9) { const float* x1 = (const float*)(p.ws + OFF_A);
                EpiRes e{x1, x1 + (size_t)NP * DM, p.out + O_Y, nullptr, (float*)(p.ws + OFF_SS2)};
                gemm_phase((const bf16_t*)(p.ws + OFF_F), (const bf16_t*)(p.ws + OFF_W4), 1024, 2048, e, (bf16_t*)smem, true); } PH_END(9)
  PH_BEGIN(10) final_phase(p); }
}

extern "C" void kernel_launch(void* const* d_in, const int* in_sizes, int n_in, void* d_out, int out_size, void* d_ws, size_t ws_size, hipStream_t stream) {
  static int grid = 0;
  if (grid == 0) {
    int dev = 0, cus = 0, per_cu = 0;
    hipGetDevice(&dev);
    hipDeviceGetAttribute(&cus, hipDeviceAttributeMultiprocessorCount, dev);
    hipOccupancyMaxActiveBlocksPerMultiprocessor(&per_cu, (const void*)fwd_kernel<true>, NBLK, 0);
    if (per_cu < 1) per_cu = 1;
    if (per_cu > 2) per_cu = 2;
    grid = cus * per_cu;
    if (ws_size < WS_END) { fprintf(stderr, "kernel_launch: workspace too small (%zu < %zu)\n", ws_size, (size_t)WS_END); grid = -1; }
  }
  if (grid < 0) return;
  Params p{};
  for (int i = 0; i < 25; ++i) p.in[i] = (const float*)d_in[i];
  p.out = (float*)d_out; p.ws = (char*)d_ws;
#if MULTI_LAUNCH
  for (int ph = 0; ph < NPHASE; ++ph) {
    p.ph_lo = ph; p.ph_hi = ph + 1;
    hipLaunchKernelGGL(fwd_kernel<false>, dim3(grid), dim3(NBLK), 0, stream, p);
  }
#else
  p.ph_lo = 0; p.ph_hi = NPHASE;
  (void)hipMemsetAsync((char*)d_ws + OFF_BAR, 0, 16384, stream);
  void* args[] = {&p};
  hipError_t e = hipLaunchCooperativeKernel((const void*)fwd_kernel<true>, dim3(grid), dim3(NBLK), args, 0, stream);
  if (e != hipSuccess) fprintf(stderr, "cooperative launch failed: %s (grid %d)\n", hipGetErrorString(e), grid);
#endif
}
```

```cpp
#include <hip/hip_runtime.h>
#include <hip/hip_cooperative_groups.h>
#include <cstdio>
#include <cstdint>
namespace cg = cooperative_groups;

#ifndef MULTI_LAUNCH
#define MULTI_LAUNCH 0
#endif

typedef unsigned short bf16_t;
typedef short bf16x8 __attribute__((ext_vector_type(8)));
typedef float f32x16 __attribute__((ext_vector_type(16)));
typedef float f32x4 __attribute__((ext_vector_type(4)));
typedef float f32x2 __attribute__((ext_vector_type(2)));
typedef unsigned u32x4 __attribute__((ext_vector_type(4)));
typedef unsigned u32x2 __attribute__((ext_vector_type(2)));
#define DEV __device__ __forceinline__
#define MFMA32(a, b, c) __builtin_amdgcn_mfma_f32_32x32x16_bf16((a), (b), (c), 0, 0, 0)

constexpr int T = 16896, NP = 16384, DM = 1024, E = 2048, NBLK = 256;
constexpr int NPHASE = 11;
constexpr size_t SLOT = 69206016;
constexpr size_t OFF_A = 0;
constexpr size_t OFF_B = SLOT;
constexpr size_t OFF_C = 2 * SLOT;
constexpr size_t OFF_D = 3 * SLOT;
constexpr size_t OFF_E = 4 * SLOT;
constexpr size_t OFF_F = 5 * SLOT;
constexpr size_t OFF_W1 = 6 * SLOT;
constexpr size_t OFF_W2 = OFF_W1 + 12582912;
constexpr size_t OFF_W3 = OFF_W2 + 4194304;
constexpr size_t OFF_W4 = OFF_W3 + 8388608;
constexpr size_t OFF_WM = OFF_W4 + 4194304;
constexpr size_t OFF_WMS = OFF_WM + 262144;
constexpr size_t OFF_SW = OFF_WMS + 262144;
constexpr size_t OFF_VST = OFF_SW + 69206016;
constexpr size_t OFF_RS0 = OFF_VST + 4325376;
constexpr size_t OFF_SS1 = OFF_RS0 + 67584;
constexpr size_t OFF_SS2 = OFF_SS1 + 1081344;
constexpr size_t OFF_GB = OFF_SS2 + 1081344;
constexpr size_t OFF_GU = OFF_GB + 270336;
constexpr size_t OFF_GA = OFF_GU + 270336;
constexpr size_t OFF_WINTER = OFF_GA + 270336;
constexpr size_t OFF_WUPD = OFF_WINTER + 270336;
constexpr size_t OFF_DENI = OFF_WUPD + 270336;
constexpr size_t OFF_ENEGM = OFF_DENI + 270336;
constexpr size_t OFF_DINV = OFF_ENEGM + 270336;
constexpr size_t OFF_CHS = OFF_DINV + 270336;
constexpr size_t OFF_DECAY = OFF_CHS + 8192;
constexpr size_t OFF_GP = OFF_DECAY + 8192;
constexpr size_t OFF_BAR = OFF_GP + 1081344;
constexpr size_t OFF_GT = OFF_BAR + 16384;
constexpr size_t WS_END = OFF_GT + 524288;
constexpr size_t O_Y = 0;
constexpr size_t O_SGUV = 17301504;
constexpr size_t O_CP = 18350080;
constexpr size_t O_NP = 20447232;
constexpr size_t O_MP = 20451328;
constexpr size_t O_CONVP = 20451336;
constexpr size_t O_CS = 20463624;
constexpr size_t O_NS = 54018056;
constexpr size_t O_MS = 54083592;
constexpr size_t O_CONVS = 54083720;

struct Params {
  const float* in[25];
  float* out;
  char* ws;
  int ph_lo, ph_hi;
};

typedef __bf16 bf16v2 __attribute__((ext_vector_type(2)));
DEV unsigned cvt_pk_bf16(float lo, float hi) { f32x2 v = {lo, hi}; bf16v2 b = __builtin_convertvector(v, bf16v2); return __builtin_bit_cast(unsigned, b); }
DEV float bf_lo(unsigned u) { return __uint_as_float(u << 16); }
DEV float bf_hi(unsigned u) { return __uint_as_float(u & 0xffff0000u); }
DEV float bf1(bf16_t b) { return __uint_as_float(((unsigned)b) << 16); }
DEV bf16_t f2bf(float x) { return (bf16_t)(cvt_pk_bf16(x, 0.f) & 0xffffu); }
DEV float sigmoidf_(float x) { return __builtin_amdgcn_rcpf(1.f + __builtin_amdgcn_exp2f(-1.4426950408889634f * x)); }
DEV float siluf_(float x) { return x * __builtin_amdgcn_rcpf(1.f + __builtin_amdgcn_exp2f(-1.4426950408889634f * x)); }
DEV float geluf_(float x) { const float x2 = x * x; const float t = x * (-2.302208198092545f - 0.10294324517f * x2); return x * __builtin_amdgcn_rcpf(1.f + __builtin_amdgcn_exp2f(t)); }
DEV int crow(int reg, int h) { return (reg & 3) + 8 * (reg >> 2) + 4 * h; }
DEV float wave_sum(float v) {
#pragma unroll
  for (int o = 1; o < 64; o <<= 1) v += __shfl_xor(v, o);
  return v;
}
DEV bf16x8 as_bf16x8(u32x4 v) { return __builtin_bit_cast(bf16x8, v); }

DEV void transpose_tile(const float* __restrict__ W, int K, int N, const float* __restrict__ gain, bf16_t* __restrict__ WT, int tile, float* scr) {
  const int tid = threadIdx.x;
  const int ntn = N / 64, kb = tile / ntn, nb = tile % ntn, k0 = kb * 64, n0 = nb * 64;
#pragma unroll
  for (int j = 0; j < 4; ++j) {
    const int c = tid + 256 * j, r = c >> 4, c4 = (c & 15) * 4;
    f32x4 v = *(const f32x4*)(W + (size_t)(k0 + r) * N + n0 + c4);
    const float g = gain ? gain[k0 + r] : 1.f;
    scr[r * 65 + c4 + 0] = v.x * g; scr[r * 65 + c4 + 1] = v.y * g; scr[r * 65 + c4 + 2] = v.z * g; scr[r * 65 + c4 + 3] = v.w * g;
  }
  __syncthreads();
  {
    const int n = tid >> 2, ks = (tid & 3) * 16;
    u32x4 o0, o1;
    const float* s = scr + ks * 65 + n;
    o0.x = cvt_pk_bf16(s[0 * 65], s[1 * 65]); o0.y = cvt_pk_bf16(s[2 * 65], s[3 * 65]); o0.z = cvt_pk_bf16(s[4 * 65], s[5 * 65]); o0.w = cvt_pk_bf16(s[6 * 65], s[7 * 65]);
    o1.x = cvt_pk_bf16(s[8 * 65], s[9 * 65]); o1.y = cvt_pk_bf16(s[10 * 65], s[11 * 65]); o1.z = cvt_pk_bf16(s[12 * 65], s[13 * 65]); o1.w = cvt_pk_bf16(s[14 * 65], s[15 * 65]);
    bf16_t* dst = WT + (size_t)(n0 + n) * K + k0 + ks;
    *(u32x4*)dst = o0; *(u32x4*)(dst + 8) = o1;
  }
  __syncthreads();
}

DEV void phase0(const Params& p, char* smem) {
  float* scr = (float*)smem;
  const int nb = gridDim.x, bid = blockIdx.x, tid = threadIdx.x;
  bf16_t* W1 = (bf16_t*)(p.ws + OFF_W1); bf16_t* W2 = (bf16_t*)(p.ws + OFF_W2); bf16_t* W3 = (bf16_t*)(p.ws + OFF_W3); bf16_t* W4 = (bf16_t*)(p.ws + OFF_W4);
  constexpr int T1 = 16 * 96, T2 = 32 * 16, T3 = 16 * 64, T4 = 32 * 16;
  for (int it = bid; it < T1 + T2 + T3 + T4; it += nb) {
    int r = it;
    if (r < T1) { transpose_tile(p.in[8], 1024, 6144, p.in[6], W1, r, scr); continue; } r -= T1;
    if (r < T2) { transpose_tile(p.in[13], 2048, 1024, nullptr, W2, r, scr); continue; } r -= T2;
    if (r < T3) { transpose_tile(p.in[14], 1024, 4096, p.in[6] + 1024, W3, r, scr); continue; } r -= T3;
    transpose_tile(p.in[24], 2048, 1024, nullptr, W4, r, scr);
  }
  {
    bf16_t* XB = (bf16_t*)(p.ws + OFF_E); float* RS0 = (float*)(p.ws + OFF_RS0);
    const int lane = tid & 63, wid = tid >> 6;
    for (int row = bid * 4 + wid; row < T; row += nb * 4) {
      const float* xr = row < NP ? p.in[0] + (size_t)row * DM : p.in[1] + (size_t)(row - NP) * DM;
      f32x4 v[4]; float ss = 0.f;
#pragma unroll
      for (int j = 0; j < 4; ++j) { v[j] = *(const f32x4*)(xr + j * 256 + lane * 4); ss += v[j].x * v[j].x + v[j].y * v[j].y + v[j].z * v[j].z + v[j].w * v[j].w; }
      ss = wave_sum(ss);
#pragma unroll
      for (int j = 0; j < 4; ++j) { u32x2 o; o.x = cvt_pk_bf16(v[j].x, v[j].y); o.y = cvt_pk_bf16(v[j].z, v[j].w); *(u32x2*)(XB + (size_t)row * DM + j * 256 + lane * 4) = o; }
      if (lane == 0) RS0[row] = rsqrtf(ss * (1.f / DM) + 1e-6f);
    }
  }
  {
    bf16_t* GT = (bf16_t*)(p.ws + OFF_GT);
    const float* wq = p.in[17]; const float* wk = p.in[18]; const float* wv = p.in[19]; const float* wgt = p.in[20];
    for (int idx = bid * 256 + tid; idx < 32 * 4096; idx += nb * 256) {
      const int j = idx >> 12, k = idx & 4095;
      bf16_t hi = 0, lo = 0;
      if (j < 8) {
        const int part = k >> 11, ch = k & 2047, nbk = ch >> 2, i = ch & 3, cb4 = ch & ~3;
        float g = 0.f;
#pragma unroll
        for (int o = 0; o < 4; ++o) {
          if (part == 0) g += wq[nbk * 16 + i * 4 + o] * wgt[(size_t)(cb4 + o) * 8 + j] + wk[nbk * 16 + i * 4 + o] * wgt[(size_t)(E + cb4 + o) * 8 + j];
          else g += wv[nbk * 16 + i * 4 + o] * wgt[(size_t)(2 * E + cb4 + o) * 8 + j];
        }
        hi = f2bf(g); lo = f2bf(g - bf1(hi));
      }
      GT[(size_t)j * 4096 + k] = hi; GT[(size_t)(32 + j) * 4096 + k] = lo;
    }
  }
  {
    bf16_t* WM = (bf16_t*)(p.ws + OFF_WM); bf16_t* WMS = (bf16_t*)(p.ws + OFF_WMS);
    const float* ws_ = p.in[11];
    for (int i = bid * 256 + tid; i < 8 * 128 * 128; i += nb * 256) {
      const int g = i >> 14, t = (i >> 7) & 127, s = i & 127;
      WM[i] = f2bf(s <= t ? ws_[i] : 0.f);
      const int tl = t & 15, sl = s & 15;
      WMS[i] = f2bf(((t >> 4) == (s >> 4) && sl <= tl) ? ws_[(g << 14) + tl * 128 + sl] : 0.f);
    }
  }
}

constexpr int LDS_ST = 72;
constexpr int TILE_E = 128 * LDS_ST;

constexpr int TILE_G = 128 * 64;

template <int MI, class Epi>
DEV void gemm_tile(const bf16_t* __restrict__ X, const bf16_t* __restrict__ W, const int K, const int row0, const int col0, const Epi& epi, bf16_t* sm) {
  int tid_ = threadIdx.x; asm volatile("" : "+v"(tid_));
  const int tid = tid_, lane = tid & 63, wid = tid >> 6, wr = wid >> 1, wc = wid & 1;
  const int l31 = lane & 31, hh = lane >> 5;
  bf16_t* sa = sm; bf16_t* sb = sm + 2 * TILE_G;
  f32x16 acc[MI][2];
#pragma unroll
  for (int a = 0; a < MI; ++a)
#pragma unroll
    for (int b = 0; b < 2; ++b)
#pragma unroll
      for (int i = 0; i < 16; ++i) acc[a][b][i] = 0.f;
  const int srow = wid * 8 + (lane >> 3);
  const int sc8 = ((lane & 7) ^ (((wid & 1) << 2) | (lane >> 4))) * 8;
  const bf16_t* xp = X + (size_t)(row0 + srow) * K + sc8;
  const bf16_t* wp = W + (size_t)(col0 + srow) * K + sc8;
  const int sdst = wid * 8 * 64 + lane * 8;
#define GEMM_STAGE(bufi, k0) do { _Pragma("unroll") for (int j = 0; j < 4; ++j) { \
      if (j < 2 * MI) __builtin_amdgcn_global_load_lds((const unsigned*)(xp + (size_t)(32 * j) * K + (k0)), (unsigned*)(sa + (bufi) * TILE_G + sdst + j * 2048), 16, 0, 0); \
      __builtin_amdgcn_global_load_lds((const unsigned*)(wp + (size_t)(32 * j) * K + (k0)), (unsigned*)(sb + (bufi) * TILE_G + sdst + j * 2048), 16, 0, 0); } } while (0)
  GEMM_STAGE(0, 0); GEMM_STAGE(1, 64);
  const int swz = (l31 >> 1) & 7;
  int koff[4];
#pragma unroll
  for (int kk = 0; kk < 4; ++kk) koff[kk] = ((2 * kk + hh) ^ swz) * 8;
  const int nk = K >> 6;
  for (int kt = 0; kt < nk; ++kt) {
    const int buf = kt & 1;
    if (kt + 1 < nk) { if (MI == 2) asm volatile("s_waitcnt vmcnt(8)" ::: "memory"); else asm volatile("s_waitcnt vmcnt(6)" ::: "memory"); }
    else asm volatile("s_waitcnt vmcnt(0)" ::: "memory");
    __builtin_amdgcn_s_barrier();
    const bf16_t* ca = sa + buf * TILE_G + (wr * 32 * MI + l31) * 64;
    const bf16_t* cb = sb + buf * TILE_G + (wc * 64 + l31) * 64;
    bf16x8 fa[4][MI], fb[4][2];
#pragma unroll
    for (int kk = 0; kk < 4; ++kk) {
#pragma unroll
      for (int mi = 0; mi < MI; ++mi) fa[kk][mi] = *(const bf16x8*)(ca + mi * 32 * 64 + koff[kk]);
      fb[kk][0] = *(const bf16x8*)(cb + koff[kk]); fb[kk][1] = *(const bf16x8*)(cb + 32 * 64 + koff[kk]);
    }
    asm volatile("s_waitcnt lgkmcnt(0)" ::: "memory");
    __builtin_amdgcn_s_barrier();
    if (kt + 2 < nk) GEMM_STAGE(buf, (kt + 2) * 64);
    __builtin_amdgcn_sched_barrier(0);
    __builtin_amdgcn_s_setprio(1);
#pragma unroll
    for (int kk = 0; kk < 4; ++kk)
#pragma unroll
      for (int mi = 0; mi < MI; ++mi) {
        acc[mi][0] = MFMA32(fb[kk][0], fa[kk][mi], acc[mi][0]); acc[mi][1] = MFMA32(fb[kk][1], fa[kk][mi], acc[mi][1]);
      }
    __builtin_amdgcn_s_setprio(0);
  }
#undef GEMM_STAGE
  epi.template run<MI>(acc, row0 + wr * 32 * MI, col0 + wc * 64, l31, hh);
}

template <class Epi>
DEV void gemm_phase(const bf16_t* X, const bf16_t* W, int N, int K, const Epi& epi, bf16_t* sm, bool half_tail = false) {
  const int ntn = N / 128, ntm = T / 128, nt = ntn * ntm;
  const int rem = nt % (int)gridDim.x;
  const int full_rows = (half_tail && rem > 0 && rem % ntn == 0) ? ntm - rem / ntn : ntm;
  const int G = gridDim.x;
  if (half_tail && ntn == 8 && (G & 7) == 0 && (full_rows & 1) == 0) {
    const int x = blockIdx.x & 7, cgrp = x & 3, rsub = x >> 2, nbx = G >> 3, nloc = (full_rows >> 1) * 2;
    for (int li = blockIdx.x >> 3; li < nloc; li += nbx) {
      const int tm = 2 * (li >> 1) + rsub, tn = 2 * cgrp + (li & 1);
      gemm_tile<2>(X, W, K, tm * 128, tn * 128, epi, sm);
    }
  } else {
    for (int t = blockIdx.x; t < full_rows * ntn; t += gridDim.x) {
      const int tm = t / ntn, tn = t % ntn;
      gemm_tile<2>(X, W, K, tm * 128, tn * 128, epi, sm);
    }
  }
  if (full_rows < ntm) {
    for (int t = blockIdx.x; t < (ntm - full_rows) * 2 * ntn; t += gridDim.x) {
      const int tmh = t / ntn, tn = t % ntn;
      gemm_tile<1>(X, W, K, full_rows * 128 + tmh * 64, tn * 128, epi, sm);
    }
  }
}

struct Epi1 {
  const float* rs0; bf16_t* U; bf16_t* VT; bf16_t* Z; float* VST;
  template <int MI> DEV void run(const f32x16 (&acc)[MI][2], int rbase, int cbase, int l31, int hh) const {
    const float rr[2] = {rs0[rbase + l31], rs0[rbase + 32 + l31]};
#pragma unroll
    for (int mi = 0; mi < MI; ++mi) {
      const int tok = rbase + mi * 32 + l31;
      const float r = rr[mi];
      if (cbase < 2048) {
#pragma unroll
        for (int ni = 0; ni < 2; ++ni)
#pragma unroll
          for (int g = 0; g < 4; ++g) {
            const int ch = cbase + ni * 32 + 8 * g + 4 * hh;
            u32x2 o; o.x = cvt_pk_bf16(geluf_(acc[mi][ni][4 * g] * r), geluf_(acc[mi][ni][4 * g + 1] * r));
            o.y = cvt_pk_bf16(geluf_(acc[mi][ni][4 * g + 2] * r), geluf_(acc[mi][ni][4 * g + 3] * r));
            *(u32x2*)(U + (size_t)tok * E + ch) = o;
          }
      } else if (cbase < 4096) {
        float s = 0.f, ss = 0.f;
#pragma unroll
        for (int ni = 0; ni < 2; ++ni)
#pragma unroll
          for (int i = 0; i < 16; ++i) {
            const int ch = cbase - 2048 + ni * 32 + crow(i, hh);
            const float v = geluf_(acc[mi][ni][i] * r);
            s += v; ss += v * v;
            VT[(size_t)ch * T + tok] = f2bf(v);
          }
        s += __shfl_xor(s, 32); ss += __shfl_xor(ss, 32);
        if (hh == 0) { f32x2 o; o.x = s; o.y = ss; *(f32x2*)(VST + ((size_t)tok * 32 + ((cbase - 2048) >> 6)) * 2) = o; }
      } else {
#pragma unroll
        for (int ni = 0; ni < 2; ++ni)
#pragma unroll
          for (int g = 0; g < 4; ++g) {
            const int ch = cbase - 4096 + ni * 32 + 8 * g + 4 * hh;
            u32x2 o; o.x = cvt_pk_bf16(acc[mi][ni][4 * g] * r, acc[mi][ni][4 * g + 1] * r);
            o.y = cvt_pk_bf16(acc[mi][ni][4 * g + 2] * r, acc[mi][ni][4 * g + 3] * r);
            *(u32x2*)(Z + (size_t)tok * E + ch) = o;
          }
      }
    }
  }
};

struct EpiRes {
  const float* res_p; const float* res_s;
  float* OUT; bf16_t* OUTB; float* SS;
  template <int MI> DEV void run(const f32x16 (&acc)[MI][2], int rbase, int cbase, int l31, int hh) const {
#pragma unroll
    for (int mi = 0; mi < MI; ++mi) {
      const int tok = rbase + mi * 32 + l31;
      const float* rp = tok < NP ? res_p + (size_t)tok * DM : res_s + (size_t)(tok - NP) * DM;
      f32x4 rva[2][4];
#pragma unroll
      for (int ni = 0; ni < 2; ++ni)
#pragma unroll
        for (int g = 0; g < 4; ++g) rva[ni][g] = *(const f32x4*)(rp + cbase + ni * 32 + 8 * g + 4 * hh);
      float ss = 0.f;
#pragma unroll
      for (int ni = 0; ni < 2; ++ni)
#pragma unroll
        for (int g = 0; g < 4; ++g) {
          const int ch = cbase + ni * 32 + 8 * g + 4 * hh;
          const f32x4 rv = rva[ni][g];
          f32x4 o; o.x = acc[mi][ni][4 * g] + rv.x; o.y = acc[mi][ni][4 * g + 1] + rv.y; o.z = acc[mi][ni][4 * g + 2] + rv.z; o.w = acc[mi][ni][4 * g + 3] + rv.w;
          ss += o.x * o.x + o.y * o.y + o.z * o.z + o.w * o.w;
          *(f32x4*)(OUT + (size_t)tok * DM + ch) = o;
          if (OUTB) { u32x2 b; b.x = cvt_pk_bf16(o.x, o.y); b.y = cvt_pk_bf16(o.z, o.w); *(u32x2*)(OUTB + (size_t)tok * DM + ch) = b; }
        }
      ss += __shfl_xor(ss, 32);
      if (hh == 0) SS[(size_t)tok * 16 + (cbase >> 6)] = ss;
    }
  }
};

struct Epi3 {
  const float* SS1; bf16_t* XM; bf16_t* Z2;
  template <int MI> DEV void run(const f32x16 (&acc)[MI][2], int rbase, int cbase, int l31, int hh) const {
    float sums[2];
#pragma unroll
    for (int mi = 0; mi < MI; ++mi) {
      float s = 0.f;
#pragma unroll
      for (int j = 0; j < 4; ++j) { const f32x4 v = *(const f32x4*)(SS1 + (size_t)(rbase + mi * 32 + l31) * 16 + 4 * j); s += v.x + v.y + v.z + v.w; }
      sums[mi] = s;
    }
#pragma unroll
    for (int mi = 0; mi < MI; ++mi) {
      const int tok = rbase + mi * 32 + l31;
      const float r = rsqrtf(sums[mi] * (1.f / DM) + 1e-6f);
      bf16_t* dst = cbase < 2048 ? XM + (size_t)tok * E + cbase : Z2 + (size_t)tok * E + cbase - 2048;
#pragma unroll
      for (int ni = 0; ni < 2; ++ni)
#pragma unroll
        for (int g = 0; g < 4; ++g) {
          u32x2 o; o.x = cvt_pk_bf16(acc[mi][ni][4 * g] * r, acc[mi][ni][4 * g + 1] * r);
          o.y = cvt_pk_bf16(acc[mi][ni][4 * g + 2] * r, acc[mi][ni][4 * g + 3] * r);
          *(u32x2*)(dst + ni * 32 + 8 * g + 4 * hh) = o;
        }
    }
  }
};

DEV void sgu_phase(const Params& p, char* smem) {
  const int tid = threadIdx.x, lane = tid & 63, wid = tid >> 6, l31 = lane & 31, hh = lane >> 5;
  float* smu = (float*)smem; float* srs = smu + 128;
  const bf16_t* U = (const bf16_t*)(p.ws + OFF_A); const bf16_t* VT = (const bf16_t*)(p.ws + OFF_B); const bf16_t* Z = (const bf16_t*)(p.ws + OFF_C);
  bf16_t* G = (bf16_t*)(p.ws + OFF_D);
  const float* VST = (const float*)(p.ws + OFF_VST);
  const float* lng = p.in[9]; const float* lnb = p.in[10]; const float* bs = p.in[12];
  for (int unit = blockIdx.x; unit < 132 * 8; unit += gridDim.x) {
    const int ci = unit >> 3, g = unit & 7, tok0 = ci * 128;
    const bool samp = ci >= 128;
    const bf16_t* WMg = (const bf16_t*)(p.ws + (samp ? OFF_WMS : OFF_WM)) + g * 16384;
    __syncthreads();
    if (tid < 128) {
      float s = 0.f, ss = 0.f;
      const f32x4* q = (const f32x4*)(VST + (size_t)(tok0 + tid) * 64);
#pragma unroll
      for (int j = 0; j < 16; ++j) { const f32x4 v = q[j]; s += v.x + v.z; ss += v.y + v.w; }
      const float mean = s * (1.f / E); const float var = ss * (1.f / E) - mean * mean;
      smu[tid] = mean; srs[tid] = rsqrtf(var + 1e-5f);
    }
    __syncthreads();
    const int cbase = g * 256 + wid * 64;
    bf16x8 af[2][8];
#pragma unroll
    for (int mi = 0; mi < 2; ++mi) {
      const int c = cbase + mi * 32 + l31;
      const float gg = lng[c], bb = lnb[c];
      u32x4 raws[8];
#pragma unroll
      for (int kk = 0; kk < 8; ++kk) raws[kk] = *(const u32x4*)(VT + (size_t)c * T + tok0 + kk * 16 + 8 * hh);
      __builtin_amdgcn_sched_barrier(0);
#pragma unroll
      for (int kk = 0; kk < 8; ++kk) {
        const int s0 = kk * 16 + 8 * hh;
        const u32x4 raw = raws[kk];
        const f32x4 m0 = *(const f32x4*)(smu + s0), m1 = *(const f32x4*)(smu + s0 + 4);
        const f32x4 r0 = *(const f32x4*)(srs + s0), r1 = *(const f32x4*)(srs + s0 + 4);
        float v[8];
        v[0] = (bf_lo(raw.x) - m0.x) * r0.x * gg + bb; v[1] = (bf_hi(raw.x) - m0.y) * r0.y * gg + bb;
        v[2] = (bf_lo(raw.y) - m0.z) * r0.z * gg + bb; v[3] = (bf_hi(raw.y) - m0.w) * r0.w * gg + bb;
        v[4] = (bf_lo(raw.z) - m1.x) * r1.x * gg + bb; v[5] = (bf_hi(raw.z) - m1.y) * r1.y * gg + bb;
        v[6] = (bf_lo(raw.w) - m1.z) * r1.z * gg + bb; v[7] = (bf_hi(raw.w) - m1.w) * r1.w * gg + bb;
        u32x4 pk; pk.x = cvt_pk_bf16(v[0], v[1]); pk.y = cvt_pk_bf16(v[2], v[3]); pk.z = cvt_pk_bf16(v[4], v[5]); pk.w = cvt_pk_bf16(v[6], v[7]);
        af[mi][kk] = as_bf16x8(pk);
        if (samp) {
          float* sv = p.out + O_SGUV + (size_t)(tok0 - NP + s0) * E + c;
#pragma unroll
          for (int j = 0; j < 8; ++j) sv[(size_t)j * E] = v[j];
        }
      }
    }
#pragma unroll
    for (int nt = 0; nt < 4; ++nt) {
      f32x16 acc[2];
#pragma unroll
      for (int i = 0; i < 16; ++i) { acc[0][i] = 0.f; acc[1][i] = 0.f; }
      const int tl = nt * 32 + l31;
      u32x4 bfrs[8];
#pragma unroll
      for (int kk = 0; kk < 8; ++kk) if (kk <= 2 * nt + 1) bfrs[kk] = *(const u32x4*)(WMg + tl * 128 + kk * 16 + 8 * hh);
      __builtin_amdgcn_sched_barrier(0);
#pragma unroll
      for (int kk = 0; kk < 8; ++kk) {
        if (kk <= 2 * nt + 1) {
          acc[0] = MFMA32(af[0][kk], as_bf16x8(bfrs[kk]), acc[0]);
          acc[1] = MFMA32(af[1][kk], as_bf16x8(bfrs[kk]), acc[1]);
        }
      }
      const int tok = tok0 + tl;
      const float bias = bs[g * 128 + (samp ? (tl & 15) : tl)];
      u32x2 uus[2][4], zzs[2][4];
#pragma unroll
      for (int mi = 0; mi < 2; ++mi)
#pragma unroll
        for (int q = 0; q < 4; ++q) {
          const int c = cbase + mi * 32 + 8 * q + 4 * hh;
          uus[mi][q] = *(const u32x2*)(U + (size_t)tok * E + c);
          zzs[mi][q] = *(const u32x2*)(Z + (size_t)tok * E + c);
        }
#pragma unroll
      for (int mi = 0; mi < 2; ++mi)
#pragma unroll
        for (int q = 0; q < 4; ++q) {
          const int c = cbase + mi * 32 + 8 * q + 4 * hh;
          const u32x2 uu = uus[mi][q];
          const u32x2 zz = zzs[mi][q];
          const float o0 = bf_lo(uu.x) * (acc[mi][4 * q] + bias) * siluf_(bf_lo(zz.x));
          const float o1 = bf_hi(uu.x) * (acc[mi][4 * q + 1] + bias) * siluf_(bf_hi(zz.x));
          const float o2 = bf_lo(uu.y) * (acc[mi][4 * q + 2] + bias) * siluf_(bf_lo(zz.y));
          const float o3 = bf_hi(uu.y) * (acc[mi][4 * q + 3] + bias) * siluf_(bf_hi(zz.y));
          u32x2 o; o.x = cvt_pk_bf16(o0, o1); o.y = cvt_pk_bf16(o2, o3);
          *(u32x2*)(G + (size_t)tok * E + c) = o;
        }
    }
  }
}

DEV int perm4(int g) { return ((g & 1) << 1) | (g >> 1); }

struct ConvHist { float x1[4], x2[4], x3[4]; };
DEV void conv_hist_init(ConvHist& H, const bf16_t* XM, const float* conv0, int t, int tt, int pos, bool samp, int ch) {
  if (pos == 0) {
    if (samp) {
      const float* c0 = conv0 + (size_t)((t - NP) >> 4) * 3 * E + ch;
      const f32x4 a = *(const f32x4*)(c0), b = *(const f32x4*)(c0 + E), c = *(const f32x4*)(c0 + 2 * E);
      H.x3[0] = a.x; H.x3[1] = a.y; H.x3[2] = a.z; H.x3[3] = a.w; H.x2[0] = b.x; H.x2[1] = b.y; H.x2[2] = b.z; H.x2[3] = b.w; H.x1[0] = c.x; H.x1[1] = c.y; H.x1[2] = c.z; H.x1[3] = c.w;
    } else {
#pragma unroll
      for (int i = 0; i < 4; ++i) { H.x1[i] = 0.f; H.x2[i] = 0.f; H.x3[i] = 0.f; }
    }
  } else if (tt == 0) {
    const u32x2 a = *(const u32x2*)(XM + (size_t)(t - 1) * E + ch), b = *(const u32x2*)(XM + (size_t)(t - 2) * E + ch), c = *(const u32x2*)(XM + (size_t)(t - 3) * E + ch);
    H.x1[0] = bf_lo(a.x); H.x1[1] = bf_hi(a.x); H.x1[2] = bf_lo(a.y); H.x1[3] = bf_hi(a.y);
    H.x2[0] = bf_lo(b.x); H.x2[1] = bf_hi(b.x); H.x2[2] = bf_lo(b.y); H.x2[3] = bf_hi(b.y);
    H.x3[0] = bf_lo(c.x); H.x3[1] = bf_hi(c.x); H.x3[2] = bf_lo(c.y); H.x3[3] = bf_hi(c.y);
  }
}

DEV float reduce16(float (&r16)[16], int lane) {
#pragma unroll
  for (int i = 0; i < 8; ++i) { const bool up = lane & 8; const float send = up ? r16[i] : r16[i + 8]; const float keep = up ? r16[i + 8] : r16[i]; r16[i] = keep + __shfl_xor(send, 8); }
#pragma unroll
  for (int i = 0; i < 4; ++i) { const bool up = lane & 4; const float send = up ? r16[i] : r16[i + 4]; const float keep = up ? r16[i + 4] : r16[i]; r16[i] = keep + __shfl_xor(send, 4); }
#pragma unroll
  for (int i = 0; i < 2; ++i) { const bool up = lane & 2; const float send = up ? r16[i] : r16[i + 2]; const float keep = up ? r16[i + 2] : r16[i]; r16[i] = keep + __shfl_xor(send, 2); }
  { const bool up = lane & 1; const float send = up ? r16[0] : r16[1]; const float keep = up ? r16[1] : r16[0]; r16[0] = keep + __shfl_xor(send, 1); }
  float tot = r16[0];
  tot += __shfl_xor(tot, 16); tot += __shfl_xor(tot, 32);
  return tot;
}

DEV void conv_phase(const Params& p, char* smem) {
  const int tid = threadIdx.x;
  const bf16_t* XM = (const bf16_t*)(p.ws + OFF_B);
  bf16_t* XC = (bf16_t*)(p.ws + OFF_D); bf16_t* QF = (bf16_t*)(p.ws + OFF_E); bf16_t* VF = (bf16_t*)(p.ws + OFF_F);
  bf16_t* KF = (bf16_t*)(p.out + O_CS); bf16_t* KTF = (bf16_t*)(p.out + O_Y);
  const float* conv0 = p.in[5]; const float* convw = p.in[15]; const float* convb = p.in[16];
  const float* wq = p.in[17]; const float* wk = p.in[18]; const float* wv = p.in[19];
  const float kscale = 0.04419417382415922f;
  bf16_t* QS = (bf16_t*)(smem + 4096); bf16_t* KS = QS + 128 * 136;
  for (int unit = blockIdx.x; unit < (T / 16) * 2; unit += gridDim.x) {
    const int hf = unit & 1, tok0 = (unit >> 1) * 16, cg = tok0 >> 6, tt0 = tok0 & 63;
    const bool samp = tok0 >= NP;
    const int nb = hf * 256 + tid, ch = nb * 4, h = nb >> 7, nl = nb & 127;
    const int pd = (nl & ~3) * 4 + perm4(nl & 3) * 4, kstep = pd >> 4, hhq = (pd >> 3) & 1, j0 = pd & 7;
    float cw[4][4], cb[4], q_w[4][4], k_w[4][4], v_w[4][4];
#pragma unroll
    for (int j = 0; j < 4; ++j) { const f32x4 v = *(const f32x4*)(convw + j * E + ch); cw[j][0] = v.x; cw[j][1] = v.y; cw[j][2] = v.z; cw[j][3] = v.w; }
    { const f32x4 v = *(const f32x4*)(convb + ch); cb[0] = v.x; cb[1] = v.y; cb[2] = v.z; cb[3] = v.w; }
#pragma unroll
    for (int i = 0; i < 4; ++i) {
      const f32x4 a = *(const f32x4*)(wq + nb * 16 + i * 4), b = *(const f32x4*)(wk + nb * 16 + i * 4), c = *(const f32x4*)(wv + nb * 16 + i * 4);
      q_w[i][0] = a.x; q_w[i][1] = a.y; q_w[i][2] = a.z; q_w[i][3] = a.w;
      k_w[i][0] = b.x * kscale; k_w[i][1] = b.y * kscale; k_w[i][2] = b.z * kscale; k_w[i][3] = b.w * kscale;
      v_w[i][0] = c.x; v_w[i][1] = c.y; v_w[i][2] = c.z; v_w[i][3] = c.w;
    }
    u32x2 xrow[16];
#pragma unroll
    for (int i = 0; i < 16; ++i) xrow[i] = *(const u32x2*)(XM + (size_t)(tok0 + i) * E + ch);
    __syncthreads();
    ConvHist H;
    const int srun = (((tid >> 7) * 32 + kstep) * 2 + hhq) * 136 + j0;
#pragma unroll
    for (int tb8 = 0; tb8 < 2; ++tb8) {
      unsigned kacc[4][4], vacc[4][4];
#pragma unroll
      for (int pr = 0; pr < 4; ++pr) {
        float kq[2][4], vq[2][4];
#pragma unroll
        for (int u = 0; u < 2; ++u) {
          const int ttl = tb8 * 8 + pr * 2 + u, t = tok0 + ttl;
          const int pos = samp ? ttl : (t & 8191);
          conv_hist_init(H, XM, conv0, t, ttl, pos, samp, ch);
          const u32x2 xr = xrow[ttl];
          float x0[4] = {bf_lo(xr.x), bf_hi(xr.x), bf_lo(xr.y), bf_hi(xr.y)};
          float xc[4];
#pragma unroll
          for (int i = 0; i < 4; ++i) xc[i] = siluf_(cb[i] + cw[0][i] * H.x3[i] + cw[1][i] * H.x2[i] + cw[2][i] * H.x1[i] + cw[3][i] * x0[i]);
          float qv[4];
#pragma unroll
          for (int o = 0; o < 4; ++o) {
            qv[o] = xc[0] * q_w[0][o] + xc[1] * q_w[1][o] + xc[2] * q_w[2][o] + xc[3] * q_w[3][o];
            kq[u][o] = xc[0] * k_w[0][o] + xc[1] * k_w[1][o] + xc[2] * k_w[2][o] + xc[3] * k_w[3][o];
            vq[u][o] = x0[0] * v_w[0][o] + x0[1] * v_w[1][o] + x0[2] * v_w[2][o] + x0[3] * v_w[3][o];
          }
          { u32x2 o; o.x = cvt_pk_bf16(xc[0], xc[1]); o.y = cvt_pk_bf16(xc[2], xc[3]); *(u32x2*)(XC + (size_t)t * E + ch) = o; }
          { u32x2 o; o.x = cvt_pk_bf16(qv[0], qv[1]); o.y = cvt_pk_bf16(qv[2], qv[3]); *(u32x2*)(QS + srun + ttl * 8) = o; }
          { u32x2 o; o.x = cvt_pk_bf16(kq[u][0], kq[u][1]); o.y = cvt_pk_bf16(kq[u][2], kq[u][3]); *(u32x2*)(KS + srun + ttl * 8) = o; }
          if (samp) { if (pos >= 13) { f32x4 o; o.x = x0[0]; o.y = x0[1]; o.z = x0[2]; o.w = x0[3]; *(f32x4*)(p.out + O_CONVS + ((size_t)((t - NP) >> 4) * 3 + (pos - 13)) * E + ch) = o; } }
          else if (pos >= 8189) { f32x4 o; o.x = x0[0]; o.y = x0[1]; o.z = x0[2]; o.w = x0[3]; *(f32x4*)(p.out + O_CONVP + ((size_t)(t >> 13) * 3 + (pos - 8189)) * E + ch) = o; }
#pragma unroll
          for (int i = 0; i < 4; ++i) { H.x3[i] = H.x2[i]; H.x2[i] = H.x1[i]; H.x1[i] = x0[i]; }
        }
#pragma unroll
        for (int o = 0; o < 4; ++o) { kacc[o][pr] = cvt_pk_bf16(kq[0][o], kq[1][o]); vacc[o][pr] = cvt_pk_bf16(vq[0][o], vq[1][o]); }
      }
      const int tg = tt0 + tb8 * 8, ks = tg >> 4, hht = (tg >> 3) & 1;
#pragma unroll
      for (int o = 0; o < 4; ++o) {
        const int d = nl * 4 + o;
        const size_t fo = ((((size_t)(cg * 4 + h) * 16 + (d >> 5)) * 4 + ks) * 64 + (d & 31) + 32 * hht) * 8;
        u32x4 kk_; kk_.x = kacc[o][0]; kk_.y = kacc[o][1]; kk_.z = kacc[o][2]; kk_.w = kacc[o][3];
        u32x4 vv_; vv_.x = vacc[o][0]; vv_.y = vacc[o][1]; vv_.z = vacc[o][2]; vv_.w = vacc[o][3];
        *(u32x4*)(KTF + fo) = kk_;
        *(u32x4*)(VF + fo) = vv_;
      }
    }
    __syncthreads();
#pragma unroll 2
    for (int i = 0; i < 8; ++i) {
      const int pc = i * 256 + tid, run = pc >> 4, l16 = pc & 15;
      const int hl = run >> 6, ks_ = (run >> 1) & 31, hq_ = run & 1;
      const size_t dst = ((size_t)((cg * 4 + 2 * hf + hl) * 64 + (tt0 >> 5) * 32 + ks_)) * 512 + ((tt0 & 31) + l16 + 32 * hq_) * 8;
      *(u32x4*)(QF + dst) = *(const u32x4*)(QS + run * 136 + l16 * 8);
      *(u32x4*)(KF + dst) = *(const u32x4*)(KS + run * 136 + l16 * 8);
    }
  }
}

DEV void gate_phase(const Params& p, char* smem) {
  const int tid = threadIdx.x, lane = tid & 63, wid = tid >> 6, l31 = lane & 31, hh = lane >> 5;
  float* sig = (float*)smem; float* slf = sig + 256;
  float* red = (float*)(smem + 2048);
  const bf16_t* XMb = (const bf16_t*)(p.ws + OFF_B); const bf16_t* XCb = (const bf16_t*)(p.ws + OFF_D);
  const bf16_t* GT = (const bf16_t*)(p.ws + OFF_GT);
  const float* bgt = p.in[21];
  float* GB = (float*)(p.ws + OFF_GB); float* GU = (float*)(p.ws + OFF_GU); float* GA = (float*)(p.ws + OFF_GA); float* CHS = (float*)(p.ws + OFF_CHS);
  for (int unit = blockIdx.x; unit < T / 64; unit += gridDim.x) {
    const int tok0 = unit * 64;
    const bool samp = tok0 >= NP;
    __syncthreads();
    {
      bf16_t* slab = (bf16_t*)smem;
      f32x16 a0, a1;
#pragma unroll
      for (int i = 0; i < 16; ++i) { a0[i] = 0.f; a1[i] = 0.f; }
      const int lrow = tid >> 5, lc8 = (tid & 31) * 8;
      const bf16_t* gxc = XCb + (size_t)(tok0 + lrow) * E + lc8;
      const bf16_t* gxm = XMb + (size_t)(tok0 + lrow) * E + lc8;
      const bf16_t* gtp = GT + (size_t)(l31 < 8 ? l31 : 8) * 4096 + wid * 64 + 8 * hh;
      u32x4 ar[8], bcur[8], bnxt[8];
#pragma unroll
      for (int i = 0; i < 8; ++i) ar[i] = *(const u32x4*)(gxc + (size_t)(8 * i) * E);
#pragma unroll
      for (int i = 0; i < 4; ++i) { bcur[i] = *(const u32x4*)(gtp + i * 16); bcur[4 + i] = *(const u32x4*)(gtp + (size_t)32 * 4096 + i * 16); }
#pragma unroll
      for (int i = 0; i < 8; ++i) *(u32x4*)(slab + (lrow + 8 * i) * 264 + lc8) = ar[i];
      __syncthreads();
#pragma unroll 1
      for (int s = 0; s < 16; ++s) {
        const int buf = s & 1;
        if (s + 1 < 16) {
          const bf16_t* g = ((s + 1) < 8 ? gxc : gxm) + ((s + 1) & 7) * 256;
#pragma unroll
          for (int i = 0; i < 8; ++i) ar[i] = *(const u32x4*)(g + (size_t)(8 * i) * E);
#pragma unroll
          for (int i = 0; i < 4; ++i) { bnxt[i] = *(const u32x4*)(gtp + (s + 1) * 256 + i * 16); bnxt[4 + i] = *(const u32x4*)(gtp + (size_t)32 * 4096 + (s + 1) * 256 + i * 16); }
        }
        const bf16_t* sb0 = slab + buf * (64 * 264) + l31 * 264 + wid * 64 + 8 * hh;
#pragma unroll
        for (int i = 0; i < 4; ++i) {
          const bf16x8 x0 = *(const bf16x8*)(sb0 + i * 16), x1 = *(const bf16x8*)(sb0 + 32 * 264 + i * 16);
          a0 = MFMA32(x0, as_bf16x8(bcur[i]), a0); a1 = MFMA32(x1, as_bf16x8(bcur[i]), a1);
          a0 = MFMA32(x0, as_bf16x8(bcur[4 + i]), a0); a1 = MFMA32(x1, as_bf16x8(bcur[4 + i]), a1);
        }
        if (s + 1 < 16) {
#pragma unroll
          for (int i = 0; i < 8; ++i) *(u32x4*)(slab + (buf ^ 1) * (64 * 264) + (lrow + 8 * i) * 264 + lc8) = ar[i];
#pragma unroll
          for (int i = 0; i < 8; ++i) bcur[i] = bnxt[i];
        }
        __syncthreads();
      }
      if (l31 < 8) {
        float* rb = red + (wid * 64 + 4 * hh) * 8 + l31;
#pragma unroll
        for (int i = 0; i < 16; ++i) {
          const int t0 = (i & 3) + 8 * (i >> 2);
          rb[t0 * 8] = a0[i]; rb[(32 + t0) * 8] = a1[i];
        }
      }
    }
    __syncthreads();
    {
      const int tt = tid >> 2, h = tid & 3;
      float gi = bgt[h], gf = bgt[4 + h];
#pragma unroll
      for (int w = 0; w < 4; ++w) { gi += red[(w * 64 + tt) * 8 + h]; gf += red[(w * 64 + tt) * 8 + 4 + h]; }
      sig[h * 64 + tt] = gi;
      slf[h * 64 + tt] = fminf(gf, 0.f) - log1pf(__expf(-fabsf(gf)));
    }
    __syncthreads();
    {
      const int seglen = samp ? 16 : 64, nseg = 64 / seglen;
      if (tid < 4 * nseg) {
        const int h = tid & 3, sg = tid >> 2;
        float b = 0.f, a = -INFINITY;
        for (int j = 0; j < seglen; ++j) {
          const int tt = sg * seglen + j;
          b += slf[h * 64 + tt];
          const float u = sig[h * 64 + tt] - b;
          a = fmaxf(a, u);
          const size_t o = (size_t)(tok0 + tt) * 4 + h;
          GB[o] = b; GU[o] = u; GA[o] = a;
        }
        if (!samp) { CHS[(unit * 4 + h) * 2] = b; CHS[(unit * 4 + h) * 2 + 1] = a; }
      }
    }
  }
}

DEV size_t numidx(int row, int h, int e) { return ((((size_t)(row >> 1) * 4 + h) * 16 + (e >> 5)) * 2 + (row & 1)) * 32 + (e & 31); }

DEV u32x4 coherent_load16(const bf16_t* ptr) {
  unsigned* q = (unsigned*)ptr; u32x4 r;
  r.x = __hip_atomic_load(q, __ATOMIC_RELAXED, __HIP_MEMORY_SCOPE_AGENT); r.y = __hip_atomic_load(q + 1, __ATOMIC_RELAXED, __HIP_MEMORY_SCOPE_AGENT);
  r.z = __hip_atomic_load(q + 2, __ATOMIC_RELAXED, __HIP_MEMORY_SCOPE_AGENT); r.w = __hip_atomic_load(q + 3, __ATOMIC_RELAXED, __HIP_MEMORY_SCOPE_AGENT);
  return r;
}

constexpr int NSUB = 4;

DEV float mscan_prefix(const float* CHS, int pb, int h, int c, int lane) {
  float P[2], Q[2];
#pragma unroll
  for (int j = 0; j < 2; ++j) {
    const int i = 2 * lane + j;
    if (i < c) { const float bl = CHS[((pb * 128 + i) * 4 + h) * 2], al = CHS[((pb * 128 + i) * 4 + h) * 2 + 1]; P[j] = bl; Q[j] = al + bl; }
    else { P[j] = 0.f; Q[j] = -INFINITY; }
  }
  float Pc = P[0] + P[1], Qc = fmaxf(Q[0] + P[1], Q[1]);
#pragma unroll
  for (int off = 1; off < 64; off <<= 1) {
    const float Po = __shfl_xor(Pc, off), Qo = __shfl_xor(Qc, off);
    if (lane & off) { Qc = fmaxf(Qo + Pc, Qc); Pc = Po + Pc; }
    else { Qc = fmaxf(Qc + Po, Qo); Pc = Pc + Po; }
  }
  return fmaxf(Pc, Qc);
}

DEV void intra_phase(const Params& p, char* smem) {
  const int tid = threadIdx.x, lane = tid & 63, wid = tid >> 6, l31 = lane & 31, hh = lane >> 5;
  float* su = (float*)smem;
  float* sM = su + NSUB * 64;
  float* sden = sM + 64;
  bf16_t* SWL = (bf16_t*)(smem + 2048);
  const bf16_t* QF = (const bf16_t*)(p.ws + OFF_E); const bf16_t* KF = (const bf16_t*)(p.out + O_CS); const bf16_t* VF = (const bf16_t*)(p.ws + OFF_F);
  bf16_t* NUMI = (bf16_t*)(p.ws + OFF_SW);
  const float* GB = (const float*)(p.ws + OFF_GB); const float* GU = (const float*)(p.ws + OFF_GU); const float* GA = (const float*)(p.ws + OFF_GA);
  const float* CHS = (const float*)(p.ws + OFF_CHS);
  float* WINTER = (float*)(p.ws + OFF_WINTER); float* WUPD = (float*)(p.ws + OFF_WUPD); float* DENI = (float*)(p.ws + OFF_DENI); float* ENEGM = (float*)(p.ws + OFF_ENEGM);
  float* DECAY = (float*)(p.ws + OFF_DECAY);
  const int si = wid >> 1, ti = wid & 1;
  for (int u0 = blockIdx.x; u0 < 1152; u0 += gridDim.x) {
    const int uid = (u0 >= 512 && u0 < 1024) ? (u0 ^ 12) : u0;
    const bool samp = uid >= 1024;
    const int h = uid & 3;
    __syncthreads();
    if (!samp) {
      const int cg = uid >> 2, pb = cg >> 7, cseq = cg & 127, tb = cseq & (NSUB - 1), cg0 = cg - tb, row0 = cg * 64;
      if (wid == 0) {
        const float mprev = mscan_prefix(CHS, pb, h, cseq - tb, lane);
        float B[NSUB + 1]; B[0] = 0.f; float Apre = -INFINITY, Aall = -INFINITY;
#pragma unroll
        for (int i = 0; i < NSUB; ++i) {
          const float bl = CHS[((cg0 + i) * 4 + h) * 2], al = CHS[((cg0 + i) * 4 + h) * 2 + 1];
          if (i < tb) Apre = fmaxf(Apre, al - B[i]);
          Aall = fmaxf(Aall, al - B[i]);
          B[i + 1] = B[i] + bl;
        }
        float Btb = 0.f;
#pragma unroll
        for (int i = 0; i < NSUB; ++i) if (i == tb) Btb = B[i];
        const float Mlast = fmaxf(mprev, Aall);
        const size_t o = (size_t)(row0 + lane) * 4 + h;
        const float bt = GB[o] + Btb, ut = GU[o] - Btb, at = fmaxf(Apre, GA[o] - Btb);
        const float Mt = fmaxf(mprev, at);
        sM[lane] = Mt;
        WINTER[o] = __expf(mprev - Mt);
        ENEGM[o] = __expf(-(bt + Mt));
        WUPD[o] = __expf(ut - Mlast);
#pragma unroll
        for (int i = 0; i < NSUB; ++i) if (i <= tb) su[i * 64 + lane] = GU[(size_t)((cg0 + i) * 64 + lane) * 4 + h] - B[i];
        if (lane == 0) {
          if (tb == 0) DECAY[uid] = __expf(mprev - Mlast);
          if (cseq == 127) p.out[O_MP + pb * 4 + h] = B[NSUB] + Mlast;
        }
      }
      __syncthreads();
      float dpart = 0.f;
      const int t = 32 * ti + l31;
      const float Mt = sM[t];
      for (int jj = 0; jj <= tb; ++jj) {
        bf16_t* swb = SWL + (size_t)((jj * 2 + ti) * 4) * 512;
        if (jj < tb || si <= ti) {
          f32x16 acc;
#pragma unroll
          for (int i = 0; i < 16; ++i) acc[i] = 0.f;
          const bf16_t* ka = KF + ((size_t)((cg0 + jj) * 4 + h) * 2 + si) * 32 * 512 + lane * 8;
          const bf16_t* qb = QF + ((size_t)(cg * 4 + h) * 2 + ti) * 32 * 512 + lane * 8;
#pragma unroll 1
          for (int kb = 0; kb < 2; ++kb) {
            u32x4 fa[16], fb[16];
#pragma unroll
            for (int i = 0; i < 16; ++i) { fa[i] = *(const u32x4*)(ka + (kb * 16 + i) * 512); fb[i] = *(const u32x4*)(qb + (kb * 16 + i) * 512); }
            __builtin_amdgcn_sched_barrier(0);
#pragma unroll
            for (int i = 0; i < 16; ++i) acc = MFMA32(as_bf16x8(fa[i]), as_bf16x8(fb[i]), acc);
            __builtin_amdgcn_sched_barrier(0);
          }
#pragma unroll
          for (int g = 0; g < 4; ++g) {
            float w4[4];
#pragma unroll
            for (int x = 0; x < 4; ++x) {
              const int s = 32 * si + 8 * g + 4 * hh + x;
              const float v = (jj < tb || s <= t) ? acc[4 * g + x] * __expf(su[jj * 64 + s] - Mt) : 0.f;
              w4[x] = v; dpart += v;
            }
            u32x2 o; o.x = cvt_pk_bf16(w4[0], w4[1]); o.y = cvt_pk_bf16(w4[2], w4[3]);
            *(u32x2*)(swb + (2 * si + (g >> 1)) * 512 + (l31 + 32 * (g & 1)) * 8 + 4 * hh) = o;
          }
        } else {
          u32x2 z; z.x = 0u; z.y = 0u;
#pragma unroll
          for (int g = 0; g < 4; ++g) *(u32x2*)(swb + (2 * si + (g >> 1)) * 512 + (l31 + 32 * (g & 1)) * 8 + 4 * hh) = z;
        }
      }
      dpart += __shfl_xor(dpart, 32);
      if (hh == 0) sden[si * 64 + t] = dpart;
      __syncthreads();
      if (tid < 64) DENI[(size_t)(row0 + tid) * 4 + h] = sden[tid] + sden[64 + tid];
#pragma unroll 1
      for (int eti = 0; eti < 4; ++eti) {
        const int et = wid + 4 * eti;
        f32x16 a0, a1;
#pragma unroll
        for (int i = 0; i < 16; ++i) { a0[i] = 0.f; a1[i] = 0.f; }
        u32x4 vfr[NSUB][4];
#pragma unroll
        for (int jj = 0; jj < NSUB; ++jj) {
          if (jj <= tb) {
            const bf16_t* vf = VF + ((((size_t)((cg0 + jj) * 4 + h) * 16 + et) * 4) * 64 + lane) * 8;
#pragma unroll
            for (int ks = 0; ks < 4; ++ks) vfr[jj][ks] = *(const u32x4*)(vf + ks * 512);
          }
        }
        __builtin_amdgcn_sched_barrier(0);
#pragma unroll
        for (int jj = 0; jj < NSUB; ++jj) {
          if (jj <= tb) {
            const bf16_t* sw = SWL + (size_t)(jj * 8) * 512 + lane * 8;
#pragma unroll
            for (int ks = 0; ks < 4; ++ks) {
              const bf16x8 v = as_bf16x8(vfr[jj][ks]);
              a0 = MFMA32(v, *(const bf16x8*)(sw + ks * 512), a0);
              a1 = MFMA32(v, *(const bf16x8*)(sw + (4 + ks) * 512), a1);
            }
          }
        }
        bf16_t* dst0 = NUMI + numidx(row0 + l31, h, et * 32) + 4 * hh;
        bf16_t* dst1 = NUMI + numidx(row0 + 32 + l31, h, et * 32) + 4 * hh;
#pragma unroll
        for (int g = 0; g < 4; ++g) {
          u32x2 o0; o0.x = cvt_pk_bf16(a0[4 * g], a0[4 * g + 1]); o0.y = cvt_pk_bf16(a0[4 * g + 2], a0[4 * g + 3]);
          u32x2 o1; o1.x = cvt_pk_bf16(a1[4 * g], a1[4 * g + 1]); o1.y = cvt_pk_bf16(a1[4 * g + 2], a1[4 * g + 3]);
          *(u32x2*)(dst0 + 8 * g) = o0;
          *(u32x2*)(dst1 + 8 * g) = o1;
        }
      }
    } else {
      const int sb = (uid - 1024) >> 2, row0 = NP + sb * 16, cg = row0 >> 6, r0 = (sb & 3) * 16, mts = r0 >> 5, r0t = r0 & 31, ksq = sb & 3;
      if (wid == 0) {
        const float mprev = p.in[4][uid - 1024];
        const bool valid = lane < 16;
        const size_t o = (size_t)(row0 + (valid ? lane : 0)) * 4 + h;
        const float bt = GB[o], ut = GU[o], at = GA[o];
        const float Mt = fmaxf(mprev, at);
        const float alast = __shfl(at, 15), blast = __shfl(bt, 15);
        const float Mlast = fmaxf(mprev, alast);
        sM[lane] = Mt; su[lane] = ut;
        if (valid) { WINTER[o] = __expf(mprev - Mt); ENEGM[o] = __expf(-(bt + Mt)); WUPD[o] = __expf(ut - Mlast); }
        if (lane == 0) { DECAY[uid] = __expf(mprev - Mlast); p.out[O_MS + (uid - 1024)] = blast + Mlast; }
      }
      __syncthreads();
      if (wid == 0) {
        f32x16 acc;
#pragma unroll
        for (int i = 0; i < 16; ++i) acc[i] = 0.f;
        const bf16_t* ka = KF + ((size_t)(cg * 4 + h) * 2 + mts) * 32 * 512 + lane * 8;
        const bf16_t* qb = QF + ((size_t)(cg * 4 + h) * 2 + mts) * 32 * 512 + lane * 8;
#pragma unroll 1
        for (int kb = 0; kb < 2; ++kb) {
          u32x4 fa[16], fb[16];
#pragma unroll
          for (int i = 0; i < 16; ++i) { fa[i] = *(const u32x4*)(ka + (kb * 16 + i) * 512); fb[i] = *(const u32x4*)(qb + (kb * 16 + i) * 512); }
          __builtin_amdgcn_sched_barrier(0);
#pragma unroll
          for (int i = 0; i < 16; ++i) acc = MFMA32(as_bf16x8(fa[i]), as_bf16x8(fb[i]), acc);
          __builtin_amdgcn_sched_barrier(0);
        }
        const int tl = l31 - r0t;
        const bool tv = tl >= 0 && tl < 16;
        const float Mt = sM[tv ? tl : 0];
        float dpart = 0.f;
#pragma unroll
        for (int g = 0; g < 4; ++g) {
          float w4[4];
#pragma unroll
          for (int x = 0; x < 4; ++x) {
            const int s = 8 * g + 4 * hh + x, sl = s - r0t;
            const bool ok = tv && sl >= 0 && s <= l31;
            const float v = ok ? acc[4 * g + x] * __expf(su[ok ? sl : 0] - Mt) : 0.f;
            w4[x] = v; dpart += v;
          }
          u32x2 o; o.x = cvt_pk_bf16(w4[0], w4[1]); o.y = cvt_pk_bf16(w4[2], w4[3]);
          *(u32x2*)(SWL + (g >> 1) * 512 + (l31 + 32 * (g & 1)) * 8 + 4 * hh) = o;
        }
        dpart += __shfl_xor(dpart, 32);
        if (hh == 0 && tv) DENI[(size_t)(row0 + tl) * 4 + h] = dpart;
      }
      __syncthreads();
      {
        const int tl = l31 - r0t;
        const bool tv = tl >= 0 && tl < 16;
        const bf16x8 swf = *(const bf16x8*)(SWL + (r0t >> 4) * 512 + lane * 8);
#pragma unroll 1
        for (int eti = 0; eti < 4; ++eti) {
          const int et = wid + 4 * eti;
          f32x16 a0;
#pragma unroll
          for (int i = 0; i < 16; ++i) a0[i] = 0.f;
          const bf16x8 v = as_bf16x8(*(const u32x4*)(VF + ((((size_t)(cg * 4 + h) * 16 + et) * 4 + ksq) * 64 + lane) * 8));
          a0 = MFMA32(v, swf, a0);
          if (tv) {
            bf16_t* dst = NUMI + numidx(row0 + tl, h, et * 32) + 4 * hh;
#pragma unroll
            for (int g = 0; g < 4; ++g) { u32x2 o0; o0.x = cvt_pk_bf16(a0[4 * g], a0[4 * g + 1]); o0.y = cvt_pk_bf16(a0[4 * g + 2], a0[4 * g + 3]); *(u32x2*)(dst + 8 * g) = o0; }
          }
        }
      }
    }
  }
}

DEV bf16x8 pack_acc(const f32x16& x, int s) {
  u32x4 pk;
  if (s == 0) { pk.x = cvt_pk_bf16(x[0], x[1]); pk.y = cvt_pk_bf16(x[2], x[3]); pk.z = cvt_pk_bf16(x[4], x[5]); pk.w = cvt_pk_bf16(x[6], x[7]); }
  else { pk.x = cvt_pk_bf16(x[8], x[9]); pk.y = cvt_pk_bf16(x[10], x[11]); pk.z = cvt_pk_bf16(x[12], x[13]); pk.w = cvt_pk_bf16(x[14], x[15]); }
  return as_bf16x8(pk);
}
DEV bf16x8 scale_frag(u32x4 raw, const float* w) {
  const f32x4 w0 = *(const f32x4*)(w), w1 = *(const f32x4*)(w + 4);
  u32x4 pk;
  pk.x = cvt_pk_bf16(bf_lo(raw.x) * w0.x, bf_hi(raw.x) * w0.y); pk.y = cvt_pk_bf16(bf_lo(raw.y) * w0.z, bf_hi(raw.y) * w0.w);
  pk.z = cvt_pk_bf16(bf_lo(raw.z) * w1.x, bf_hi(raw.z) * w1.y); pk.w = cvt_pk_bf16(bf_lo(raw.w) * w1.z, bf_hi(raw.w) * w1.w);
  return as_bf16x8(pk);
}

DEV void store_ctile(float* base, const f32x16 (&C)[4]) {
  float* cptr = base;
#pragma unroll
  for (int dt = 0; dt < 4; ++dt)
#pragma unroll
    for (int q = 0; q < 4; ++q) {
      cptr[0] = C[dt][4 * q]; cptr[512] = C[dt][4 * q + 1]; cptr[1024] = C[dt][4 * q + 2]; cptr[1536] = C[dt][4 * q + 3];
      cptr += 8 * 512; asm volatile("" : "+v"(cptr));
    }
}
DEV void load_ctile(const float* base, f32x16 (&C)[4]) {
  const float* cptr = base;
#pragma unroll
  for (int dt = 0; dt < 4; ++dt)
#pragma unroll
    for (int q = 0; q < 4; ++q) {
      C[dt][4 * q] = cptr[0]; C[dt][4 * q + 1] = cptr[512]; C[dt][4 * q + 2] = cptr[1024]; C[dt][4 * q + 3] = cptr[1536];
      cptr += 8 * 512; asm volatile("" : "+v"(cptr));
    }
}

constexpr unsigned BF_ONES = 0x3F803F80u;

DEV void lds_barrier() { asm volatile("s_waitcnt lgkmcnt(0)\n\ts_barrier" ::: "memory"); }

DEV void scan_prompt(const Params& p, char* smem, int pb, int h, int sl, unsigned* prog) {
  int tid_ = threadIdx.x; asm volatile("" : "+v"(tid_));
  const int tid = tid_, lane = tid & 63, wid = tid >> 6, l31 = lane & 31, hh = lane >> 5;
  float* red = (float*)smem;
  float* swi = red + 2 * 4 * 64 * 32;
  float* swu = swi + 256;
  const bf16_t* QF = (const bf16_t*)(p.ws + OFF_E); const bf16_t* VF = (const bf16_t*)(p.ws + OFF_F); const bf16_t* KTF = (const bf16_t*)(p.out + O_Y);
  bf16_t* NUM = (bf16_t*)(p.ws + OFF_B);
  const float* WINTER = (const float*)(p.ws + OFF_WINTER); const float* WUPD = (const float*)(p.ws + OFF_WUPD); const float* DECAY = (const float*)(p.ws + OFF_DECAY);
  const float* DENI = (const float*)(p.ws + OFF_DENI); const float* ENEGM = (const float*)(p.ws + OFF_ENEGM); float* DINV = (float*)(p.ws + OFF_DINV);
  const bool ns = sl == 16;
  const int slv = ns ? 0 : sl;
  f32x16 C[4];
#pragma unroll
  for (int dt = 0; dt < 4; ++dt)
#pragma unroll
    for (int i = 0; i < 16; ++i) C[dt][i] = 0.f;
  const int e0 = slv * 32;
  const u32x4 ones = {BF_ONES, BF_ONES, BF_ONES, BF_ONES};
  constexpr int RQ = 16;
  const int rt = tid >> 2, re8 = (tid & 3) * 8;
  float nwi, nwu, ndecay;
  { const size_t o = (size_t)(pb * 8192 + tid) * 4 + h; nwi = WINTER[o]; nwu = WUPD[o]; ndecay = DECAY[(pb * 128) * 4 + h]; }
  for (int sc = 0; sc < 128 / NSUB; ++sc) {
    const int cg0 = pb * 128 + sc * NSUB, rows = cg0 * 64;
    if (sl == 0 && tid == 0) __hip_atomic_store(prog + pb * 4 + h, (unsigned)sc, __ATOMIC_RELAXED, __HIP_MEMORY_SCOPE_AGENT);
    const bf16_t* qbase = QF + ((size_t)(cg0 * 4 + h) * 64 + 8 * wid) * 512 + lane * 8;
    u32x4 qf[RQ];
#pragma unroll
    for (int q = 0; q < RQ; ++q) qf[q] = *(const u32x4*)(qbase + (size_t)(q >> 4) * (4 * 64 * 512) + (size_t)(((q >> 3) & 1) * 32 + (q & 7)) * 512);
    lds_barrier();
    swi[tid] = nwi; swu[tid] = nwu;
    const float decay = ndecay;
    if (sc + 1 < 128 / NSUB) {
      const size_t o = (size_t)(rows + NSUB * 64 + tid) * 4 + h;
      nwi = WINTER[o]; nwu = WUPD[o]; ndecay = DECAY[(cg0 + NSUB) * 4 + h];
    }
    lds_barrier();
#pragma unroll
    for (int it = 0; it < 2 * NSUB; ++it) {
      const int j = it >> 1, mt = it & 1;
      const int cgj = cg0 + j;
      bf16_t* nump = NUM + numidx(cgj * 64 + rt, h, e0 + re8);
#pragma unroll
      for (int dt = 0; dt < 4; ++dt) asm volatile("" : "+v"(C[dt]));
      f32x16 ai;
#pragma unroll
      for (int i = 0; i < 16; ++i) ai[i] = 0.f;
#pragma unroll
      for (int kk = 0; kk < 8; ++kk) {
        const int q = it * 8 + kk;
        ai = MFMA32(as_bf16x8(qf[q % RQ]), pack_acc(C[kk >> 1], kk & 1), ai);
        if (q + RQ < 16 * NSUB) {
          const int qn = q + RQ;
          qf[q % RQ] = *(const u32x4*)(qbase + (size_t)(qn >> 4) * (4 * 64 * 512) + (size_t)(((qn >> 3) & 1) * 32 + (qn & 7)) * 512);
        }
      }
      float* rb = red + (j & 1) * (4 * 64 * 32);
      {
        float* rbt = rb + (wid * 64 + 4 * hh) * 32 + l31;
        const float* swij = swi + j * 64 + 4 * hh + 32 * mt;
        f32x4 w4[4];
#pragma unroll
        for (int q = 0; q < 4; ++q) w4[q] = *(const f32x4*)(swij + 8 * q);
#pragma unroll
        for (int i = 0; i < 16; ++i) {
          const int t0 = 32 * mt + (i & 3) + 8 * (i >> 2);
          rbt[t0 * 32] = w4[i >> 2][i & 3] * ai[i];
        }
      }
      if (mt == 1) {
        lds_barrier();
        f32x4 s0 = *(const f32x4*)(rb + rt * 32 + re8), s1 = *(const f32x4*)(rb + rt * 32 + re8 + 4);
#pragma unroll
        for (int w = 1; w < 4; ++w) { s0 += *(const f32x4*)(rb + (w * 64 + rt) * 32 + re8); s1 += *(const f32x4*)(rb + (w * 64 + rt) * 32 + re8 + 4); }
        if (!ns) {
          u32x4 o;
          o.x = cvt_pk_bf16(s0.x, s0.y); o.y = cvt_pk_bf16(s0.z, s0.w); o.z = cvt_pk_bf16(s1.x, s1.y); o.w = cvt_pk_bf16(s1.z, s1.w);
          *(u32x4*)nump = o;
        } else if (re8 == 0) {
          const size_t o = (size_t)(cgj * 64 + rt) * 4 + h;
          DINV[o] = s0.x;
        }
      }
    }
#pragma unroll
    for (int dt = 0; dt < 4; ++dt)
#pragma unroll
      for (int i = 0; i < 16; ++i) C[dt][i] *= decay;
    constexpr int PF = 5;
    u32x4 vb[PF], kb[PF][4];
    const bf16_t* vbase = VF + ((((size_t)(cg0 * 4 + h) * 16 + slv) * 4) * 64 + lane) * 8;
    const bf16_t* kbase = KTF + ((((size_t)(cg0 * 4 + h) * 16 + 4 * wid) * 4) * 64 + lane) * 8;
#pragma unroll
    for (int k16 = 0; k16 < PF; ++k16) {
      const size_t off = (size_t)(k16 >> 2) * (4 * 16 * 4 * 512) + (size_t)(k16 & 3) * 512;
      vb[k16] = ns ? ones : *(const u32x4*)(vbase + off);
#pragma unroll
      for (int dt = 0; dt < 4; ++dt) kb[k16][dt] = *(const u32x4*)(kbase + off + (size_t)dt * 4 * 512);
    }
#pragma unroll
    for (int k16 = 0; k16 < NSUB * 4; ++k16) {
      const bf16x8 b = scale_frag(vb[k16 % PF], swu + k16 * 16 + 8 * hh);
#pragma unroll
      for (int dt = 0; dt < 4; ++dt) C[dt] = MFMA32(as_bf16x8(kb[k16 % PF][dt]), b, C[dt]);
      if (k16 + PF < NSUB * 4) {
        const int kn = k16 + PF;
        const size_t off = (size_t)(kn >> 2) * (4 * 16 * 4 * 512) + (size_t)(kn & 3) * 512;
        vb[k16 % PF] = ns ? ones : *(const u32x4*)(vbase + off);
#pragma unroll
        for (int dt = 0; dt < 4; ++dt) kb[k16 % PF][dt] = *(const u32x4*)(kbase + off + (size_t)dt * 4 * 512);
      }
    }
  }
  if (!ns) store_ctile(p.out + O_CP + (size_t)(pb * 4 + h) * 262144 + (size_t)(128 * wid + 4 * hh) * 512 + e0 + l31, C);
  else if (l31 == 0) {
    float* nout = p.out + O_NP + (size_t)(pb * 4 + h) * 512 + 128 * wid + 4 * hh;
#pragma unroll
    for (int dt = 0; dt < 4; ++dt)
#pragma unroll
      for (int i = 0; i < 16; ++i) nout[32 * dt + (i & 3) + 8 * (i >> 2)] = C[dt][i];
  }
}

DEV void scan_sample(const Params& p_, char* smem, int sbh, int sl) {
  Params p = p_;
  asm volatile("" : "+s"(p.ws), "+s"(p.out), "+s"(p.in[2]), "+s"(p.in[3]));
  const int tid = threadIdx.x, lane = tid & 63, wid = tid >> 6, l31 = lane & 31, hh = lane >> 5;
  float* red = (float*)smem;
  float* swi = red + 2 * 4 * 64 * 32;
  float* swu = swi + 256;
  const bf16_t* QF = (const bf16_t*)(p.ws + OFF_E); const bf16_t* VF = (const bf16_t*)(p.ws + OFF_F); const bf16_t* KTF = (const bf16_t*)(p.out + O_Y);
  const bf16_t* SWF = (const bf16_t*)(p.ws + OFF_SW);
  bf16_t* NUM = (bf16_t*)(p.ws + OFF_B);
  const float* WINTER = (const float*)(p.ws + OFF_WINTER); const float* WUPD = (const float*)(p.ws + OFF_WUPD); const float* DECAY = (const float*)(p.ws + OFF_DECAY);
  const float* DENI = (const float*)(p.ws + OFF_DENI); const float* ENEGM = (const float*)(p.ws + OFF_ENEGM); float* DINV = (float*)(p.ws + OFF_DINV);
  const int sb = sbh >> 2, h = sbh & 3, row0 = NP + sb * 16, cg = row0 >> 6, r0 = (sb & 3) * 16, mts = r0 >> 5, r0t = r0 & 31, ksq = sb & 3;
  const bool ns = sl == 16;
  const int slv = ns ? 0 : sl;
  const int uid = 1024 + sbh, e0 = slv * 32;
  f32x16 C[4];
  if (!ns) load_ctile(p.in[2] + (size_t)sbh * 262144 + (size_t)(128 * wid + 4 * hh) * 512 + e0 + l31, C);
  else {
    const float* n0 = p.in[3] + (size_t)sbh * 512 + 128 * wid + 4 * hh;
#pragma unroll
    for (int dt = 0; dt < 4; ++dt)
#pragma unroll
      for (int i = 0; i < 16; ++i) C[dt][i] = n0[32 * dt + (i & 3) + 8 * (i >> 2)];
  }
  __syncthreads();
  if (tid < 32) { const int tl = tid - r0t; swi[tid] = (tl >= 0 && tl < 16) ? WINTER[(size_t)(row0 + tl) * 4 + h] : 0.f; }
  if (tid >= 64 && tid < 80) swu[tid - 64] = WUPD[(size_t)(row0 + tid - 64) * 4 + h];
  const float decay = DECAY[uid];
  f32x16 ai, aa;
#pragma unroll
  for (int i = 0; i < 16; ++i) { ai[i] = 0.f; aa[i] = 0.f; }
  const bf16_t* qa = QF + ((size_t)((cg * 4 + h) * 2 + mts) * 32 + 8 * wid) * 512 + lane * 8;
#pragma unroll
  for (int kk = 0; kk < 8; ++kk) {
    const bf16x8 a = as_bf16x8(*(const u32x4*)(qa + (size_t)kk * 512));
    ai = MFMA32(a, pack_acc(C[kk >> 1], kk & 1), ai);
  }
  u32x4 vraw = {BF_ONES, BF_ONES, BF_ONES, BF_ONES};
  if (!ns) vraw = *(const u32x4*)(VF + ((((size_t)(cg * 4 + h) * 16 + slv) * 4 + ksq) * 64 + lane) * 8);
  __syncthreads();
  {
    float* rbt = red + (wid * 32 + 4 * hh) * 32 + l31;
    const float* swij = swi + 4 * hh;
    f32x4 w4[4];
#pragma unroll
    for (int q = 0; q < 4; ++q) w4[q] = *(const f32x4*)(swij + 8 * q);
#pragma unroll
    for (int i = 0; i < 16; ++i) {
      const int t0 = (i & 3) + 8 * (i >> 2);
      rbt[t0 * 32] = aa[i] + w4[i >> 2][i & 3] * ai[i];
    }
  }
#pragma unroll
  for (int dt = 0; dt < 4; ++dt)
#pragma unroll
    for (int i = 0; i < 16; ++i) C[dt][i] *= decay;
  {
    const bf16x8 b = scale_frag(vraw, swu + 8 * hh);
    const bf16_t* ka = KTF + ((((size_t)(cg * 4 + h) * 16 + 4 * wid) * 4 + ksq) * 64 + lane) * 8;
#pragma unroll
    for (int dt = 0; dt < 4; ++dt) C[dt] = MFMA32(as_bf16x8(*(const u32x4*)(ka + (size_t)dt * 4 * 512)), b, C[dt]);
  }
  __syncthreads();
  if (tid < 64) {
    const int t = tid >> 2, e8 = (tid & 3) * 8, tr = r0t + t;
    f32x4 s0 = *(const f32x4*)(red + tr * 32 + e8), s1 = *(const f32x4*)(red + tr * 32 + e8 + 4);
#pragma unroll
    for (int w = 1; w < 4; ++w) { s0 += *(const f32x4*)(red + (w * 32 + tr) * 32 + e8); s1 += *(const f32x4*)(red + (w * 32 + tr) * 32 + e8 + 4); }
    if (!ns) {
      bf16_t* nump = NUM + numidx(row0 + t, h, e0 + e8);
      u32x4 o;
      o.x = cvt_pk_bf16(s0.x, s0.y); o.y = cvt_pk_bf16(s0.z, s0.w); o.z = cvt_pk_bf16(s1.x, s1.y); o.w = cvt_pk_bf16(s1.z, s1.w);
      *(u32x4*)nump = o;
    } else if (e8 == 0) {
      const size_t o = (size_t)(row0 + t) * 4 + h;
      DINV[o] = s0.x;
    }
  }
  if (!ns) store_ctile(p.out + O_CS + (size_t)sbh * 262144 + (size_t)(128 * wid + 4 * hh) * 512 + e0 + l31, C);
  else if (l31 == 0) {
    float* nout = p.out + O_NS + (size_t)sbh * 512 + 128 * wid + 4 * hh;
#pragma unroll
    for (int dt = 0; dt < 4; ++dt)
#pragma unroll
      for (int i = 0; i < 16; ++i) nout[32 * dt + (i & 3) + 8 * (i >> 2)] = C[dt][i];
  }
}

DEV unsigned hw_xcc_id() { return (unsigned)__builtin_amdgcn_s_getreg((3 << 11) | 20) & 0xFu; }

constexpr int NPF = 6;
constexpr int PF_AHEAD = 2;
DEV void scan_prefetch(const Params& p, int bh, int part, unsigned* prog, volatile int* flag) {
  const int tid = threadIdx.x, pb = bh >> 2, h = bh & 3;
  const bf16_t* QF = (const bf16_t*)(p.ws + OFF_E); const bf16_t* VF = (const bf16_t*)(p.ws + OFF_F); const bf16_t* KTF = (const bf16_t*)(p.out + O_Y);
  unsigned sink = 0u;
  for (int sc = 0; sc < 128 / NSUB; ++sc) {
    if (tid == 0) {
      unsigned spins = 0; int dead = 0;
      while ((int)__hip_atomic_load(prog + bh, __ATOMIC_RELAXED, __HIP_MEMORY_SCOPE_AGENT) + PF_AHEAD < sc) { __builtin_amdgcn_s_sleep(8); if (++spins > (1u << 15)) { dead = 1; break; } }
      flag[0] = dead;
    }
    __syncthreads();
    if (flag[0]) break;
    __syncthreads();
    const int cg0 = pb * 128 + sc * NSUB;
    for (int r = part; r < 3 * NSUB; r += NPF) {
      const int which = r / NSUB, j = r % NSUB;
      const bf16_t* base = (which == 0 ? QF : (which == 1 ? KTF : VF)) + (size_t)((cg0 + j) * 4 + h) * 32768;
      u32x4 v[16];
#pragma unroll
      for (int i = 0; i < 16; ++i) v[i] = *(const u32x4*)(base + (size_t)(i * 256 + tid) * 8);
#pragma unroll
      for (int i = 0; i < 16; ++i) sink ^= v[i].x ^ v[i].w;
    }
  }
  asm volatile("" :: "v"(sink));
}


DEV void scan_phase(const Params& p, char* smem) {
  const int tid = threadIdx.x, bid = blockIdx.x;
  unsigned* cnt = (unsigned*)(p.ws + OFF_BAR + 14336);
  volatile int* sunit = (volatile int*)(smem + 73728 - 16);
  constexpr int NSS = 128 * 17;
  int stage = 0, bh_try = 0;
  for (;;) {
    __syncthreads();
    if (tid == 0) {
      int kind = -1, a = 0, b = 0;
      for (;;) {
        if (stage == 0) {
          stage = 1;
          const unsigned x = hw_xcc_id() & 7u;
          if (bid < 256) { const unsigned t = atomicAdd(&cnt[x], 1u); if (t < 17u) { kind = 0; a = (int)x; b = (int)t; break; } }
          else { const unsigned t = atomicAdd(&cnt[8 + x], 1u); if (t < (unsigned)NPF) { kind = 2; a = (int)x; b = (int)t; break; } }
        } else if (stage == 1) {
          const unsigned u = atomicAdd(&cnt[16], 1u);
          if (u < (unsigned)NSS) { kind = 1; a = (int)u; break; }
          stage = 2;
        } else {
          if (bh_try >= 8) break;
          const unsigned t = atomicAdd(&cnt[bh_try], 1u);
          if (t < 17u) { kind = 0; a = bh_try; b = (int)t; break; }
          ++bh_try;
        }
      }
      sunit[0] = kind; sunit[1] = a; sunit[2] = b;
    }
    __syncthreads();
    const int kind = sunit[0], a = sunit[1], b = sunit[2];
    if (kind < 0) break;
    if (kind == 0) scan_prompt(p, smem, a >> 2, a & 3, b, cnt + 32);
    else if (kind == 1) scan_sample(p, smem, a / 17, a % 17);
    else scan_prefetch(p, a, b, cnt + 32, sunit + 3);
  }
}

DEV void hnorm_phase(const Params& p) {
  const int tid = threadIdx.x, lane = tid & 63, h = tid >> 6;
  const bf16_t* NUM = (const bf16_t*)(p.ws + OFF_B); const bf16_t* XC = (const bf16_t*)(p.ws + OFF_D); const bf16_t* Z2 = (const bf16_t*)(p.ws + OFF_C);
  const float* DINV = (const float*)(p.ws + OFF_DINV); const float* DENI = (const float*)(p.ws + OFF_DENI); const float* ENEGM = (const float*)(p.ws + OFF_ENEGM);
  bf16_t* A4 = (bf16_t*)(p.ws + OFF_F);
  const int ch = h * 512 + lane * 8;
  float hg[8], sk[8];
  { const f32x4 a = *(const f32x4*)(p.in[22] + ch), b = *(const f32x4*)(p.in[22] + ch + 4); hg[0] = a.x; hg[1] = a.y; hg[2] = a.z; hg[3] = a.w; hg[4] = b.x; hg[5] = b.y; hg[6] = b.z; hg[7] = b.w; }
  { const f32x4 a = *(const f32x4*)(p.in[23] + ch), b = *(const f32x4*)(p.in[23] + ch + 4); sk[0] = a.x; sk[1] = a.y; sk[2] = a.z; sk[3] = a.w; sk[4] = b.x; sk[5] = b.y; sk[6] = b.z; sk[7] = b.w; }
  const bf16_t* NUMI = (const bf16_t*)(p.ws + OFF_SW);
  int tok = blockIdx.x;
  float dinv_n = 0.f; u32x4 nr_n = {0u, 0u, 0u, 0u}, ni_n = nr_n, xr_n = nr_n, zr_n = nr_n;
  if (tok < T) {
    dinv_n = 1.f / fmaxf(fabsf(DENI[(size_t)tok * 4 + h] + DINV[(size_t)tok * 4 + h]), ENEGM[(size_t)tok * 4 + h]);
    nr_n = *(const u32x4*)(NUM + numidx(tok, h, lane * 8)); ni_n = *(const u32x4*)(NUMI + numidx(tok, h, lane * 8));
    xr_n = *(const u32x4*)(XC + (size_t)tok * E + ch); zr_n = *(const u32x4*)(Z2 + (size_t)tok * E + ch);
  }
  for (; tok < T; tok += gridDim.x) {
    const float dinv = dinv_n; const u32x4 nr = nr_n, ni = ni_n, xr = xr_n, zr = zr_n;
    const int tn = tok + gridDim.x;
    if (tn < T) {
      dinv_n = 1.f / fmaxf(fabsf(DENI[(size_t)tn * 4 + h] + DINV[(size_t)tn * 4 + h]), ENEGM[(size_t)tn * 4 + h]);
      nr_n = *(const u32x4*)(NUM + numidx(tn, h, lane * 8)); ni_n = *(const u32x4*)(NUMI + numidx(tn, h, lane * 8));
      xr_n = *(const u32x4*)(XC + (size_t)tn * E + ch); zr_n = *(const u32x4*)(Z2 + (size_t)tn * E + ch);
    }
    float v[8] = {(bf_lo(nr.x) + bf_lo(ni.x)) * dinv, (bf_hi(nr.x) + bf_hi(ni.x)) * dinv, (bf_lo(nr.y) + bf_lo(ni.y)) * dinv, (bf_hi(nr.y) + bf_hi(ni.y)) * dinv, (bf_lo(nr.z) + bf_lo(ni.z)) * dinv, (bf_hi(nr.z) + bf_hi(ni.z)) * dinv, (bf_lo(nr.w) + bf_lo(ni.w)) * dinv, (bf_hi(nr.w) + bf_hi(ni.w)) * dinv};
    const float xc[8] = {bf_lo(xr.x), bf_hi(xr.x), bf_lo(xr.y), bf_hi(xr.y), bf_lo(xr.z), bf_hi(xr.z), bf_lo(xr.w), bf_hi(xr.w)};
    const float z[8] = {bf_lo(zr.x), bf_hi(zr.x), bf_lo(zr.y), bf_hi(zr.y), bf_lo(zr.z), bf_hi(zr.z), bf_lo(zr.w), bf_hi(zr.w)};
    float s = 0.f;
#pragma unroll
    for (int j = 0; j < 8; ++j) s += v[j];
    const float mean = wave_sum(s) * (1.f / 512.f);
    float s2 = 0.f;
#pragma unroll
    for (int j = 0; j < 8; ++j) { v[j] -= mean; s2 += v[j] * v[j]; }
    const float rstd = rsqrtf(wave_sum(s2) * (1.f / 512.f) + 1e-5f);
    float o[8];
#pragma unroll
    for (int j = 0; j < 8; ++j) o[j] = (v[j] * rstd * hg[j] + sk[j] * xc[j]) * siluf_(z[j]);
    u32x4 ov; ov.x = cvt_pk_bf16(o[0], o[1]); ov.y = cvt_pk_bf16(o[2], o[3]); ov.z = cvt_pk_bf16(o[4], o[5]); ov.w = cvt_pk_bf16(o[6], o[7]);
    *(u32x4*)(A4 + (size_t)tok * E + ch) = ov;
  }
}

DEV void final_phase(const Params& p) {
  const int tid = threadIdx.x, lane = tid & 63, wid = tid >> 6;
  const float* SS2 = (const float*)(p.ws + OFF_SS2);
  const float* g = p.in[7];
  f32x4 gv[4];
#pragma unroll
  for (int j = 0; j < 4; ++j) gv[j] = *(const f32x4*)(g + j * 256 + lane * 4);
  for (int row = blockIdx.x * 4 + wid; row < T; row += gridDim.x * 4) {
    float s = 0.f;
#pragma unroll
    for (int j = 0; j < 4; ++j) { const f32x4 v = *(const f32x4*)(SS2 + (size_t)row * 16 + 4 * j); s += v.x + v.y + v.z + v.w; }
    const float r = rsqrtf(s * (1.f / DM) + 1e-6f);
    float* y = p.out + O_Y + (size_t)row * DM;
#pragma unroll
    for (int j = 0; j < 4; ++j) { f32x4 v = *(const f32x4*)(y + j * 256 + lane * 4); v.x *= r * gv[j].x; v.y *= r * gv[j].y; v.z *= r * gv[j].z; v.w *= r * gv[j].w; *(f32x4*)(y + j * 256 + lane * 4) = v; }
  }
}

#define XB_TMO      128
#define XB_XCNT(j)  (256  + 64 * (j))
#define XB_XSUB(j)  (1280 + 64 * (j))
#define XB_XGEN(j)  (2304 + 64 * (j))
#define XB_TOP      3328
#define XB_TOPGEN   3392
#define XCD_BAR_WORDS 3456
#define XB_SPIN_CAP (1u << 18)
#define LAS __attribute__((address_space(3)))
DEV unsigned xb_ld(unsigned* p)              { return __hip_atomic_load(p, __ATOMIC_RELAXED, __HIP_MEMORY_SCOPE_AGENT); }
DEV unsigned xb_add(unsigned* p, unsigned v) { return __hip_atomic_fetch_add(p, v, __ATOMIC_RELAXED, __HIP_MEMORY_SCOPE_AGENT); }
DEV unsigned xb_xcc_id() { return (unsigned)__builtin_amdgcn_s_getreg((3 << 11) | 20) & 0xFu; }
#define XB_SPIN(cond, bar) do { unsigned _sp = 0; while (cond) { __builtin_amdgcn_s_sleep(1); \
    if ((++_sp & 255u) == 0u) { if (xb_ld(&(bar)[XB_TMO])) break; if (_sp > XB_SPIN_CAP) { atomicAdd(&(bar)[XB_TMO], 1u); break; } } } } while (0)
struct XcdBarrier { unsigned* bar; unsigned x; volatile LAS unsigned* st; };
DEV XcdBarrier xcd_barrier_post(unsigned* bar, volatile LAS unsigned* st) {
  XcdBarrier b; b.bar = bar; b.x = xb_xcc_id(); b.st = st;
  if (threadIdx.x == 0) (void)xb_add(&bar[XB_XCNT(b.x)], 1u);
  return b;
}
DEV void xcd_barrier_complete(unsigned* bar, unsigned x, unsigned& nloc, unsigned& nx) {
  const unsigned G = gridDim.x * gridDim.y * gridDim.z;
  unsigned sum, cnt, mine, sp = 0u;
  for (;;) {
    sum = 0u; cnt = 0u; mine = 0u;
#pragma unroll
    for (unsigned j = 0; j < 16; ++j) { const unsigned c = xb_ld(&bar[XB_XCNT(j)]); sum += c; cnt += (c > 0u) ? 1u : 0u; mine = (j == x) ? c : mine; }
    if (sum == G) break;
    __builtin_amdgcn_s_sleep(1);
    if ((++sp & 255u) == 0u) { if (xb_ld(&bar[XB_TMO])) break; if (sp > XB_SPIN_CAP) { atomicAdd(&bar[XB_TMO], 1u); break; } }
  }
  nloc = mine > 0u ? mine : 1u; nx = cnt > 0u ? cnt : 1u;
}
DEV void xcd_barrier(const XcdBarrier& b) {
  asm volatile("s_waitcnt vmcnt(0)" ::: "memory");
  __syncthreads();
  if (threadIdx.x == 0) {
    unsigned* bar = b.bar;
    __builtin_amdgcn_s_waitcnt(0);
    unsigned nloc = b.st[0], nx = b.st[1];
    if (nloc == 0u) { xcd_barrier_complete(bar, b.x, nloc, nx); b.st[0] = nloc; b.st[1] = nx; }
    const unsigned old = xb_add(&bar[XB_XSUB(b.x)], 1u);
    const unsigned gen = old / nloc;
    if (old + 1u == (gen + 1u) * nloc) {
      __builtin_amdgcn_fence(__ATOMIC_RELEASE, "agent");
      asm volatile("s_waitcnt vmcnt(0)" ::: "memory");
      const unsigned og = xb_add(&bar[XB_TOP], 1u);
      const unsigned tg = og / nx;
      if (og + 1u == (tg + 1u) * nx) xb_add(&bar[XB_TOPGEN], 1u);
      else XB_SPIN(xb_ld(&bar[XB_TOPGEN]) == tg, bar);
      __builtin_amdgcn_fence(__ATOMIC_ACQUIRE, "agent");
      xb_add(&bar[XB_XGEN(b.x)], 1u);
      asm volatile("s_waitcnt vmcnt(0)" ::: "memory");
    } else {
      XB_SPIN(xb_ld(&bar[XB_XGEN(b.x)]) == gen, bar);
      __builtin_amdgcn_fence(__ATOMIC_ACQUIRE, "agent");
      asm volatile("s_waitcnt vmcnt(0)" ::: "memory");
    }
  }
  __syncthreads();
}

template <bool COOP>
__global__ void __launch_bounds__(NBLK, 2) fwd_kernel(Params p) {
  __shared__ __attribute__((aligned(16))) char smem[73728 + 16];
  XcdBarrier xb;
  if (COOP) {
    if (threadIdx.x == 0) *(uint4*)(smem + 73728) = make_uint4(0u, 0u, 0u, 0u);
    __syncthreads();
    xb = xcd_barrier_post((unsigned*)(p.ws + OFF_BAR), (volatile LAS unsigned*)(smem + 73728));
    if (p.ph_hi > 1000) cg::this_grid().sync();
  }
#ifndef REPMASK
#define REPMASK 0
#endif
#define PH_BEGIN(k) if (p.ph_lo <= (k) && (k) < p.ph_hi) for (int rep_ = 0; rep_ < (((REPMASK >> (k)) & 1) ? 2 : 1); ++rep_) { if (rep_) __syncthreads();
#define PH_END(k) } if (COOP) { if (p.ph_lo <= (k) && (k) + 1 < p.ph_hi) xcd_barrier(xb); }
  PH_BEGIN(0) phase0(p, smem); PH_END(0)
  PH_BEGIN(1) { Epi1 e{(const float*)(p.ws + OFF_RS0), (bf16_t*)(p.ws + OFF_A), (bf16_t*)(p.ws + OFF_B), (bf16_t*)(p.ws + OFF_C), (float*)(p.ws + OFF_VST)};
                gemm_phase((const bf16_t*)(p.ws + OFF_E), (const bf16_t*)(p.ws + OFF_W1), 6144, 1024, e, (bf16_t*)smem); } PH_END(1)
  PH_BEGIN(2) sgu_phase(p, smem); PH_END(2)
  PH_BEGIN(3) { EpiRes e{p.in[0], p.in[1], (float*)(p.ws + OFF_A), (bf16_t*)(p.ws + OFF_E + 34603008), (float*)(p.ws + OFF_SS1)};
                gemm_phase((const bf16_t*)(p.ws + OFF_D), (const bf16_t*)(p.ws + OFF_W2), 1024, 2048, e, (bf16_t*)smem, true); } PH_END(3)
  PH_BEGIN(4) { Epi3 e{(const float*)(p.ws + OFF_SS1), (bf16_t*)(p.ws + OFF_B), (bf16_t*)(p.ws + OFF_C)};
                gemm_phase((const bf16_t*)(p.ws + OFF_E + 34603008), (const bf16_t*)(p.ws + OFF_W3), 4096, 1024, e, (bf16_t*)smem); } PH_END(4)
  PH_BEGIN(5) conv_phase(p, smem); } if (COOP) xcd_barrier(xb); if (p.ph_lo <= 5 && 5 < p.ph_hi) { gate_phase(p, smem); PH_END(5)
  PH_BEGIN(6) intra_phase(p, smem); PH_END(6)
  PH_BEGIN(7) scan_phase(p, smem); PH_END(7)
  PH_BEGIN(8) hnorm_phase(p); PH_END(8)
  PH_BEGIN(9) { const float* x1 = (const float*)(p.ws + OFF_A);
                EpiRes e{x1, x1 + (size_t)NP * DM, p.out + O_Y, nullptr, (float*)(p.ws + OFF_SS2)};
                gemm_phase((const bf16_t*)(p.ws + OFF_F), (const bf16_t*)(p.ws + OFF_W4), 1024, 2048, e, (bf16_t*)smem, true); } PH_END(9)
  PH_BEGIN(10) final_phase(p); }
}

extern "C" void kernel_launch(void* const* d_in, const int* in_sizes, int n_in, void* d_out, int out_size, void* d_ws, size_t ws_size, hipStream_t stream) {
  static int grid = 0;
  if (grid == 0) {
    int dev = 0, cus = 0, per_cu = 0;
    hipGetDevice(&dev);
    hipDeviceGetAttribute(&cus, hipDeviceAttributeMultiprocessorCount, dev);
    hipOccupancyMaxActiveBlocksPerMultiprocessor(&per_cu, (const void*)fwd_kernel<true>, NBLK, 0);
    if (per_cu < 1) per_cu = 1;
    if (per_cu > 2) per_cu = 2;
    grid = cus * per_cu;
    if (ws_size < WS_END) { fprintf(stderr, "kernel_launch: workspace too small (%zu < %zu)\n", ws_size, (size_t)WS_END); grid = -1; }
  }
  if (grid < 0) return;
  Params p{};
  for (int i = 0; i < 25; ++i) p.in[i] = (const float*)d_in[i];
  p.out = (float*)d_out; p.ws = (char*)d_ws;
#if MULTI_LAUNCH
  for (int ph = 0; ph < NPHASE; ++ph) {
    p.ph_lo = ph; p.ph_hi = ph + 1;
    hipLaunchKernelGGL(fwd_kernel<false>, dim3(grid), dim3(NBLK), 0, stream, p);
  }
#else
  p.ph_lo = 0; p.ph_hi = NPHASE;
  (void)hipMemsetAsync((char*)d_ws + OFF_BAR, 0, 16384, stream);
  void* args[] = {&p};
  hipError_t e = hipLaunchCooperativeKernel((const void*)fwd_kernel<true>, dim3(grid), dim3(NBLK), args, 0, stream);
  if (e != hipSuccess) fprintf(stderr, "cooperative launch failed: %s (grid %d)\n", hipGetErrorString(e), grid);
#endif
}
```
